# Optimizing an MI355X kernel written in HIP

```python
import math
import jax, jax.numpy as jnp
from jax import lax
import numpy as np

D_MODEL = 1024
BATCH = 16
SEQ = 2048
DEPTH = 2

GRID_W = 64
CTX_LEN = 256
D_MIX = D_MODEL
N_GROUPS = 4
GROUP_W = D_MIX // N_GROUPS
CONV_W = 4
LRU_HEADS = 4
LRU_HD = GROUP_W // LRU_HEADS
LRU_C = 8.0
HGRN_HEADS = 4
HGRN_HD = GROUP_W // HGRN_HEADS
HGRN_CHUNK = 64
SSD_HEADS = 4
SSD_HD = GROUP_W // SSD_HEADS
SSD_BC_GROUPS = 2
SSD_STATE = 64
SSD_CHUNK = 64
SSD_XBC = GROUP_W + 2 * SSD_BC_GROUPS * SSD_STATE
MLA_HEADS = 4
MLA_Q_RANK = 192
MLA_KV_RANK = 128
MLA_NOPE = 64
MLA_ROPE = 32
MLA_V = GROUP_W // MLA_HEADS
ROPE_BASE = 10000.0
Q_BLOCK = 128
N_EXPERTS = 16
EXPERT_FF = 512
EC_FACTOR = 2
N_MOD = 6
EPS = 1e-6
LRU_COLS = 2 * GROUP_W
HGRN_COLS = 5 * GROUP_W
SSD_COLS = GROUP_W + SSD_XBC + 2 * SSD_HEADS
MLA_COLS = MLA_Q_RANK + MLA_KV_RANK + MLA_ROPE
IN_COLS = LRU_COLS + HGRN_COLS + SSD_COLS + MLA_COLS
SPLITS = [LRU_COLS, LRU_COLS + HGRN_COLS, LRU_COLS + HGRN_COLS + SSD_COLS]

kernel_name = 'hybrid_dit_rglru_hgrn2_ssd_mla_ecmoe'


def rmsnorm(x, w):
    xf = x.astype(jnp.float32)
    y = xf * lax.rsqrt(jnp.mean(xf * xf, axis=-1, keepdims=True) + EPS)
    return (y * w).astype(x.dtype)


def modulate(h, shift, scale):
    return h * (1.0 + scale) + shift


def flip(t, d):
    return t[:, ::-1] if d else t


def to_chunks(t, chunk):
    b, n = t.shape[:2]
    return t.reshape(b, n // chunk, chunk, *t.shape[2:]).swapaxes(0, 1)


def from_chunks(t):
    nc, b, ch = t.shape[:3]
    return t.swapaxes(0, 1).reshape(b, nc * ch, *t.shape[3:])


def dwconv(x, w, b):
    k = w.shape[0]
    n = x.shape[1]
    xp = jnp.pad(x, ((0, 0), (k // 2, k - 1 - k // 2), (0, 0)))
    return sum(xp[:, j:j + n] * w[j] for j in range(k)) + b


def linear_scan(a, b, h0):
    b = b.at[:, 0].add(a[:, 0] * h0)

    def combine(left, right):
        a_l, b_l = left
        a_r, b_r = right
        return a_l * a_r, a_r * b_l + b_r

    _, h = lax.associative_scan(combine, (a, b), axis=1)
    return h


def masked_decay(seg, mask):
    return jnp.where(mask, jnp.exp(jnp.where(mask, seg, 0.0)), 0.0)


def rglru_coeffs(xc, w_r, b_r, w_i, b_i, lam):
    bn, nn, _ = xc.shape
    xh = xc.reshape(bn, nn, LRU_HEADS, LRU_HD)
    r = jax.nn.sigmoid((jnp.einsum('bnhd,hde->bnhe', xh, w_r).reshape(bn, nn, GROUP_W) + b_r).astype(jnp.float32))
    i = jax.nn.sigmoid((jnp.einsum('bnhd,hde->bnhe', xh, w_i).reshape(bn, nn, GROUP_W) + b_i).astype(jnp.float32))
    log_a = -LRU_C * r * jax.nn.softplus(-lam.astype(jnp.float32))
    a = jnp.exp(log_a)
    b = jnp.sqrt(-jnp.expm1(2.0 * log_a)) * (i * xc.astype(jnp.float32))
    return a, b


def rglru_mixer(u, u_ctx, conv_w, conv_b, w_r, b_r, w_i, b_i, lam, need_ctx):
    x_l, gate_l = jnp.split(u, 2, axis=-1)
    x_c, gate_c = jnp.split(u_ctx, 2, axis=-1)
    x_l = dwconv(x_l, conv_w, conv_b)
    x_c = dwconv(x_c, conv_w, conv_b)
    h_l, h_c = [], []
    for d in range(2):
        a, b = rglru_coeffs(flip(x_c, d), w_r[d], b_r[d], w_i[d], b_i[d], lam[d])
        hc = linear_scan(a, b, jnp.zeros((u_ctx.shape[0], GROUP_W), jnp.float32))
        a, b = rglru_coeffs(flip(x_l, d), w_r[d], b_r[d], w_i[d], b_i[d], lam[d])
        hl = linear_scan(a, b, hc[:, -1])
        h_l.append(flip(hl, d))
        h_c.append(flip(hc, d))
    y_l = ((h_l[0] + h_l[1]) * jax.nn.gelu(gate_l.astype(jnp.float32))).astype(u.dtype)
    y_c = ((h_c[0] + h_c[1]) * jax.nn.gelu(gate_c.astype(jnp.float32))).astype(u.dtype) if need_ctx else None
    return y_l, y_c


def gla_chunk_scan(q, k, v, log_f, s0):
    f32 = jnp.float32
    mask = jnp.tril(jnp.ones((HGRN_CHUNK, HGRN_CHUNK), bool))[None, :, :, None, None]

    def step(s, blk):
        qc, kc, vc, gc = blk
        cum = jnp.cumsum(gc, axis=1)
        seg = cum[:, :, None] - cum[:, None]
        decay = masked_decay(seg, mask)
        scores = jnp.einsum('bthk,bshk,btshk->btsh', qc, kc, decay)
        y = jnp.einsum('btsh,bshv->bthv', scores, vc) + jnp.einsum('bthk,bhkv->bthv', qc * jnp.exp(cum), s)
        k_end = kc * jnp.exp(cum[:, -1:] - cum)
        s_new = s * jnp.exp(cum[:, -1])[..., None] + jnp.einsum('bshk,bshv->bhkv', k_end, vc)
        return s_new, y

    blks = tuple(to_chunks(t.astype(f32), HGRN_CHUNK) for t in (q, k, v, log_f))
    s_fin, ys = lax.scan(step, s0.astype(f32), blks)
    return from_chunks(ys), s_fin


def hgrn2_mixer(u, u_ctx, lb, norm_w, need_ctx):
    lb = lb.astype(jnp.float32).reshape(HGRN_HEADS, HGRN_HD)

    def heads(t):
        return t.reshape(t.shape[0], t.shape[1], HGRN_HEADS, HGRN_HD)

    def prep(v):
        q, f_fwd, f_bwd, inp, g = jnp.split(v, 5, axis=-1)
        return heads(jax.nn.silu(q)), (heads(f_fwd), heads(f_bwd)), heads(inp), g

    def gates(f_raw):
        sig = jax.nn.sigmoid(f_raw.astype(jnp.float32))
        f = lb + (1.0 - lb) * sig
        return jnp.log(f), 1.0 - f

    q_l, f_l, v_l, g_l = prep(u)
    q_c, f_c, v_c, g_c = prep(u_ctx)
    o_l, o_c = [], []
    for d in range(2):
        log_f, k = gates(f_c[d])
        s0 = jnp.zeros((u_ctx.shape[0], HGRN_HEADS, HGRN_HD, HGRN_HD), jnp.float32)
        oc, s_c = gla_chunk_scan(flip(q_c, d), flip(k, d), flip(v_c, d), flip(log_f, d), s0)
        log_f, k = gates(f_l[d])
        ol, _ = gla_chunk_scan(flip(q_l, d), flip(k, d), flip(v_l, d), flip(log_f, d), s_c)
        o_l.append(flip(ol, d))
        o_c.append(flip(oc, d))

    def out(o, g):
        o = rmsnorm(o, norm_w.reshape(HGRN_HEADS, HGRN_HD)).reshape(o.shape[0], o.shape[1], GROUP_W)
        return (o * jax.nn.silu(g.astype(jnp.float32))).astype(u.dtype)

    y_l = out(o_l[0] + o_l[1], g_l)
    y_c = out(o_c[0] + o_c[1], g_c) if need_ctx else None
    return y_l, y_c


def ssd_chunk_scan(xs, bm, cm, dt, log_a, s0):
    f32 = jnp.float32
    mask = jnp.tril(jnp.ones((SSD_CHUNK, SSD_CHUNK), bool))[None, :, :, None]

    def step(s, blk):
        xc, bc, cc, dtc, lac = blk
        cum = jnp.cumsum(lac, axis=1)
        seg = cum[:, :, None, :] - cum[:, None, :, :]
        decay = masked_decay(seg, mask)
        scores = jnp.einsum('bthn,bshn->btsh', cc, bc) * decay
        y = jnp.einsum('btsh,bsh,bshp->bthp', scores, dtc, xc)
        y = y + jnp.einsum('bthn,bhpn->bthp', cc, s) * jnp.exp(cum)[..., None]
        w_end = dtc * jnp.exp(cum[:, -1:, :] - cum)
        s_new = s * jnp.exp(cum[:, -1])[:, :, None, None] + jnp.einsum('bshn,bsh,bshp->bhpn', bc, w_end, xc)
        return s_new, y

    blks = tuple(to_chunks(t.astype(f32), SSD_CHUNK) for t in (xs, bm, cm, dt, log_a))
    s_fin, ys = lax.scan(step, s0.astype(f32), blks)
    return from_chunks(ys), s_fin


def ssd_mixer(u, u_ctx, conv_w, conv_b, a_log, dt_bias, d_skip, norm_w, need_ctx):
    rep = SSD_HEADS // SSD_BC_GROUPS

    def prep(v):
        bn, nn = v.shape[:2]
        z, xbc, dt_raw = jnp.split(v, [GROUP_W, GROUP_W + SSD_XBC], axis=-1)
        xbc = jax.nn.silu(dwconv(xbc, conv_w, conv_b))
        xs, bm, cm = jnp.split(xbc, [GROUP_W, GROUP_W + SSD_BC_GROUPS * SSD_STATE], axis=-1)
        xs = xs.reshape(bn, nn, SSD_HEADS, SSD_HD)
        bm = jnp.repeat(bm.reshape(bn, nn, SSD_BC_GROUPS, SSD_STATE), rep, axis=2)
        cm = jnp.repeat(cm.reshape(bn, nn, SSD_BC_GROUPS, SSD_STATE), rep, axis=2)
        return z, xs, bm, cm, dt_raw.reshape(bn, nn, 2, SSD_HEADS)

    z_l, x_l, b_l, c_l, dt_l = prep(u)
    z_c, x_c, b_c, c_c, dt_c = prep(u_ctx)
    y_l, y_c = [], []
    for d in range(2):
        a = -jnp.exp(a_log[d].astype(jnp.float32))
        dt = jax.nn.softplus(dt_c[:, :, d].astype(jnp.float32) + dt_bias[d])
        s0 = jnp.zeros((u_ctx.shape[0], SSD_HEADS, SSD_HD, SSD_STATE), jnp.float32)
        yc, s_c = ssd_chunk_scan(flip(x_c, d), flip(b_c, d), flip(c_c, d), flip(dt, d), flip(dt * a, d), s0)
        dt = jax.nn.softplus(dt_l[:, :, d].astype(jnp.float32) + dt_bias[d])
        yl, _ = ssd_chunk_scan(flip(x_l, d), flip(b_l, d), flip(c_l, d), flip(dt, d), flip(dt * a, d), s_c)
        y_l.append(flip(yl, d))
        y_c.append(flip(yc, d))

    def out(y, xs, z):
        y = (y + d_skip[:, None] * xs).reshape(y.shape[0], y.shape[1], GROUP_W)
        return rmsnorm(y * jax.nn.silu(z.astype(jnp.float32)), norm_w).astype(u.dtype)

    out_l = out(y_l[0] + y_l[1], x_l, z_l)
    out_c = out(y_c[0] + y_c[1], x_c, z_c) if need_ctx else None
    return out_l, out_c


def axial_rope_tables(n_tokens):
    rows = n_tokens // GRID_W
    row = jnp.repeat(jnp.arange(rows, dtype=jnp.float32), GRID_W)
    col = jnp.tile(jnp.arange(GRID_W, dtype=jnp.float32), rows)
    half = MLA_ROPE // 2
    inv = ROPE_BASE ** (-jnp.arange(0, half, 2, dtype=jnp.float32) / half)
    ang = jnp.concatenate([row[:, None] * inv, col[:, None] * inv], axis=-1)
    return jnp.cos(ang), jnp.sin(ang)


def apply_rope(t, cos, sin):
    t1, t2 = t[..., 0::2], t[..., 1::2]
    cos = cos[:, None, :]
    sin = sin[:, None, :]
    return jnp.stack([t1 * cos - t2 * sin, t1 * sin + t2 * cos], axis=-1).reshape(t.shape)


def block_attention(q, k, v):
    scale = q.shape[-1] ** -0.5

    def one_block(qi):
        s = jnp.einsum('bqhd,bkhd->bhqk', qi, k).astype(jnp.float32) * scale
        p = jax.nn.softmax(s, axis=-1).astype(v.dtype)
        return jnp.einsum('bhqk,bkhd->bqhd', p, v)

    return from_chunks(lax.map(one_block, to_chunks(q, Q_BLOCK)))


def mla_mixer(u, u_ctx, cos, sin, q_a_norm, w_q_up, kv_a_norm, w_kv_up, q_norm, k_norm, need_ctx):
    def project(v, rotary):
        bn, nn = v.shape[:2]
        cq, ckv, kr = jnp.split(v, [MLA_Q_RANK, MLA_Q_RANK + MLA_KV_RANK], axis=-1)
        q = (rmsnorm(cq, q_a_norm) @ w_q_up).reshape(bn, nn, MLA_HEADS, MLA_NOPE + MLA_ROPE)
        kv = (rmsnorm(ckv, kv_a_norm) @ w_kv_up).reshape(bn, nn, MLA_HEADS, MLA_NOPE + MLA_V)
        q_nope = rmsnorm(q[..., :MLA_NOPE], q_norm[:MLA_NOPE])
        q_rope = rmsnorm(q[..., MLA_NOPE:], q_norm[MLA_NOPE:])
        k_nope = rmsnorm(kv[..., :MLA_NOPE], k_norm[:MLA_NOPE])
        k_rope = rmsnorm(kr, k_norm[MLA_NOPE:])[:, :, None, :]
        if rotary:
            q_rope = apply_rope(q_rope, cos, sin)
            k_rope = apply_rope(k_rope, cos, sin)
        k = jnp.concatenate([k_nope, jnp.broadcast_to(k_rope, k_nope.shape[:-1] + (MLA_ROPE,))], axis=-1)
        q = jnp.concatenate([q_nope, q_rope], axis=-1)
        return q, k, kv[..., MLA_NOPE:]

    q_l, k_l, v_l = project(u, True)
    q_c, k_c, v_c = project(u_ctx, False)
    k_all = jnp.concatenate([k_c, k_l], axis=1)
    v_all = jnp.concatenate([v_c, v_l], axis=1)
    o_l = block_attention(q_l, k_all, v_all)
    y_l = o_l.reshape(o_l.shape[0], o_l.shape[1], GROUP_W)
    if need_ctx:
        o_c = block_attention(q_c, k_c, v_c)
        return y_l, o_c.reshape(o_c.shape[0], o_c.shape[1], GROUP_W)
    return y_l, None


def expert_choice_ffn(h, w_router, w_gate, w_up, w_down):
    n, dm = h.shape[1], h.shape[2]
    cap = EC_FACTOR * n // N_EXPERTS
    aff = jax.nn.softmax(jnp.einsum('bnd,de->bne', h, w_router).astype(jnp.float32), axis=-1)
    g, idx = lax.top_k(aff.swapaxes(1, 2), cap)
    xs = jax.vmap(lambda hb, ib: hb[ib])(h, idx)
    act = jax.nn.silu(jnp.einsum('becd,edf->becf', xs, w_gate)) * jnp.einsum('becd,edf->becf', xs, w_up)
    ys = jnp.einsum('becf,efd->becd', act, w_down) * g[..., None].astype(h.dtype)

    def combine(ib, yb):
        return jnp.zeros((n, dm), yb.dtype).at[ib.reshape(-1)].add(yb.reshape(-1, dm))

    return jax.vmap(combine)(idx, ys)


def setup_inputs(seed: int = 0) -> dict:
    key = jax.random.key(seed)
    keys = iter(jax.random.split(key, 48))
    f32 = jnp.float32
    L = DEPTH

    def normal(shape, scale):
        return jax.random.normal(next(keys), shape, f32) * scale

    def gain(shape):
        return 1.0 + normal(shape, 0.02)

    a0 = jax.random.uniform(next(keys), (L, 2, GROUP_W), f32, 0.9, 0.999)
    dt0 = jnp.exp(jax.random.uniform(next(keys), (L, 2, SSD_HEADS), f32, math.log(1e-3), math.log(1e-1)))
    a_init = jax.random.uniform(next(keys), (L, 2, SSD_HEADS), f32, 1.0, 16.0)
    return {
        'x': normal((BATCH, SEQ, D_MODEL), 1.0),
        'c': normal((BATCH, D_MODEL), 1.0),
        'ctx': normal((BATCH, CTX_LEN, D_MODEL), 1.0),
        'c_ctx': normal((D_MODEL,), 1.0),
        'ada_w': normal((L, D_MODEL, N_MOD * D_MODEL), 0.5 * D_MODEL ** -0.5),
        'ada_b': normal((L, N_MOD * D_MODEL), 0.02),
        'norm1_w': gain((L, D_MODEL)),
        'norm2_w': gain((L, D_MODEL)),
        'w_in': normal((L, D_MODEL, IN_COLS), D_MODEL ** -0.5),
        'w_out': normal((L, D_MIX, D_MODEL), D_MIX ** -0.5),
        'lru_conv_w': normal((L, CONV_W, GROUP_W), CONV_W ** -0.5),
        'lru_conv_b': normal((L, GROUP_W), 0.02),
        'lru_w_r': normal((L, 2, LRU_HEADS, LRU_HD, LRU_HD), LRU_HD ** -0.5),
        'lru_b_r': normal((L, 2, GROUP_W), 0.02),
        'lru_w_i': normal((L, 2, LRU_HEADS, LRU_HD, LRU_HD), LRU_HD ** -0.5),
        'lru_b_i': normal((L, 2, GROUP_W), 0.02),
        'lru_lam': jnp.log(a0) - jnp.log1p(-a0),
        'hgrn_lb_logits': normal((L, GROUP_W), 0.5),
        'hgrn_norm_w': gain((L, GROUP_W)),
        'ssd_conv_w': normal((L, CONV_W, SSD_XBC), CONV_W ** -0.5),
        'ssd_conv_b': normal((L, SSD_XBC), 0.02),
        'ssd_a_log': jnp.log(a_init),
        'ssd_dt_bias': dt0 + jnp.log(-jnp.expm1(-dt0)),
        'ssd_d_skip': gain((L, SSD_HEADS)),
        'ssd_norm_w': gain((L, GROUP_W)),
        'mla_q_a_norm': gain((L, MLA_Q_RANK)),
        'mla_w_q_up': normal((L, MLA_Q_RANK, MLA_HEADS * (MLA_NOPE + MLA_ROPE)), MLA_Q_RANK ** -0.5),
        'mla_kv_a_norm': gain((L, MLA_KV_RANK)),
        'mla_w_kv_up': normal((L, MLA_KV_RANK, MLA_HEADS * (MLA_NOPE + MLA_V)), MLA_KV_RANK ** -0.5),
        'mla_q_norm': gain((L, MLA_NOPE + MLA_ROPE)),
        'mla_k_norm': gain((L, MLA_NOPE + MLA_ROPE)),
        'moe_router': normal((L, D_MODEL, N_EXPERTS), D_MODEL ** -0.5),
        'moe_w_gate': normal((L, N_EXPERTS, D_MODEL, EXPERT_FF), D_MODEL ** -0.5),
        'moe_w_up': normal((L, N_EXPERTS, D_MODEL, EXPERT_FF), D_MODEL ** -0.5),
        'moe_w_down': normal((L, N_EXPERTS, EXPERT_FF, D_MODEL), EXPERT_FF ** -0.5),
    }


def reference(x, c, ctx, c_ctx, ada_w, ada_b, norm1_w, norm2_w, w_in, w_out,
              lru_conv_w, lru_conv_b, lru_w_r, lru_b_r, lru_w_i, lru_b_i, lru_lam,
              hgrn_lb_logits, hgrn_norm_w,
              ssd_conv_w, ssd_conv_b, ssd_a_log, ssd_dt_bias, ssd_d_skip, ssd_norm_w,
              mla_q_a_norm, mla_w_q_up, mla_kv_a_norm, mla_w_kv_up, mla_q_norm, mla_k_norm,
              moe_router, moe_w_gate, moe_w_up, moe_w_down):
    cos, sin = axial_rope_tables(x.shape[1])
    lb_w = jax.nn.softmax(hgrn_lb_logits.astype(jnp.float32), axis=0)
    lb_all = jnp.cumsum(lb_w, axis=0) - lb_w[0]
    s_c = jax.nn.silu(c)
    s_cc = jax.nn.silu(c_ctx)
    for l in range(DEPTH):
        need_ctx = l < DEPTH - 1
        mod_l = jnp.split((s_c @ ada_w[l] + ada_b[l])[:, None, :], N_MOD, axis=-1)
        mod_c = jnp.split((s_cc @ ada_w[l] + ada_b[l])[None, None, :], N_MOD, axis=-1)
        h = modulate(rmsnorm(x, norm1_w[l]), mod_l[0], mod_l[1])
        hc = modulate(rmsnorm(ctx, norm1_w[l]), mod_c[0], mod_c[1])
        u_a, u_b, u_s, u_m = jnp.split(h @ w_in[l], SPLITS, axis=-1)
        c_a, c_b, c_s, c_m = jnp.split(hc @ w_in[l], SPLITS, axis=-1)
        ya, yca = rglru_mixer(u_a, c_a, lru_conv_w[l], lru_conv_b[l], lru_w_r[l], lru_b_r[l],
                              lru_w_i[l], lru_b_i[l], lru_lam[l], need_ctx)
        yb, ycb = hgrn2_mixer(u_b, c_b, lb_all[l], hgrn_norm_w[l], need_ctx)
        ys, ycs = ssd_mixer(u_s, c_s, ssd_conv_w[l], ssd_conv_b[l], ssd_a_log[l], ssd_dt_bias[l],
                            ssd_d_skip[l], ssd_norm_w[l], need_ctx)
        ym, ycm = mla_mixer(u_m, c_m, cos, sin, mla_q_a_norm[l], mla_w_q_up[l], mla_kv_a_norm[l],
                            mla_w_kv_up[l], mla_q_norm[l], mla_k_norm[l], need_ctx)
        x = x + mod_l[2] * (jnp.concatenate([ya, yb, ys, ym], axis=-1) @ w_out[l])
        h = modulate(rmsnorm(x, norm2_w[l]), mod_l[3], mod_l[4])
        x = x + mod_l[5] * expert_choice_ffn(h, moe_router[l], moe_w_gate[l], moe_w_up[l], moe_w_down[l])
        if need_ctx:
            ctx = ctx + mod_c[2] * (jnp.concatenate([yca, ycb, ycs, ycm], axis=-1) @ w_out[l])
            hc = modulate(rmsnorm(ctx, norm2_w[l]), mod_c[3], mod_c[4])
            ctx = ctx + mod_c[5] * expert_choice_ffn(hc, moe_router[l], moe_w_gate[l], moe_w_up[l], moe_w_down[l])
    return x
```

```cpp
#include <hip/hip_runtime.h>
#include <hip/hip_cooperative_groups.h>
#include <cstdio>
#include <cstdint>
namespace cg = cooperative_groups;

#ifndef MEGA
#define MEGA 0
#endif

typedef unsigned short bf16_t;
typedef short bf16x8 __attribute__((ext_vector_type(8)));
typedef float f32x4 __attribute__((ext_vector_type(4)));

#define NB 16
#define SEQ 2048
#define CTXL 256
#define DM 1024
#define NLAT (NB * SEQ)
#define NCTX (NB * CTXL)
#define NTOK (NLAT + NCTX)
#define INC 2920
#define INP 2944
#define NEXP 16
#define FF 512
#define CAPL 256
#define CAPC 32
#define SLOTS_L (NB * CAPL)
#define SLOTS_C (NB * CAPC)
#define SLOTS (SLOTS_L + SLOTS_C)
#define NKEY (CTXL + SEQ)
#define EPSF 1e-6f

enum { I_X = 0, I_C, I_CTX, I_CCTX, I_ADAW, I_ADAB, I_N1W, I_N2W, I_WIN, I_WOUT, I_LCW, I_LCB, I_LWR, I_LBR, I_LWI, I_LBI, I_LLAM,
       I_HLB, I_HNW, I_SCW, I_SCB, I_SALOG, I_SDTB, I_SDSK, I_SNW, I_MQAN, I_MWQ, I_MKVAN, I_MWKV, I_MQN, I_MKN, I_ROUT, I_WG, I_WU, I_WD, N_IN };

struct Params {
  const float* in[N_IN];
  float* out;
  char* ws;
};

constexpr size_t OFF_MOD = 0;
constexpr size_t SZ_MOD = (size_t)2 * 17 * 6144 * 4;
constexpr size_t OFF_WINT = OFF_MOD + SZ_MOD;
constexpr size_t SZ_WINT = (size_t)2 * INP * DM * 2;
constexpr size_t OFF_WOUTT = OFF_WINT + SZ_WINT;
constexpr size_t SZ_WOUTT = (size_t)2 * DM * DM * 2;
constexpr size_t OFF_WGU = OFF_WOUTT + SZ_WOUTT;
constexpr size_t SZ_WGU = (size_t)2 * NEXP * 1024 * DM * 2;
constexpr size_t OFF_WDT = OFF_WGU + SZ_WGU;
constexpr size_t SZ_WDT = (size_t)2 * NEXP * DM * FF * 2;
constexpr size_t OFF_CTXS = OFF_WDT + SZ_WDT;
constexpr size_t SZ_CTXS = (size_t)NCTX * DM * 4;
constexpr size_t OFF_ACTA = OFF_CTXS + SZ_CTXS;
constexpr size_t SZ_ACT = (size_t)NTOK * DM * 2;
constexpr size_t OFF_ACTB = OFF_ACTA + SZ_ACT;
constexpr size_t OFF_U = OFF_ACTB + SZ_ACT;
constexpr size_t SZ_U = (size_t)NTOK * INP * 2;
constexpr size_t OFF_AFF = OFF_U + SZ_U;
constexpr size_t SZ_AFF = (size_t)(NB * NEXP * SEQ + NB * NEXP * CTXL) * 4;
constexpr size_t OFF_ROWL = OFF_AFF + SZ_AFF;
constexpr size_t SZ_ROWL = (size_t)NEXP * SLOTS * 4;
constexpr size_t OFF_GATE = OFF_ROWL + SZ_ROWL;
constexpr size_t WS_END = OFF_GATE + SZ_ROWL;

constexpr size_t QB_OFF = 0;
constexpr size_t KB_OFF = (size_t)NTOK * 384 * 2;
constexpr size_t VB_OFF = KB_OFF + (size_t)NB * 4 * NKEY * 96 * 2;

extern __shared__ __attribute__((aligned(16))) char dynsmem[];
#define DYN_LDS 40960

__device__ __forceinline__ bf16_t f2bf(float f) {
  unsigned u = __float_as_uint(f);
  u += 0x7fffu + ((u >> 16) & 1u);
  return (bf16_t)(u >> 16);
}
__device__ __forceinline__ float bf2f(bf16_t h) { return __uint_as_float(((unsigned)h) << 16); }
__device__ __forceinline__ float sigmoidf_(float x) { return 1.f / (1.f + expf(-x)); }
__device__ __forceinline__ float siluf_(float x) { return x / (1.f + expf(-x)); }
__device__ __forceinline__ float softplusf_(float x) { return x > 20.f ? x : log1pf(expf(x)); }
__device__ __forceinline__ float gelu_tanh(float x) {
  float t = tanhf(0.7978845608028654f * (x + 0.044715f * x * x * x));
  return 0.5f * x * (1.f + t);
}
__device__ __forceinline__ float wave_sum(float v) {
#pragma unroll
  for (int o = 1; o < 64; o <<= 1) v += __shfl_xor(v, o);
  return v;
}
__device__ __forceinline__ const float* xrow_src(const Params& p, int srcmode, int row) {
  if (srcmode == 0) return row < NLAT ? p.in[I_X] + (size_t)row * DM : p.in[I_CTX] + (size_t)(row - NLAT) * DM;
  return row < NLAT ? p.out + (size_t)row * DM : (const float*)(p.ws + OFF_CTXS) + (size_t)(row - NLAT) * DM;
}
__device__ __forceinline__ float* xrow_dst(const Params& p, int row) {
  return row < NLAT ? p.out + (size_t)row * DM : (float*)(p.ws + OFF_CTXS) + (size_t)(row - NLAT) * DM;
}
__device__ __forceinline__ int modrow(int row) { return row < NLAT ? (row >> 11) : 16; }
__device__ __forceinline__ const float* modptr(const Params& p, int layer, int mrow, int chunk) {
  return (const float*)(p.ws + OFF_MOD) + ((size_t)(layer * 17 + mrow) * 6144 + chunk * 1024);
}

__device__ __forceinline__ void transpose_tile(const float* __restrict__ src, int N, int k0, int n0, bf16_t* __restrict__ dst, int K, int mode) {
  float* tile = (float*)dynsmem;
  const int tid = threadIdx.x;
#pragma unroll
  for (int i = 0; i < 16; ++i) {
    int idx = i * 256 + tid;
    int r = idx >> 6, c = idx & 63;
    int n = n0 + c;
    float v = (n < N) ? src[(size_t)(k0 + r) * N + n] : 0.f;
    tile[r * 65 + c] = v;
  }
  __syncthreads();
#pragma unroll
  for (int i = 0; i < 16; ++i) {
    int idx = i * 256 + tid;
    int nl = idx >> 6, kl = idx & 63;
    int n = n0 + nl;
    int nr = (mode == 0) ? n : ((n >> 4) * 32 + (mode == 2 ? 16 : 0) + (n & 15));
    dst[(size_t)nr * K + k0 + kl] = f2bf(tile[kl * 65 + nl]);
  }
  __syncthreads();
}

__device__ void mod_item(const Params& p, int j) {
  float* s = (float*)dynsmem;
  float* red = s + 17 * 256;
  const int tid = threadIdx.x;
  const int l = j / 96, cb = (j % 96) * 64;
  const int kg = tid >> 6, col = tid & 63;
  const float* cc = p.in[I_C];
  const float* cctx = p.in[I_CCTX];
  const float* aw = p.in[I_ADAW] + (size_t)l * DM * 6144;
  float acc[17];
#pragma unroll
  for (int r = 0; r < 17; ++r) acc[r] = 0.f;
  for (int kc = 0; kc < 4; ++kc) {
    __syncthreads();
    for (int idx = tid; idx < 17 * 256; idx += 256) {
      int r = idx >> 8, kk = idx & 255;
      int k = kc * 256 + kk;
      float v = (r < 16) ? cc[r * DM + k] : cctx[k];
      s[idx] = siluf_(v);
    }
    __syncthreads();
    for (int kk = 0; kk < 64; ++kk) {
      int kl = kg * 64 + kk;
      float w = aw[(size_t)(kc * 256 + kl) * 6144 + cb + col];
#pragma unroll
      for (int r = 0; r < 17; ++r) acc[r] += s[r * 256 + kl] * w;
    }
  }
#pragma unroll
  for (int r = 0; r < 17; ++r) red[(kg * 17 + r) * 64 + col] = acc[r];
  __syncthreads();
  float* mod = (float*)(p.ws + OFF_MOD);
  for (int idx = tid; idx < 17 * 64; idx += 256) {
    int r = idx >> 6, c2 = idx & 63;
    float v = red[(0 * 17 + r) * 64 + c2] + red[(1 * 17 + r) * 64 + c2] + red[(2 * 17 + r) * 64 + c2] + red[(3 * 17 + r) * 64 + c2];
    v += p.in[I_ADAB][l * 6144 + cb + c2];
    mod[(size_t)(l * 17 + r) * 6144 + cb + c2] = v;
  }
  __syncthreads();
}

__device__ void phase_prep(const Params& p, int bid, int nb) {
  constexpr int T_PER_LAYER = 736 + 256 + 16 * 384;
  constexpr int NT = 2 * T_PER_LAYER;
  for (int it = bid; it < 192 + NT; it += nb) {
    if (it < 192) { mod_item(p, it); continue; }
    int tt = it - 192;
    int l = tt / T_PER_LAYER, r = tt % T_PER_LAYER;
    if (r < 736) {
      int tk = r / 46, tn = r % 46;
      transpose_tile(p.in[I_WIN] + (size_t)l * DM * INC, INC, tk * 64, tn * 64, (bf16_t*)(p.ws + OFF_WINT) + (size_t)l * INP * DM, DM, 0);
    } else if (r < 992) {
      r -= 736;
      int tk = r / 16, tn = r % 16;
      transpose_tile(p.in[I_WOUT] + (size_t)l * DM * DM, DM, tk * 64, tn * 64, (bf16_t*)(p.ws + OFF_WOUTT) + (size_t)l * DM * DM, DM, 0);
    } else {
      r -= 992;
      int e = r / 384, rr = r % 384, sub = rr / 128, t = rr % 128;
      size_t le = (size_t)(l * NEXP + e);
      if (sub < 2) {
        int tk = t / 8, tn = t % 8;
        const float* src = (sub == 0 ? p.in[I_WG] : p.in[I_WU]) + le * DM * FF;
        transpose_tile(src, FF, tk * 64, tn * 64, (bf16_t*)(p.ws + OFF_WGU) + le * 1024 * DM, DM, sub == 0 ? 1 : 2);
      } else {
        int tk = t / 16, tn = t % 16;
        transpose_tile(p.in[I_WD] + le * FF * DM, DM, tk * 64, tn * 64, (bf16_t*)(p.ws + OFF_WDT) + le * DM * FF, FF, 0);
      }
    }
  }
}

__device__ void phase_norm(const Params& p, int layer, int which, int srcmode, int nrows, int bid, int nb) {
  const int wave = threadIdx.x >> 6, lane = threadIdx.x & 63;
  const float* nw = (which == 0 ? p.in[I_N1W] : p.in[I_N2W]) + layer * DM;
  bf16_t* dstb = (bf16_t*)(p.ws + (which == 0 ? OFF_ACTA : OFF_ACTB));
  const float* wr = p.in[I_ROUT] + (size_t)layer * DM * NEXP;
  for (int row = bid * 4 + wave; row < nrows; row += nb * 4) {
    const float4* src = (const float4*)xrow_src(p, srcmode, row);
    const int mr = modrow(row);
    const float4* sh = (const float4*)modptr(p, layer, mr, which == 0 ? 0 : 3);
    const float4* sc = (const float4*)modptr(p, layer, mr, which == 0 ? 1 : 4);
    float4 v[4];
    float ss = 0.f;
#pragma unroll
    for (int j = 0; j < 4; ++j) {
      v[j] = src[j * 64 + lane];
      ss += v[j].x * v[j].x + v[j].y * v[j].y + v[j].z * v[j].z + v[j].w * v[j].w;
    }
    ss = wave_sum(ss);
    const float rstd = rsqrtf(ss * (1.f / DM) + EPSF);
    float lg[16];
#pragma unroll
    for (int e = 0; e < 16; ++e) lg[e] = 0.f;
#pragma unroll
    for (int j = 0; j < 4; ++j) {
      float4 w4 = ((const float4*)nw)[j * 64 + lane];
      float4 s4 = sh[j * 64 + lane], c4 = sc[j * 64 + lane];
      float h0 = v[j].x * rstd * w4.x * (1.f + c4.x) + s4.x;
      float h1 = v[j].y * rstd * w4.y * (1.f + c4.y) + s4.y;
      float h2 = v[j].z * rstd * w4.z * (1.f + c4.z) + s4.z;
      float h3 = v[j].w * rstd * w4.w * (1.f + c4.w) + s4.w;
      uint2 o;
      o.x = (unsigned)f2bf(h0) | ((unsigned)f2bf(h1) << 16);
      o.y = (unsigned)f2bf(h2) | ((unsigned)f2bf(h3) << 16);
      ((uint2*)(dstb + (size_t)row * DM))[j * 64 + lane] = o;
      if (which == 1) {
        const int k = j * 256 + lane * 4;
        float hh[4] = {h0, h1, h2, h3};
#pragma unroll
        for (int i = 0; i < 4; ++i) {
          const float4* wp = (const float4*)(wr + (size_t)(k + i) * NEXP);
#pragma unroll
          for (int q = 0; q < 4; ++q) {
            float4 w = wp[q];
            lg[q * 4 + 0] += hh[i] * w.x; lg[q * 4 + 1] += hh[i] * w.y; lg[q * 4 + 2] += hh[i] * w.z; lg[q * 4 + 3] += hh[i] * w.w;
          }
        }
      }
    }
    if (which == 1) {
      float mx = -1e30f;
#pragma unroll
      for (int e = 0; e < 16; ++e) { lg[e] = wave_sum(lg[e]); mx = fmaxf(mx, lg[e]); }
      float den = 0.f, mine = 0.f;
#pragma unroll
      for (int e = 0; e < 16; ++e) { float pe = expf(lg[e] - mx); den += pe; if (lane == e) mine = pe; }
      if (lane < 16) {
        float* aff = (float*)(p.ws + OFF_AFF);
        size_t idx;
        if (row < NLAT) { int b = row >> 11, n = row & 2047; idx = ((size_t)(b * NEXP + lane)) * SEQ + n; }
        else { int rr = row - NLAT; int b = rr >> 8, n = rr & 255; idx = (size_t)NB * NEXP * SEQ + ((size_t)(b * NEXP + lane)) * CTXL + n; }
        aff[idx] = mine / den;
      }
    }
  }
}

template <int EPI>
__device__ void gemm_tile(const Params& p, int layer, int srcmode, const bf16_t* __restrict__ A, int lda, const int* __restrict__ rowl, int arow0,
                          const bf16_t* __restrict__ Bt, int ldb, int bcol0, int K, int orow0) {
  bf16_t* SA = (bf16_t*)dynsmem;
  bf16_t* SB = SA + 128 * 32;
  const int tid = threadIdx.x, wid = tid >> 6, lane = tid & 63, wr = wid >> 1, wc = wid & 1, fr = lane & 15, fq = lane >> 4;
  const bf16_t* ap[2];
  const bf16_t* bp[2];
#pragma unroll
  for (int i = 0; i < 2; ++i) {
    int b = tid * 16 + i * 4096;
    int r = b >> 6, c = (b & 63) >> 1;
    int ar = arow0 + r;
    if (rowl) ar = rowl[ar];
    ap[i] = A + (size_t)ar * lda + c;
    bp[i] = Bt + (size_t)(bcol0 + r) * ldb + c;
  }
  f32x4 acc[4][4];
#pragma unroll
  for (int m = 0; m < 4; ++m)
#pragma unroll
    for (int n = 0; n < 4; ++n) acc[m][n] = (f32x4){0.f, 0.f, 0.f, 0.f};
  const int nk = K >> 5;
  for (int kt = 0; kt < nk; ++kt) {
#pragma unroll
    for (int i = 0; i < 2; ++i) {
      int b = tid * 16 + i * 4096;
      __builtin_amdgcn_global_load_lds((const unsigned*)(ap[i] + kt * 32), (unsigned*)((char*)SA + b), 16, 0, 0);
      __builtin_amdgcn_global_load_lds((const unsigned*)(bp[i] + kt * 32), (unsigned*)((char*)SB + b), 16, 0, 0);
    }
    asm volatile("s_waitcnt vmcnt(0)" ::: "memory");
    __syncthreads();
    bf16x8 af[4], bfr[4];
#pragma unroll
    for (int m = 0; m < 4; ++m) af[m] = *reinterpret_cast<const bf16x8*>((const char*)SA + (wr * 64 + m * 16 + fr) * 64 + fq * 16);
#pragma unroll
    for (int n = 0; n < 4; ++n) bfr[n] = *reinterpret_cast<const bf16x8*>((const char*)SB + (wc * 64 + n * 16 + fr) * 64 + fq * 16);
#pragma unroll
    for (int m = 0; m < 4; ++m)
#pragma unroll
      for (int n = 0; n < 4; ++n) acc[m][n] = __builtin_amdgcn_mfma_f32_16x16x32_bf16(af[m], bfr[n], acc[m][n], 0, 0, 0);
    __syncthreads();
  }
  if (EPI == 0) {
    bf16_t* U = (bf16_t*)(p.ws + OFF_U);
#pragma unroll
    for (int m = 0; m < 4; ++m)
#pragma unroll
      for (int n = 0; n < 4; ++n)
#pragma unroll
        for (int j = 0; j < 4; ++j) {
          int row = orow0 + wr * 64 + m * 16 + fq * 4 + j, col = bcol0 + wc * 64 + n * 16 + fr;
          U[(size_t)row * INP + col] = f2bf(acc[m][n][j]);
        }
  } else if (EPI == 1) {
#pragma unroll
    for (int m = 0; m < 4; ++m)
#pragma unroll
      for (int j = 0; j < 4; ++j) {
        int row = orow0 + wr * 64 + m * 16 + fq * 4 + j;
        const float* xs = xrow_src(p, srcmode, row);
        float* xd = xrow_dst(p, row);
        const float* g2 = modptr(p, layer, modrow(row), 2);
#pragma unroll
        for (int n = 0; n < 4; ++n) {
          int col = bcol0 + wc * 64 + n * 16 + fr;
          xd[col] = xs[col] + g2[col] * acc[m][n][j];
        }
      }
  } else if (EPI == 2) {
    bf16_t* ACT = (bf16_t*)(p.ws + OFF_ACTA);
#pragma unroll
    for (int m = 0; m < 4; ++m)
#pragma unroll
      for (int j = 0; j < 4; ++j) {
        int sr = orow0 + wr * 64 + m * 16 + fq * 4 + j;
#pragma unroll
        for (int nn = 0; nn < 2; ++nn) {
          int f = (((bcol0 + wc * 64) >> 5) + nn) * 16 + fr;
          float g = acc[m][2 * nn][j], u = acc[m][2 * nn + 1][j];
          ACT[(size_t)sr * FF + f] = f2bf(siluf_(g) * u);
        }
      }
  } else {
    const int* ROWL = (const int*)(p.ws + OFF_ROWL);
    const float* GATE = (const float*)(p.ws + OFF_GATE);
#pragma unroll
    for (int m = 0; m < 4; ++m)
#pragma unroll
      for (int j = 0; j < 4; ++j) {
        int sr = orow0 + wr * 64 + m * 16 + fq * 4 + j;
        int tok = ROWL[sr];
        float gt = GATE[sr];
        float* xd = xrow_dst(p, tok);
        const float* g5 = modptr(p, layer, modrow(tok), 5);
#pragma unroll
        for (int n = 0; n < 4; ++n) {
          int col = bcol0 + wc * 64 + n * 16 + fr;
          unsafeAtomicAdd(xd + col, g5[col] * gt * acc[m][n][j]);
        }
      }
  }
}

__device__ void phase_inproj(const Params& p, int layer, int bid, int nb) {
  const bf16_t* A = (const bf16_t*)(p.ws + OFF_ACTA);
  const bf16_t* Bt = (const bf16_t*)(p.ws + OFF_WINT) + (size_t)layer * INP * DM;
  constexpr int MT = NTOK / 128, NT = INP / 128;
  for (int t = bid; t < MT * NT; t += nb) {
    int mt = t / NT, nt = t % NT;
    gemm_tile<0>(p, layer, 0, A, DM, nullptr, mt * 128, Bt, DM, nt * 128, DM, mt * 128);
  }
}
__device__ void phase_outproj(const Params& p, int layer, int bid, int nb) {
  const bf16_t* A = (const bf16_t*)(p.ws + OFF_ACTA);
  const bf16_t* Bt = (const bf16_t*)(p.ws + OFF_WOUTT) + (size_t)layer * DM * DM;
  const int MT = (layer == 0 ? NTOK : NLAT) / 128, NT = DM / 128;
  for (int t = bid; t < MT * NT; t += nb) {
    int mt = t / NT, nt = t % NT;
    gemm_tile<1>(p, layer, layer == 0 ? 0 : 1, A, DM, nullptr, mt * 128, Bt, DM, nt * 128, DM, mt * 128);
  }
}
__device__ void phase_moe1(const Params& p, int layer, int bid, int nb) {
  const bf16_t* A = (const bf16_t*)(p.ws + OFF_ACTB);
  const int* ROWL = (const int*)(p.ws + OFF_ROWL);
  const int MT = (layer == 0 ? SLOTS : SLOTS_L) / 128;
  for (int t = bid; t < NEXP * MT * 8; t += nb) {
    int e = t / (MT * 8), r = t % (MT * 8), nt = r / MT, mt = r % MT;
    const bf16_t* Bt = (const bf16_t*)(p.ws + OFF_WGU) + (size_t)(layer * NEXP + e) * 1024 * DM;
    gemm_tile<2>(p, layer, 0, A, DM, ROWL, e * SLOTS + mt * 128, Bt, DM, nt * 128, DM, e * SLOTS + mt * 128);
  }
}
__device__ void phase_moe2(const Params& p, int layer, int bid, int nb) {
  const bf16_t* A = (const bf16_t*)(p.ws + OFF_ACTA);
  const int MT = (layer == 0 ? SLOTS : SLOTS_L) / 128;
  for (int t = bid; t < NEXP * MT * 8; t += nb) {
    int e = t / (MT * 8), r = t % (MT * 8), nt = r / MT, mt = r % MT;
    const bf16_t* Bt = (const bf16_t*)(p.ws + OFF_WDT) + (size_t)(layer * NEXP + e) * DM * FF;
    gemm_tile<3>(p, layer, 0, A, FF, nullptr, e * SLOTS + mt * 128, Bt, FF, nt * 128, FF, e * SLOTS + mt * 128);
  }
}

__device__ void phase_mlaproj(const Params& p, int layer, int bid, int nb) {
  float* cq = (float*)dynsmem;
  float* ckv = cq + 192;
  float* kr = ckv + 128;
  float* qv = kr + 32;
  float* kvv = qv + 384;
  float* sc = kvv + 512;
  const int tid = threadIdx.x, wave = tid >> 6, lane = tid & 63;
  const bf16_t* U = (const bf16_t*)(p.ws + OFF_U);
  const float* qan = p.in[I_MQAN] + layer * 192;
  const float* kvan = p.in[I_MKVAN] + layer * 128;
  const float* wq = p.in[I_MWQ] + (size_t)layer * 192 * 384;
  const float* wkv = p.in[I_MWKV] + (size_t)layer * 128 * 512;
  const float* qn = p.in[I_MQN] + layer * 96;
  const float* kn = p.in[I_MKN] + layer * 96;
  bf16_t* QB = (bf16_t*)(p.ws + OFF_ACTB + QB_OFF);
  bf16_t* KB = (bf16_t*)(p.ws + OFF_ACTB + KB_OFF);
  bf16_t* VB = (bf16_t*)(p.ws + OFF_ACTB + VB_OFF);
  for (int row = bid; row < NTOK; row += nb) {
    const bool lat = row < NLAT;
    const int b = lat ? (row >> 11) : ((row - NLAT) >> 8);
    const int n = lat ? (row & 2047) : ((row - NLAT) & 255);
    const int key = lat ? (CTXL + n) : n;
    const bf16_t* ur = U + (size_t)row * INP + 2568;
    __syncthreads();
    if (tid < 192) cq[tid] = bf2f(ur[tid]);
    if (tid < 128) ckv[tid] = bf2f(ur[192 + tid]);
    if (tid < 32) kr[tid] = bf2f(ur[320 + tid]);
    __syncthreads();
    if (wave == 0) {
      float s = cq[lane] * cq[lane] + cq[64 + lane] * cq[64 + lane] + cq[128 + lane] * cq[128 + lane];
      s = wave_sum(s);
      if (lane == 0) sc[0] = rsqrtf(s * (1.f / 192.f) + EPSF);
    } else if (wave == 1) {
      float s = ckv[lane] * ckv[lane] + ckv[64 + lane] * ckv[64 + lane];
      s = wave_sum(s);
      if (lane == 0) sc[1] = rsqrtf(s * (1.f / 128.f) + EPSF);
    } else if (wave == 2) {
      float s = lane < 32 ? kr[lane] * kr[lane] : 0.f;
      s = wave_sum(s);
      if (lane == 0) sc[2] = rsqrtf(s * (1.f / 32.f) + EPSF);
    }
    __syncthreads();
    if (tid < 192) cq[tid] = cq[tid] * sc[0] * qan[tid];
    if (tid < 128) ckv[tid] = ckv[tid] * sc[1] * kvan[tid];
    __syncthreads();
    {
      float a0 = 0.f, a1 = 0.f;
      for (int k = 0; k < 192; ++k) {
        float x = cq[k];
        a0 += x * wq[k * 384 + tid];
        if (tid < 128) a1 += x * wq[k * 384 + 256 + tid];
      }
      qv[tid] = a0;
      if (tid < 128) qv[256 + tid] = a1;
      float b0 = 0.f, b1 = 0.f;
      for (int k = 0; k < 128; ++k) {
        float x = ckv[k];
        b0 += x * wkv[k * 512 + tid];
        b1 += x * wkv[k * 512 + 256 + tid];
      }
      kvv[tid] = b0;
      kvv[256 + tid] = b1;
    }
    __syncthreads();
    {
      const int h = wave;
      const int pi = (lane & 31) >> 1;
      const float inv = powf(10000.f, -(float)(pi & 7) / 8.f);
      const float pos = (pi < 8) ? (float)(n >> 6) : (float)(n & 63);
      const float ang = pos * inv;
      const float cs = cosf(ang), sn = sinf(ang);
      float x = qv[h * 96 + lane];
      float s = wave_sum(x * x);
      float qn_v = x * rsqrtf(s * (1.f / 64.f) + EPSF) * qn[lane];
      float xr = lane < 32 ? qv[h * 96 + 64 + lane] : 0.f;
      float s2 = wave_sum(xr * xr);
      float qr_v = lane < 32 ? xr * rsqrtf(s2 * (1.f / 32.f) + EPSF) * qn[64 + lane] : 0.f;
      float y = kvv[h * 128 + lane];
      float s3 = wave_sum(y * y);
      float kn_v = y * rsqrtf(s3 * (1.f / 64.f) + EPSF) * kn[lane];
      float kk = lane < 32 ? kr[lane] * sc[2] * kn[64 + lane] : 0.f;
      if (lat) {
        float qo = __shfl_xor(qr_v, 1), ko = __shfl_xor(kk, 1);
        if (lane & 1) { qr_v = qo * sn + qr_v * cs; kk = ko * sn + kk * cs; }
        else { qr_v = qr_v * cs - qo * sn; kk = kk * cs - ko * sn; }
      }
      const float qscale = 0.10206207261596577f;
      bf16_t* qd = QB + ((size_t)row * 4 + h) * 96;
      bf16_t* kd = KB + (((size_t)(b * 4 + h)) * NKEY + key) * 96;
      bf16_t* vd = VB + (((size_t)(b * 4 + h)) * NKEY + key) * 64;
      qd[lane] = f2bf(qn_v * qscale);
      kd[lane] = f2bf(kn_v);
      if (lane < 32) { qd[64 + lane] = f2bf(qr_v * qscale); kd[64 + lane] = f2bf(kk); }
      vd[lane] = f2bf(kvv[h * 128 + 64 + lane]);
    }
  }
}

__device__ void chain_lru(const Params& p, int L, int b) {
  float* xs = (float*)dynsmem;
  const int tid = threadIdx.x, h = tid >> 6, lane = tid & 63, ch = h * 64 + lane;
  const bf16_t* U = (const bf16_t*)(p.ws + OFF_U);
  bf16_t* Y = (bf16_t*)(p.ws + OFF_ACTA);
  float cw[4];
#pragma unroll
  for (int j = 0; j < 4; ++j) cw[j] = p.in[I_LCW][(L * 4 + j) * 256 + ch];
  const float cb = p.in[I_LCB][L * 256 + ch];
  for (int d = 0; d < 2; ++d) {
    float wrc[64], wic[64];
    const float* wr = p.in[I_LWR] + (size_t)((L * 2 + d) * 4 + h) * 4096;
    const float* wi = p.in[I_LWI] + (size_t)((L * 2 + d) * 4 + h) * 4096;
#pragma unroll
    for (int k = 0; k < 64; ++k) { wrc[k] = wr[k * 64 + lane]; wic[k] = wi[k * 64 + lane]; }
    const float br = p.in[I_LBR][(L * 2 + d) * 256 + ch], bi = p.in[I_LBI][(L * 2 + d) * 256 + ch];
    const float lam = p.in[I_LLAM][(L * 2 + d) * 256 + ch];
    const float sp = softplusf_(-lam);
    float hst = 0.f;
    for (int seg = 0; seg < 2; ++seg) {
      const int seglen = seg == 0 ? CTXL : SEQ;
      const int rowbase = seg == 0 ? NLAT + b * CTXL : b * SEQ;
      const bool wout = !(L == 1 && seg == 0);
      for (int i = 0; i < seglen; ++i) {
        const int t = d ? seglen - 1 - i : i;
        float xc = cb;
#pragma unroll
        for (int j = 0; j < 4; ++j) {
          int tt = t + j - 2;
          if (tt >= 0 && tt < seglen) xc += bf2f(U[(size_t)(rowbase + tt) * INP + ch]) * cw[j];
        }
        __syncthreads();
        xs[tid] = xc;
        __syncthreads();
        float r = br, ii = bi;
#pragma unroll
        for (int k = 0; k < 64; ++k) { float xv = xs[h * 64 + k]; r += xv * wrc[k]; ii += xv * wic[k]; }
        r = sigmoidf_(r); ii = sigmoidf_(ii);
        float log_a = -8.f * r * sp;
        float a = expf(log_a);
        float bb = sqrtf(-expm1f(2.f * log_a)) * (ii * xc);
        hst = a * hst + bb;
        if (wout) {
          const size_t row = (size_t)(rowbase + t);
          if (d == 0) Y[row * DM + ch] = f2bf(hst);
          else {
            float tot = bf2f(Y[row * DM + ch]) + hst;
            float gate = bf2f(U[row * INP + 256 + ch]);
            Y[row * DM + ch] = f2bf(tot * gelu_tanh(gate));
          }
        }
      }
    }
  }
}

__device__ void chain_hgrn(const Params& p, int L, int b) {
  float* lq = (float*)dynsmem;
  float* lf = lq + 256;
  const int tid = threadIdx.x, h = tid >> 6, lane = tid & 63, ch = h * 64 + lane;
  const bf16_t* U = (const bf16_t*)(p.ws + OFF_U);
  bf16_t* Y = (bf16_t*)(p.ws + OFF_ACTA);
  float lb = 0.f;
  if (L == 1) lb = sigmoidf_(p.in[I_HLB][256 + ch] - p.in[I_HLB][ch]);
  const float nwv = p.in[I_HNW][L * 256 + ch];
  for (int d = 0; d < 2; ++d) {
    float S[64];
#pragma unroll
    for (int k = 0; k < 64; ++k) S[k] = 0.f;
    for (int seg = 0; seg < 2; ++seg) {
      const int seglen = seg == 0 ? CTXL : SEQ;
      const int rowbase = seg == 0 ? NLAT + b * CTXL : b * SEQ;
      const bool wout = !(L == 1 && seg == 0);
      for (int i = 0; i < seglen; ++i) {
        const int t = d ? seglen - 1 - i : i;
        const size_t row = (size_t)(rowbase + t);
        const bf16_t* ur = U + row * INP;
        float qv = siluf_(bf2f(ur[512 + ch]));
        float f = lb + (1.f - lb) * sigmoidf_(bf2f(ur[768 + d * 256 + ch]));
        float vv = bf2f(ur[1280 + ch]);
        __syncthreads();
        lq[tid] = qv; lf[tid] = f;
        __syncthreads();
        float o = 0.f;
#pragma unroll
        for (int k = 0; k < 64; ++k) {
          float fk = lf[h * 64 + k];
          S[k] = fk * S[k] + (1.f - fk) * vv;
          o += lq[h * 64 + k] * S[k];
        }
        if (wout) {
          if (d == 0) Y[row * DM + 256 + ch] = f2bf(o);
          else {
            float tot = bf2f(Y[row * DM + 256 + ch]) + o;
            float ss = wave_sum(tot * tot);
            float rn = rsqrtf(ss * (1.f / 64.f) + EPSF);
            float g = bf2f(ur[1536 + ch]);
            Y[row * DM + 256 + ch] = f2bf(tot * rn * nwv * siluf_(g));
          }
        }
      }
    }
  }
}

__device__ void chain_ssd(const Params& p, int L, int b) {
  float* lB = (float*)dynsmem;
  float* lC = lB + 256;
  const int tid = threadIdx.x, h = tid >> 6, lane = tid & 63, g = h >> 1;
  const bf16_t* U = (const bf16_t*)(p.ws + OFF_U);
  bf16_t* Y = (bf16_t*)(p.ws + OFF_ACTA);
  const int c_x = h * 64 + lane, c_b = 256 + g * 64 + lane, c_c = 384 + g * 64 + lane;
  float wx[4], wb[4], wcc[4];
#pragma unroll
  for (int j = 0; j < 4; ++j) {
    wx[j] = p.in[I_SCW][(L * 4 + j) * 512 + c_x];
    wb[j] = p.in[I_SCW][(L * 4 + j) * 512 + c_b];
    wcc[j] = p.in[I_SCW][(L * 4 + j) * 512 + c_c];
  }
  const float bx = p.in[I_SCB][L * 512 + c_x], bbv = p.in[I_SCB][L * 512 + c_b], bc = p.in[I_SCB][L * 512 + c_c];
  const float dsk = p.in[I_SDSK][L * 4 + h];
  for (int d = 0; d < 2; ++d) {
    const float Aa = -expf(p.in[I_SALOG][(L * 2 + d) * 4 + h]);
    const float dtb = p.in[I_SDTB][(L * 2 + d) * 4 + h];
    float S[64];
#pragma unroll
    for (int k = 0; k < 64; ++k) S[k] = 0.f;
    for (int seg = 0; seg < 2; ++seg) {
      const int seglen = seg == 0 ? CTXL : SEQ;
      const int rowbase = seg == 0 ? NLAT + b * CTXL : b * SEQ;
      const bool wout = !(L == 1 && seg == 0);
      for (int i = 0; i < seglen; ++i) {
        const int t = d ? seglen - 1 - i : i;
        const size_t row = (size_t)(rowbase + t);
        float xv = bx, Bv = bbv, Cv = bc;
#pragma unroll
        for (int j = 0; j < 4; ++j) {
          int tt = t + j - 2;
          if (tt >= 0 && tt < seglen) {
            const bf16_t* ur = U + (size_t)(rowbase + tt) * INP + 2048;
            xv += bf2f(ur[c_x]) * wx[j];
            Bv += bf2f(ur[c_b]) * wb[j];
            Cv += bf2f(ur[c_c]) * wcc[j];
          }
        }
        xv = siluf_(xv); Bv = siluf_(Bv); Cv = siluf_(Cv);
        const bf16_t* ur0 = U + row * INP;
        float dt = softplusf_(bf2f(ur0[2560 + d * 4 + h]) + dtb);
        float dec = expf(dt * Aa);
        __syncthreads();
        lB[tid] = Bv; lC[tid] = Cv;
        __syncthreads();
        float y = 0.f;
        const float dx = dt * xv;
#pragma unroll
        for (int k = 0; k < 64; ++k) {
          S[k] = dec * S[k] + dx * lB[h * 64 + k];
          y += lC[h * 64 + k] * S[k];
        }
        if (wout) {
          const size_t yi = row * DM + 512 + h * 64 + lane;
          if (d == 0) Y[yi] = f2bf(y);
          else {
            float tot = bf2f(Y[yi]) + y + dsk * xv;
            float z = bf2f(ur0[1792 + h * 64 + lane]);
            Y[yi] = f2bf(tot * siluf_(z));
          }
        }
      }
    }
  }
}

__device__ void attn_item(const Params& p, int L, int item) {
  bf16_t* Kt = (bf16_t*)dynsmem;
  bf16_t* Vt = Kt + 64 * 96;
  const int tid = threadIdx.x;
  int b, h, rowq, nkeys;
  if (item < 512) { int bh = item >> 3, qb = item & 7; b = bh >> 2; h = bh & 3; rowq = b * SEQ + qb * 256 + tid; nkeys = NKEY; }
  else { int bh = item - 512; b = bh >> 2; h = bh & 3; rowq = NLAT + b * CTXL + tid; nkeys = CTXL; }
  const bf16_t* QB = (const bf16_t*)(p.ws + OFF_ACTB + QB_OFF);
  const bf16_t* KB = (const bf16_t*)(p.ws + OFF_ACTB + KB_OFF) + ((size_t)(b * 4 + h)) * NKEY * 96;
  const bf16_t* VB = (const bf16_t*)(p.ws + OFF_ACTB + VB_OFF) + ((size_t)(b * 4 + h)) * NKEY * 64;
  bf16_t* Y = (bf16_t*)(p.ws + OFF_ACTA);
  float q[96];
  {
    const uint4* qp = (const uint4*)(QB + ((size_t)rowq * 4 + h) * 96);
#pragma unroll
    for (int i = 0; i < 12; ++i) {
      uint4 v = qp[i];
      unsigned w[4] = {v.x, v.y, v.z, v.w};
#pragma unroll
      for (int j = 0; j < 4; ++j) { q[i * 8 + j * 2] = __uint_as_float(w[j] << 16); q[i * 8 + j * 2 + 1] = __uint_as_float(w[j] & 0xffff0000u); }
    }
  }
  float o[64];
#pragma unroll
  for (int i = 0; i < 64; ++i) o[i] = 0.f;
  float m = -1e30f, l = 0.f;
  for (int k0 = 0; k0 < nkeys; k0 += 64) {
    __syncthreads();
    {
      const uint4* ks = (const uint4*)(KB + (size_t)k0 * 96);
      uint4* kd = (uint4*)Kt;
      for (int i = tid; i < 64 * 96 * 2 / 16; i += 256) kd[i] = ks[i];
      const uint4* vs = (const uint4*)(VB + (size_t)k0 * 64);
      uint4* vd = (uint4*)Vt;
      for (int i = tid; i < 64 * 64 * 2 / 16; i += 256) vd[i] = vs[i];
    }
    __syncthreads();
    for (int kk = 0; kk < 64; ++kk) {
      const uint4* kr = (const uint4*)(Kt + kk * 96);
      float s = 0.f;
#pragma unroll
      for (int i = 0; i < 12; ++i) {
        uint4 v = kr[i];
        unsigned w[4] = {v.x, v.y, v.z, v.w};
#pragma unroll
        for (int j = 0; j < 4; ++j) { s += q[i * 8 + j * 2] * __uint_as_float(w[j] << 16); s += q[i * 8 + j * 2 + 1] * __uint_as_float(w[j] & 0xffff0000u); }
      }
      if (s > m) {
        float corr = expf(m - s);
        l *= corr;
#pragma unroll
        for (int i = 0; i < 64; ++i) o[i] *= corr;
        m = s;
      }
      float pe = expf(s - m);
      l += pe;
      const uint4* vr = (const uint4*)(Vt + kk * 64);
#pragma unroll
      for (int i = 0; i < 8; ++i) {
        uint4 v = vr[i];
        unsigned w[4] = {v.x, v.y, v.z, v.w};
#pragma unroll
        for (int j = 0; j < 4; ++j) { o[i * 8 + j * 2] += pe * __uint_as_float(w[j] << 16); o[i * 8 + j * 2 + 1] += pe * __uint_as_float(w[j] & 0xffff0000u); }
      }
    }
  }
  const float il = 1.f / l;
  bf16_t* yd = Y + (size_t)rowq * DM + 768 + h * 64;
#pragma unroll
  for (int i = 0; i < 64; ++i) yd[i] = f2bf(o[i] * il);
}

__device__ void phase_mix(const Params& p, int L, int bid, int nb) {
  const int nattn = (L == 0) ? 576 : 512;
  for (int it = bid; it < 48 + nattn; it += nb) {
    if (it < 16) chain_hgrn(p, L, it);
    else if (it < 32) chain_ssd(p, L, it - 16);
    else if (it < 48) chain_lru(p, L, it - 32);
    else attn_item(p, L, it - 48);
    __syncthreads();
  }
}

__device__ void phase_ssdnorm(const Params& p, int L, int bid, int nb) {
  const int wave = threadIdx.x >> 6, lane = threadIdx.x & 63;
  bf16_t* Y = (bf16_t*)(p.ws + OFF_ACTA);
  const float* nw = p.in[I_SNW] + L * 256;
  const int nrows = (L == 0) ? NTOK : NLAT;
  for (int row = bid * 4 + wave; row < nrows; row += nb * 4) {
    uint2* yp = (uint2*)(Y + (size_t)row * DM + 512) + lane;
    uint2 v = *yp;
    float a0 = __uint_as_float(v.x << 16), a1 = __uint_as_float(v.x & 0xffff0000u), a2 = __uint_as_float(v.y << 16), a3 = __uint_as_float(v.y & 0xffff0000u);
    float ss = wave_sum(a0 * a0 + a1 * a1 + a2 * a2 + a3 * a3);
    float rn = rsqrtf(ss * (1.f / 256.f) + EPSF);
    float4 w = ((const float4*)nw)[lane];
    uint2 o;
    o.x = (unsigned)f2bf(a0 * rn * w.x) | ((unsigned)f2bf(a1 * rn * w.y) << 16);
    o.y = (unsigned)f2bf(a2 * rn * w.z) | ((unsigned)f2bf(a3 * rn * w.w) << 16);
    *yp = o;
  }
}

__device__ void phase_topk(const Params& p, int L, int bid, int nb) {
  float* a = (float*)dynsmem;
  const int tid = threadIdx.x;
  const float* aff = (const float*)(p.ws + OFF_AFF);
  int* ROWL = (int*)(p.ws + OFF_ROWL);
  float* GATE = (float*)(p.ws + OFF_GATE);
  const int nitems = (L == 0) ? 512 : 256;
  for (int it = bid; it < nitems; it += nb) {
    const bool lat = it < 256;
    const int be = lat ? it : it - 256;
    const int b = be >> 4, e = be & 15;
    const int n = lat ? SEQ : CTXL, cap = lat ? CAPL : CAPC;
    const float* src = lat ? aff + (size_t)be * SEQ : aff + (size_t)NB * NEXP * SEQ + (size_t)be * CTXL;
    __syncthreads();
    for (int i = tid; i < n; i += 256) a[i] = src[i];
    __syncthreads();
    for (int i0 = 0; i0 < n; i0 += 1024) {
      float av[4]; int rk[4];
#pragma unroll
      for (int q = 0; q < 4; ++q) { int i = i0 + q * 256 + tid; av[q] = i < n ? a[i] : 0.f; rk[q] = 0; }
      for (int j = 0; j < n; ++j) {
        float aj = a[j];
#pragma unroll
        for (int q = 0; q < 4; ++q) {
          int i = i0 + q * 256 + tid;
          rk[q] += (aj > av[q] || (aj == av[q] && j < i)) ? 1 : 0;
        }
      }
#pragma unroll
      for (int q = 0; q < 4; ++q) {
        int i = i0 + q * 256 + tid;
        if (i < n && rk[q] < cap) {
          int slot = lat ? (e * SLOTS + b * CAPL + rk[q]) : (e * SLOTS + SLOTS_L + b * CAPC + rk[q]);
          ROWL[slot] = lat ? (b * SEQ + i) : (NLAT + b * CTXL + i);
          GATE[slot] = av[q];
        }
      }
    }
  }
}

enum { PH_PREP = 0, PH_NORM1, PH_INPROJ, PH_MLAPROJ, PH_MIX, PH_SSDNORM, PH_OUTPROJ, PH_NORM2, PH_TOPK, PH_MOE1, PH_MOE2 };

__device__ __forceinline__ void run_phase(const Params& p, int ph, int L, int bid, int nb) {
  switch (ph) {
    case PH_PREP: phase_prep(p, bid, nb); break;
    case PH_NORM1: phase_norm(p, L, 0, L == 0 ? 0 : 1, NTOK, bid, nb); break;
    case PH_INPROJ: phase_inproj(p, L, bid, nb); break;
    case PH_MLAPROJ: phase_mlaproj(p, L, bid, nb); break;
    case PH_MIX: phase_mix(p, L, bid, nb); break;
    case PH_SSDNORM: phase_ssdnorm(p, L, bid, nb); break;
    case PH_OUTPROJ: phase_outproj(p, L, bid, nb); break;
    case PH_NORM2: phase_norm(p, L, 1, 1, L == 0 ? NTOK : NLAT, bid, nb); break;
    case PH_TOPK: phase_topk(p, L, bid, nb); break;
    case PH_MOE1: phase_moe1(p, L, bid, nb); break;
    case PH_MOE2: phase_moe2(p, L, bid, nb); break;
  }
}

template <int PH>
__global__ void __launch_bounds__(256, 2) k_phase(Params p, int L) {
  run_phase(p, PH, L, blockIdx.x, gridDim.x);
}
__global__ void __launch_bounds__(256) k_phase_mix(Params p, int L) {
  phase_mix(p, L, blockIdx.x, gridDim.x);
}

#if MEGA
__global__ void __launch_bounds__(256, 2) k_mega(Params p) {
  cg::grid_group grid = cg::this_grid();
  const int bid = blockIdx.x, nb = gridDim.x;
  phase_prep(p, bid, nb);
  grid.sync();
  for (int L = 0; L < 2; ++L) {
    for (int ph = PH_NORM1; ph <= PH_MOE2; ++ph) {
      run_phase(p, ph, L, bid, nb);
      grid.sync();
    }
  }
}
#endif

extern "C" void kernel_launch(void* const* d_in, const int* in_sizes, int n_in, void* d_out, int out_size, void* d_ws, size_t ws_size, hipStream_t stream) {
  Params p{};
  for (int i = 0; i < N_IN; ++i) p.in[i] = (const float*)d_in[i];
  p.out = (float*)d_out;
  p.ws = (char*)d_ws;
  if (n_in != N_IN || ws_size < WS_END) { fprintf(stderr, "kernel_launch: bad args n_in=%d ws=%zu need %zu\n", n_in, ws_size, (size_t)WS_END); return; }
#if MEGA
  static int grid = 0;
  if (!grid) {
    int dev = 0, cus = 0, per_cu = 0;
    hipGetDevice(&dev);
    hipDeviceGetAttribute(&cus, hipDeviceAttributeMultiprocessorCount, dev);
    hipFuncSetAttribute((const void*)k_mega, hipFuncAttributeMaxDynamicSharedMemorySize, DYN_LDS);
    hipOccupancyMaxActiveBlocksPerMultiprocessor(&per_cu, (const void*)k_mega, 256, DYN_LDS);
    if (per_cu > 2) per_cu = 2;
    if (per_cu < 1) per_cu = 1;
    grid = cus * per_cu;
  }
  void* args[] = {&p};
  hipError_t e = hipLaunchCooperativeKernel((const void*)k_mega, dim3(grid), dim3(256), args, DYN_LDS, stream);
  if (e != hipSuccess) fprintf(stderr, "cooperative launch failed: %s (grid %d)\n", hipGetErrorString(e), grid);
#else
  const int G = 1024;
#define LAUNCH(PH, L) k_phase<PH><<<G, 256, DYN_LDS, stream>>>(p, L)
  LAUNCH(PH_PREP, 0);
  for (int L = 0; L < 2; ++L) {
    LAUNCH(PH_NORM1, L); LAUNCH(PH_INPROJ, L); LAUNCH(PH_MLAPROJ, L); k_phase_mix<<<G, 256, DYN_LDS, stream>>>(p, L); LAUNCH(PH_SSDNORM, L);
    LAUNCH(PH_OUTPROJ, L); LAUNCH(PH_NORM2, L); LAUNCH(PH_TOPK, L); LAUNCH(PH_MOE1, L); LAUNCH(PH_MOE2, L);
  }
#endif
}
```

```cpp
#include <hip/hip_runtime.h>
#include <hip/hip_cooperative_groups.h>
#include <cstdio>
#include <cstdint>
namespace cg = cooperative_groups;

#ifndef MEGA
#define MEGA 1
#endif

typedef unsigned short bf16_t;
typedef short bf16x8 __attribute__((ext_vector_type(8)));
typedef float f32x4 __attribute__((ext_vector_type(4)));

#define NB 16
#define SEQ 2048
#define CTXL 256
#define DM 1024
#define NLAT (NB * SEQ)
#define NCTX (NB * CTXL)
#define NTOK (NLAT + NCTX)
#define INC 2920
#define INP 2944
#define NEXP 16
#define FF 512
#define CAPL 256
#define CAPC 32
#define SLOTS_L (NB * CAPL)
#define SLOTS_C (NB * CAPC)
#define SLOTS (SLOTS_L + SLOTS_C)
#define NKEY (CTXL + SEQ)
#define EPSF 1e-6f

enum { I_X = 0, I_C, I_CTX, I_CCTX, I_ADAW, I_ADAB, I_N1W, I_N2W, I_WIN, I_WOUT, I_LCW, I_LCB, I_LWR, I_LBR, I_LWI, I_LBI, I_LLAM,
       I_HLB, I_HNW, I_SCW, I_SCB, I_SALOG, I_SDTB, I_SDSK, I_SNW, I_MQAN, I_MWQ, I_MKVAN, I_MWKV, I_MQN, I_MKN, I_ROUT, I_WG, I_WU, I_WD, N_IN };

struct Params {
  const float* in[N_IN];
  float* out;
  char* ws;
};

constexpr size_t OFF_MOD = 0;
constexpr size_t SZ_MOD = (size_t)2 * 17 * 6144 * 4;
constexpr size_t OFF_WINT = OFF_MOD + SZ_MOD;
constexpr size_t SZ_WINT = (size_t)2 * INP * DM * 2;
constexpr size_t OFF_WOUTT = OFF_WINT + SZ_WINT;
constexpr size_t SZ_WOUTT = (size_t)2 * DM * DM * 2;
constexpr size_t OFF_WGU = OFF_WOUTT + SZ_WOUTT;
constexpr size_t SZ_WGU = (size_t)2 * NEXP * 1024 * DM * 2;
constexpr size_t OFF_WDT = OFF_WGU + SZ_WGU;
constexpr size_t SZ_WDT = (size_t)2 * NEXP * DM * FF * 2;
constexpr size_t OFF_CTXS = OFF_WDT + SZ_WDT;
constexpr size_t SZ_CTXS = (size_t)NCTX * DM * 4;
constexpr size_t OFF_ACTA = OFF_CTXS + SZ_CTXS;
constexpr size_t SZ_ACT = (size_t)NTOK * DM * 2;
constexpr size_t OFF_ACTB = OFF_ACTA + SZ_ACT;
constexpr size_t OFF_U = OFF_ACTB + SZ_ACT;
constexpr size_t SZ_U = (size_t)NTOK * INP * 2;
constexpr size_t OFF_AFF = OFF_U + SZ_U;
constexpr size_t SZ_AFF = (size_t)(NB * NEXP * SEQ + NB * NEXP * CTXL) * 4;
constexpr size_t OFF_ROWL = OFF_AFF + SZ_AFF;
constexpr size_t SZ_ROWL = (size_t)NEXP * SLOTS * 4;
constexpr size_t OFF_GATE = OFF_ROWL + SZ_ROWL;
constexpr size_t WS_END = OFF_GATE + SZ_ROWL;

constexpr size_t QB_OFF = 0;
constexpr size_t KB_OFF = (size_t)NTOK * 384 * 2;
constexpr size_t VB_OFF = KB_OFF + (size_t)NB * 4 * NKEY * 96 * 2;

extern __shared__ __attribute__((aligned(16))) char dynsmem[];
#define DYN_LDS 135168

__device__ __forceinline__ bf16_t f2bf(float f) {
  unsigned u = __float_as_uint(f);
  u += 0x7fffu + ((u >> 16) & 1u);
  return (bf16_t)(u >> 16);
}
__device__ __forceinline__ float bf2f(bf16_t h) { return __uint_as_float(((unsigned)h) << 16); }
__device__ __forceinline__ float sigmoidf_(float x) { return 1.f / (1.f + expf(-x)); }
__device__ __forceinline__ float siluf_(float x) { return x / (1.f + expf(-x)); }
__device__ __forceinline__ float softplusf_(float x) { return x > 20.f ? x : log1pf(expf(x)); }
__device__ __forceinline__ float gelu_tanh(float x) {
  float t = tanhf(0.7978845608028654f * (x + 0.044715f * x * x * x));
  return 0.5f * x * (1.f + t);
}
__device__ __forceinline__ float wave_sum(float v) {
#pragma unroll
  for (int o = 1; o < 64; o <<= 1) v += __shfl_xor(v, o);
  return v;
}
__device__ __forceinline__ const float* xrow_src(const Params& p, int srcmode, int row) {
  if (srcmode == 0) return row < NLAT ? p.in[I_X] + (size_t)row * DM : p.in[I_CTX] + (size_t)(row - NLAT) * DM;
  return row < NLAT ? p.out + (size_t)row * DM : (const float*)(p.ws + OFF_CTXS) + (size_t)(row - NLAT) * DM;
}
__device__ __forceinline__ float* xrow_dst(const Params& p, int row) {
  return row < NLAT ? p.out + (size_t)row * DM : (float*)(p.ws + OFF_CTXS) + (size_t)(row - NLAT) * DM;
}
__device__ __forceinline__ int modrow(int row) { return row < NLAT ? (row >> 11) : 16; }
__device__ __forceinline__ const float* modptr(const Params& p, int layer, int mrow, int chunk) {
  return (const float*)(p.ws + OFF_MOD) + ((size_t)(layer * 17 + mrow) * 6144 + chunk * 1024);
}

__device__ __forceinline__ void transpose_tile(const float* __restrict__ src, int N, int k0, int n0, bf16_t* __restrict__ dst, int K, int mode) {
  float* tile = (float*)dynsmem;
  const int tid = threadIdx.x;
#pragma unroll
  for (int i = 0; i < 16; ++i) {
    int idx = i * 256 + tid;
    int r = idx >> 6, c = idx & 63;
    int n = n0 + c;
    float v = (n < N) ? src[(size_t)(k0 + r) * N + n] : 0.f;
    tile[r * 65 + c] = v;
  }
  __syncthreads();
#pragma unroll
  for (int i = 0; i < 16; ++i) {
    int idx = i * 256 + tid;
    int nl = idx >> 6, kl = idx & 63;
    int n = n0 + nl;
    int nr = (mode == 0) ? n : ((n >> 4) * 32 + (mode == 2 ? 16 : 0) + (n & 15));
    dst[(size_t)nr * K + k0 + kl] = f2bf(tile[kl * 65 + nl]);
  }
  __syncthreads();
}

__device__ void mod_item(const Params& p, int j) {
  float* s = (float*)dynsmem;
  float* red = s + 17 * 256;
  const int tid = threadIdx.x;
  const int l = j / 96, cb = (j % 96) * 64;
  const int kg = tid >> 6, col = tid & 63;
  const float* cc = p.in[I_C];
  const float* cctx = p.in[I_CCTX];
  const float* aw = p.in[I_ADAW] + (size_t)l * DM * 6144;
  float acc[17];
#pragma unroll
  for (int r = 0; r < 17; ++r) acc[r] = 0.f;
  for (int kc = 0; kc < 4; ++kc) {
    __syncthreads();
    for (int idx = tid; idx < 17 * 256; idx += 256) {
      int r = idx >> 8, kk = idx & 255;
      int k = kc * 256 + kk;
      float v = (r < 16) ? cc[r * DM + k] : cctx[k];
      s[idx] = siluf_(v);
    }
    __syncthreads();
    for (int kk = 0; kk < 64; ++kk) {
      int kl = kg * 64 + kk;
      float w = aw[(size_t)(kc * 256 + kl) * 6144 + cb + col];
#pragma unroll
      for (int r = 0; r < 17; ++r) acc[r] += s[r * 256 + kl] * w;
    }
  }
#pragma unroll
  for (int r = 0; r < 17; ++r) red[(kg * 17 + r) * 64 + col] = acc[r];
  __syncthreads();
  float* mod = (float*)(p.ws + OFF_MOD);
  for (int idx = tid; idx < 17 * 64; idx += 256) {
    int r = idx >> 6, c2 = idx & 63;
    float v = red[(0 * 17 + r) * 64 + c2] + red[(1 * 17 + r) * 64 + c2] + red[(2 * 17 + r) * 64 + c2] + red[(3 * 17 + r) * 64 + c2];
    v += p.in[I_ADAB][l * 6144 + cb + c2];
    mod[(size_t)(l * 17 + r) * 6144 + cb + c2] = v;
  }
  __syncthreads();
}

__device__ void phase_prep(const Params& p, int bid, int nb) {
  constexpr int T_PER_LAYER = 736 + 256 + 16 * 384;
  constexpr int NT = 2 * T_PER_LAYER;
  for (int it = bid; it < 192 + NT; it += nb) {
    if (it < 192) { mod_item(p, it); continue; }
    int tt = it - 192;
    int l = tt / T_PER_LAYER, r = tt % T_PER_LAYER;
    if (r < 736) {
      int tk = r / 46, tn = r % 46;
      transpose_tile(p.in[I_WIN] + (size_t)l * DM * INC, INC, tk * 64, tn * 64, (bf16_t*)(p.ws + OFF_WINT) + (size_t)l * INP * DM, DM, 0);
    } else if (r < 992) {
      r -= 736;
      int tk = r / 16, tn = r % 16;
      transpose_tile(p.in[I_WOUT] + (size_t)l * DM * DM, DM, tk * 64, tn * 64, (bf16_t*)(p.ws + OFF_WOUTT) + (size_t)l * DM * DM, DM, 0);
    } else {
      r -= 992;
      int e = r / 384, rr = r % 384, sub = rr / 128, t = rr % 128;
      size_t le = (size_t)(l * NEXP + e);
      if (sub < 2) {
        int tk = t / 8, tn = t % 8;
        const float* src = (sub == 0 ? p.in[I_WG] : p.in[I_WU]) + le * DM * FF;
        transpose_tile(src, FF, tk * 64, tn * 64, (bf16_t*)(p.ws + OFF_WGU) + le * 1024 * DM, DM, sub == 0 ? 1 : 2);
      } else {
        int tk = t / 16, tn = t % 16;
        transpose_tile(p.in[I_WD] + le * FF * DM, DM, tk * 64, tn * 64, (bf16_t*)(p.ws + OFF_WDT) + le * DM * FF, FF, 0);
      }
    }
  }
}

__device__ void phase_norm(const Params& p, int layer, int which, int srcmode, int nrows, int bid, int nb) {
  const int wave = threadIdx.x >> 6, lane = threadIdx.x & 63;
  const float* nw = (which == 0 ? p.in[I_N1W] : p.in[I_N2W]) + layer * DM;
  bf16_t* dstb = (bf16_t*)(p.ws + (which == 0 ? OFF_ACTA : OFF_ACTB));
  const float* wr = p.in[I_ROUT] + (size_t)layer * DM * NEXP;
  for (int row = bid * 4 + wave; row < nrows; row += nb * 4) {
    const float4* src = (const float4*)xrow_src(p, srcmode, row);
    const int mr = modrow(row);
    const float4* sh = (const float4*)modptr(p, layer, mr, which == 0 ? 0 : 3);
    const float4* sc = (const float4*)modptr(p, layer, mr, which == 0 ? 1 : 4);
    float4 v[4];
    float ss = 0.f;
#pragma unroll
    for (int j = 0; j < 4; ++j) {
      v[j] = src[j * 64 + lane];
      ss += v[j].x * v[j].x + v[j].y * v[j].y + v[j].z * v[j].z + v[j].w * v[j].w;
    }
    ss = wave_sum(ss);
    const float rstd = rsqrtf(ss * (1.f / DM) + EPSF);
    float lg[16];
#pragma unroll
    for (int e = 0; e < 16; ++e) lg[e] = 0.f;
#pragma unroll
    for (int j = 0; j < 4; ++j) {
      float4 w4 = ((const float4*)nw)[j * 64 + lane];
      float4 s4 = sh[j * 64 + lane], c4 = sc[j * 64 + lane];
      float h0 = v[j].x * rstd * w4.x * (1.f + c4.x) + s4.x;
      float h1 = v[j].y * rstd * w4.y * (1.f + c4.y) + s4.y;
      float h2 = v[j].z * rstd * w4.z * (1.f + c4.z) + s4.z;
      float h3 = v[j].w * rstd * w4.w * (1.f + c4.w) + s4.w;
      uint2 o;
      o.x = (unsigned)f2bf(h0) | ((unsigned)f2bf(h1) << 16);
      o.y = (unsigned)f2bf(h2) | ((unsigned)f2bf(h3) << 16);
      ((uint2*)(dstb + (size_t)row * DM))[j * 64 + lane] = o;
      if (which == 1) {
        const int k = j * 256 + lane * 4;
        float hh[4] = {h0, h1, h2, h3};
#pragma unroll
        for (int i = 0; i < 4; ++i) {
          const float4* wp = (const float4*)(wr + (size_t)(k + i) * NEXP);
#pragma unroll
          for (int q = 0; q < 4; ++q) {
            float4 w = wp[q];
            lg[q * 4 + 0] += hh[i] * w.x; lg[q * 4 + 1] += hh[i] * w.y; lg[q * 4 + 2] += hh[i] * w.z; lg[q * 4 + 3] += hh[i] * w.w;
          }
        }
      }
    }
    if (which == 1) {
      float mx = -1e30f;
#pragma unroll
      for (int e = 0; e < 16; ++e) { lg[e] = wave_sum(lg[e]); mx = fmaxf(mx, lg[e]); }
      float den = 0.f, mine = 0.f;
#pragma unroll
      for (int e = 0; e < 16; ++e) { float pe = expf(lg[e] - mx); den += pe; if (lane == e) mine = pe; }
      if (lane < 16) {
        float* aff = (float*)(p.ws + OFF_AFF);
        size_t idx;
        if (row < NLAT) { int b = row >> 11, n = row & 2047; idx = ((size_t)(b * NEXP + lane)) * SEQ + n; }
        else { int rr = row - NLAT; int b = rr >> 8, n = rr & 255; idx = (size_t)NB * NEXP * SEQ + ((size_t)(b * NEXP + lane)) * CTXL + n; }
        aff[idx] = mine / den;
      }
    }
  }
}

template <int EPI>
__device__ void gemm_tile(const Params& p, int layer, int srcmode, const bf16_t* __restrict__ A, int lda, const int* __restrict__ rowl, int arow0,
                          const bf16_t* __restrict__ Bt, int ldb, int bcol0, int K, int orow0) {
  bf16_t* SA = (bf16_t*)dynsmem;
  bf16_t* SB = SA + 128 * 32;
  const int tid = threadIdx.x, wid = tid >> 6, lane = tid & 63, wr = wid >> 1, wc = wid & 1, fr = lane & 15, fq = lane >> 4;
  const bf16_t* ap[2];
  const bf16_t* bp[2];
#pragma unroll
  for (int i = 0; i < 2; ++i) {
    int b = tid * 16 + i * 4096;
    int r = b >> 6, c = (b & 63) >> 1;
    int ar = arow0 + r;
    if (rowl) ar = rowl[ar];
    ap[i] = A + (size_t)ar * lda + c;
    bp[i] = Bt + (size_t)(bcol0 + r) * ldb + c;
  }
  f32x4 acc[4][4];
#pragma unroll
  for (int m = 0; m < 4; ++m)
#pragma unroll
    for (int n = 0; n < 4; ++n) acc[m][n] = (f32x4){0.f, 0.f, 0.f, 0.f};
  const int nk = K >> 5;
  for (int kt = 0; kt < nk; ++kt) {
#pragma unroll
    for (int i = 0; i < 2; ++i) {
      int b = tid * 16 + i * 4096;
      __builtin_amdgcn_global_load_lds((const unsigned*)(ap[i] + kt * 32), (unsigned*)((char*)SA + b), 16, 0, 0);
      __builtin_amdgcn_global_load_lds((const unsigned*)(bp[i] + kt * 32), (unsigned*)((char*)SB + b), 16, 0, 0);
    }
    asm volatile("s_waitcnt vmcnt(0)" ::: "memory");
    __syncthreads();
    bf16x8 af[4], bfr[4];
#pragma unroll
    for (int m = 0; m < 4; ++m) af[m] = *reinterpret_cast<const bf16x8*>((const char*)SA + (wr * 64 + m * 16 + fr) * 64 + fq * 16);
#pragma unroll
    for (int n = 0; n < 4; ++n) bfr[n] = *reinterpret_cast<const bf16x8*>((const char*)SB + (wc * 64 + n * 16 + fr) * 64 + fq * 16);
#pragma unroll
    for (int m = 0; m < 4; ++m)
#pragma unroll
      for (int n = 0; n < 4; ++n) acc[m][n] = __builtin_amdgcn_mfma_f32_16x16x32_bf16(af[m], bfr[n], acc[m][n], 0, 0, 0);
    __syncthreads();
  }
  if (EPI == 0) {
    bf16_t* U = (bf16_t*)(p.ws + OFF_U);
#pragma unroll
    for (int m = 0; m < 4; ++m)
#pragma unroll
      for (int n = 0; n < 4; ++n)
#pragma unroll
        for (int j = 0; j < 4; ++j) {
          int row = orow0 + wr * 64 + m * 16 + fq * 4 + j, col = bcol0 + wc * 64 + n * 16 + fr;
          U[(size_t)row * INP + col] = f2bf(acc[m][n][j]);
        }
  } else if (EPI == 1) {
#pragma unroll
    for (int m = 0; m < 4; ++m)
#pragma unroll
      for (int j = 0; j < 4; ++j) {
        int row = orow0 + wr * 64 + m * 16 + fq * 4 + j;
        const float* xs = xrow_src(p, srcmode, row);
        float* xd = xrow_dst(p, row);
        const float* g2 = modptr(p, layer, modrow(row), 2);
#pragma unroll
        for (int n = 0; n < 4; ++n) {
          int col = bcol0 + wc * 64 + n * 16 + fr;
          xd[col] = xs[col] + g2[col] * acc[m][n][j];
        }
      }
  } else if (EPI == 2) {
    bf16_t* ACT = (bf16_t*)(p.ws + OFF_ACTA);
#pragma unroll
    for (int m = 0; m < 4; ++m)
#pragma unroll
      for (int j = 0; j < 4; ++j) {
        int sr = orow0 + wr * 64 + m * 16 + fq * 4 + j;
#pragma unroll
        for (int nn = 0; nn < 2; ++nn) {
          int f = (((bcol0 + wc * 64) >> 5) + nn) * 16 + fr;
          float g = acc[m][2 * nn][j], u = acc[m][2 * nn + 1][j];
          ACT[(size_t)sr * FF + f] = f2bf(siluf_(g) * u);
        }
      }
  } else {
    const int* ROWL = (const int*)(p.ws + OFF_ROWL);
    const float* GATE = (const float*)(p.ws + OFF_GATE);
#pragma unroll
    for (int m = 0; m < 4; ++m)
#pragma unroll
      for (int j = 0; j < 4; ++j) {
        int sr = orow0 + wr * 64 + m * 16 + fq * 4 + j;
        int tok = ROWL[sr];
        float gt = GATE[sr];
        float* xd = xrow_dst(p, tok);
        const float* g5 = modptr(p, layer, modrow(tok), 5);
#pragma unroll
        for (int n = 0; n < 4; ++n) {
          int col = bcol0 + wc * 64 + n * 16 + fr;
          unsafeAtomicAdd(xd + col, g5[col] * gt * acc[m][n][j]);
        }
      }
  }
}

__device__ void phase_inproj(const Params& p, int layer, int bid, int nb) {
  const bf16_t* A = (const bf16_t*)(p.ws + OFF_ACTA);
  const bf16_t* Bt = (const bf16_t*)(p.ws + OFF_WINT) + (size_t)layer * INP * DM;
  constexpr int MT = NTOK / 128, NT = INP / 128;
  for (int t = bid; t < MT * NT; t += nb) {
    int mt = t / NT, nt = t % NT;
    gemm_tile<0>(p, layer, 0, A, DM, nullptr, mt * 128, Bt, DM, nt * 128, DM, mt * 128);
  }
}
__device__ void phase_outproj(const Params& p, int layer, int bid, int nb) {
  const bf16_t* A = (const bf16_t*)(p.ws + OFF_ACTA);
  const bf16_t* Bt = (const bf16_t*)(p.ws + OFF_WOUTT) + (size_t)layer * DM * DM;
  const int MT = (layer == 0 ? NTOK : NLAT) / 128, NT = DM / 128;
  for (int t = bid; t < MT * NT; t += nb) {
    int mt = t / NT, nt = t % NT;
    gemm_tile<1>(p, layer, layer == 0 ? 0 : 1, A, DM, nullptr, mt * 128, Bt, DM, nt * 128, DM, mt * 128);
  }
}
__device__ void phase_moe1(const Params& p, int layer, int bid, int nb) {
  const bf16_t* A = (const bf16_t*)(p.ws + OFF_ACTB);
  const int* ROWL = (const int*)(p.ws + OFF_ROWL);
  const int MT = (layer == 0 ? SLOTS : SLOTS_L) / 128;
  for (int t = bid; t < NEXP * MT * 8; t += nb) {
    int e = t / (MT * 8), r = t % (MT * 8), nt = r / MT, mt = r % MT;
    const bf16_t* Bt = (const bf16_t*)(p.ws + OFF_WGU) + (size_t)(layer * NEXP + e) * 1024 * DM;
    gemm_tile<2>(p, layer, 0, A, DM, ROWL, e * SLOTS + mt * 128, Bt, DM, nt * 128, DM, e * SLOTS + mt * 128);
  }
}
__device__ void phase_moe2(const Params& p, int layer, int bid, int nb) {
  const bf16_t* A = (const bf16_t*)(p.ws + OFF_ACTA);
  const int MT = (layer == 0 ? SLOTS : SLOTS_L) / 128;
  for (int t = bid; t < NEXP * MT * 8; t += nb) {
    int e = t / (MT * 8), r = t % (MT * 8), nt = r / MT, mt = r % MT;
    const bf16_t* Bt = (const bf16_t*)(p.ws + OFF_WDT) + (size_t)(layer * NEXP + e) * DM * FF;
    gemm_tile<3>(p, layer, 0, A, FF, nullptr, e * SLOTS + mt * 128, Bt, FF, nt * 128, FF, e * SLOTS + mt * 128);
  }
}

__device__ void phase_mlaproj(const Params& p, int layer, int bid, int nb) {
  float* cq = (float*)dynsmem;
  float* ckv = cq + 192;
  float* kr = ckv + 128;
  float* qv = kr + 32;
  float* kvv = qv + 384;
  float* sc = kvv + 512;
  const int tid = threadIdx.x, wave = tid >> 6, lane = tid & 63;
  const bf16_t* U = (const bf16_t*)(p.ws + OFF_U);
  const float* qan = p.in[I_MQAN] + layer * 192;
  const float* kvan = p.in[I_MKVAN] + layer * 128;
  const float* wq = p.in[I_MWQ] + (size_t)layer * 192 * 384;
  const float* wkv = p.in[I_MWKV] + (size_t)layer * 128 * 512;
  const float* qn = p.in[I_MQN] + layer * 96;
  const float* kn = p.in[I_MKN] + layer * 96;
  bf16_t* QB = (bf16_t*)(p.ws + OFF_ACTB + QB_OFF);
  bf16_t* KB = (bf16_t*)(p.ws + OFF_ACTB + KB_OFF);
  bf16_t* VB = (bf16_t*)(p.ws + OFF_ACTB + VB_OFF);
  for (int row = bid; row < NTOK; row += nb) {
    const bool lat = row < NLAT;
    const int b = lat ? (row >> 11) : ((row - NLAT) >> 8);
    const int n = lat ? (row & 2047) : ((row - NLAT) & 255);
    const int key = lat ? (CTXL + n) : n;
    const bf16_t* ur = U + (size_t)row * INP + 2568;
    __syncthreads();
    if (tid < 192) cq[tid] = bf2f(ur[tid]);
    if (tid < 128) ckv[tid] = bf2f(ur[192 + tid]);
    if (tid < 32) kr[tid] = bf2f(ur[320 + tid]);
    __syncthreads();
    if (wave == 0) {
      float s = cq[lane] * cq[lane] + cq[64 + lane] * cq[64 + lane] + cq[128 + lane] * cq[128 + lane];
      s = wave_sum(s);
      if (lane == 0) sc[0] = rsqrtf(s * (1.f / 192.f) + EPSF);
    } else if (wave == 1) {
      float s = ckv[lane] * ckv[lane] + ckv[64 + lane] * ckv[64 + lane];
      s = wave_sum(s);
      if (lane == 0) sc[1] = rsqrtf(s * (1.f / 128.f) + EPSF);
    } else if (wave == 2) {
      float s = lane < 32 ? kr[lane] * kr[lane] : 0.f;
      s = wave_sum(s);
      if (lane == 0) sc[2] = rsqrtf(s * (1.f / 32.f) + EPSF);
    }
    __syncthreads();
    if (tid < 192) cq[tid] = cq[tid] * sc[0] * qan[tid];
    if (tid < 128) ckv[tid] = ckv[tid] * sc[1] * kvan[tid];
    __syncthreads();
    {
      float a0 = 0.f, a1 = 0.f;
      for (int k = 0; k < 192; ++k) {
        float x = cq[k];
        a0 += x * wq[k * 384 + tid];
        if (tid < 128) a1 += x * wq[k * 384 + 256 + tid];
      }
      qv[tid] = a0;
      if (tid < 128) qv[256 + tid] = a1;
      float b0 = 0.f, b1 = 0.f;
      for (int k = 0; k < 128; ++k) {
        float x = ckv[k];
        b0 += x * wkv[k * 512 + tid];
        b1 += x * wkv[k * 512 + 256 + tid];
      }
      kvv[tid] = b0;
      kvv[256 + tid] = b1;
    }
    __syncthreads();
    {
      const int h = wave;
      const int pi = (lane & 31) >> 1;
      const float inv = powf(10000.f, -(float)(pi & 7) / 8.f);
      const float pos = (pi < 8) ? (float)(n >> 6) : (float)(n & 63);
      const float ang = pos * inv;
      const float cs = cosf(ang), sn = sinf(ang);
      float x = qv[h * 96 + lane];
      float s = wave_sum(x * x);
      float qn_v = x * rsqrtf(s * (1.f / 64.f) + EPSF) * qn[lane];
      float xr = lane < 32 ? qv[h * 96 + 64 + lane] : 0.f;
      float s2 = wave_sum(xr * xr);
      float qr_v = lane < 32 ? xr * rsqrtf(s2 * (1.f / 32.f) + EPSF) * qn[64 + lane] : 0.f;
      float y = kvv[h * 128 + lane];
      float s3 = wave_sum(y * y);
      float kn_v = y * rsqrtf(s3 * (1.f / 64.f) + EPSF) * kn[lane];
      float kk = lane < 32 ? kr[lane] * sc[2] * kn[64 + lane] : 0.f;
      if (lat) {
        float qo = __shfl_xor(qr_v, 1), ko = __shfl_xor(kk, 1);
        if (lane & 1) { qr_v = qo * sn + qr_v * cs; kk = ko * sn + kk * cs; }
        else { qr_v = qr_v * cs - qo * sn; kk = kk * cs - ko * sn; }
      }
      const float qscale = 0.10206207261596577f;
      bf16_t* qd = QB + ((size_t)row * 4 + h) * 96;
      bf16_t* kd = KB + (((size_t)(b * 4 + h)) * NKEY + key) * 96;
      bf16_t* vd = VB + (((size_t)(b * 4 + h)) * NKEY + key) * 64;
      qd[lane] = f2bf(qn_v * qscale);
      kd[lane] = f2bf(kn_v);
      if (lane < 32) { qd[64 + lane] = f2bf(qr_v * qscale); kd[64 + lane] = f2bf(kk); }
      vd[lane] = f2bf(kvv[h * 128 + 64 + lane]);
    }
  }
}

__device__ void chain_lru(const Params& p, int L, int b) {
  float* xs = (float*)dynsmem;
  const int tid = threadIdx.x, h = tid >> 6, lane = tid & 63, ch = h * 64 + lane;
  const bf16_t* U = (const bf16_t*)(p.ws + OFF_U);
  bf16_t* Y = (bf16_t*)(p.ws + OFF_ACTA);
  float cw[4];
#pragma unroll
  for (int j = 0; j < 4; ++j) cw[j] = p.in[I_LCW][(L * 4 + j) * 256 + ch];
  const float cb = p.in[I_LCB][L * 256 + ch];
  float* wrl = xs + 256;
  float* wil = wrl + 4 * 4096;
  for (int d = 0; d < 2; ++d) {
    __syncthreads();
    {
      const float* wr = p.in[I_LWR] + (size_t)((L * 2 + d) * 4) * 4096;
      const float* wi = p.in[I_LWI] + (size_t)((L * 2 + d) * 4) * 4096;
      for (int i = tid; i < 4 * 4096; i += 256) { wrl[i] = wr[i]; wil[i] = wi[i]; }
    }
    __syncthreads();
    const float br = p.in[I_LBR][(L * 2 + d) * 256 + ch], bi = p.in[I_LBI][(L * 2 + d) * 256 + ch];
    const float lam = p.in[I_LLAM][(L * 2 + d) * 256 + ch];
    const float sp = softplusf_(-lam);
    float hst = 0.f;
    for (int seg = 0; seg < 2; ++seg) {
      const int seglen = seg == 0 ? CTXL : SEQ;
      const int rowbase = seg == 0 ? NLAT + b * CTXL : b * SEQ;
      const bool wout = !(L == 1 && seg == 0);
      for (int i = 0; i < seglen; ++i) {
        const int t = d ? seglen - 1 - i : i;
        float xc = cb;
#pragma unroll
        for (int j = 0; j < 4; ++j) {
          int tt = t + j - 2;
          if (tt >= 0 && tt < seglen) xc += bf2f(U[(size_t)(rowbase + tt) * INP + ch]) * cw[j];
        }
        __syncthreads();
        xs[tid] = xc;
        __syncthreads();
        float r = br, ii = bi;
#pragma unroll
        for (int k = 0; k < 64; ++k) { float xv = xs[h * 64 + k]; r += xv * wrl[(h * 64 + k) * 64 + lane]; ii += xv * wil[(h * 64 + k) * 64 + lane]; }
        r = sigmoidf_(r); ii = sigmoidf_(ii);
        float log_a = -8.f * r * sp;
        float a = expf(log_a);
        float bb = sqrtf(-expm1f(2.f * log_a)) * (ii * xc);
        hst = a * hst + bb;
        if (wout) {
          const size_t row = (size_t)(rowbase + t);
          if (d == 0) Y[row * DM + ch] = f2bf(hst);
          else {
            float tot = bf2f(Y[row * DM + ch]) + hst;
            float gate = bf2f(U[row * INP + 256 + ch]);
            Y[row * DM + ch] = f2bf(tot * gelu_tanh(gate));
          }
        }
      }
    }
  }
}

__device__ void chain_hgrn(const Params& p, int L, int b) {
  float* lq = (float*)dynsmem;
  float* lf = lq + 256;
  const int tid = threadIdx.x, h = tid >> 6, lane = tid & 63, ch = h * 64 + lane;
  const bf16_t* U = (const bf16_t*)(p.ws + OFF_U);
  bf16_t* Y = (bf16_t*)(p.ws + OFF_ACTA);
  float lb = 0.f;
  if (L == 1) lb = sigmoidf_(p.in[I_HLB][256 + ch] - p.in[I_HLB][ch]);
  const float nwv = p.in[I_HNW][L * 256 + ch];
  for (int d = 0; d < 2; ++d) {
    float S[64];
#pragma unroll
    for (int k = 0; k < 64; ++k) S[k] = 0.f;
    for (int seg = 0; seg < 2; ++seg) {
      const int seglen = seg == 0 ? CTXL : SEQ;
      const int rowbase = seg == 0 ? NLAT + b * CTXL : b * SEQ;
      const bool wout = !(L == 1 && seg == 0);
      for (int i = 0; i < seglen; ++i) {
        const int t = d ? seglen - 1 - i : i;
        const size_t row = (size_t)(rowbase + t);
        const bf16_t* ur = U + row * INP;
        float qv = siluf_(bf2f(ur[512 + ch]));
        float f = lb + (1.f - lb) * sigmoidf_(bf2f(ur[768 + d * 256 + ch]));
        float vv = bf2f(ur[1280 + ch]);
        __syncthreads();
        lq[tid] = qv; lf[tid] = f;
        __syncthreads();
        float o = 0.f;
#pragma unroll
        for (int k = 0; k < 64; ++k) {
          float fk = lf[h * 64 + k];
          S[k] = fk * S[k] + (1.f - fk) * vv;
          o += lq[h * 64 + k] * S[k];
        }
        if (wout) {
          if (d == 0) Y[row * DM + 256 + ch] = f2bf(o);
          else {
            float tot = bf2f(Y[row * DM + 256 + ch]) + o;
            float ss = wave_sum(tot * tot);
            float rn = rsqrtf(ss * (1.f / 64.f) + EPSF);
            float g = bf2f(ur[1536 + ch]);
            Y[row * DM + 256 + ch] = f2bf(tot * rn * nwv * siluf_(g));
          }
        }
      }
    }
  }
}

__device__ void chain_ssd(const Params& p, int L, int b) {
  float* lB = (float*)dynsmem;
  float* lC = lB + 256;
  const int tid = threadIdx.x, h = tid >> 6, lane = tid & 63, g = h >> 1;
  const bf16_t* U = (const bf16_t*)(p.ws + OFF_U);
  bf16_t* Y = (bf16_t*)(p.ws + OFF_ACTA);
  const int c_x = h * 64 + lane, c_b = 256 + g * 64 + lane, c_c = 384 + g * 64 + lane;
  float wx[4], wb[4], wcc[4];
#pragma unroll
  for (int j = 0; j < 4; ++j) {
    wx[j] = p.in[I_SCW][(L * 4 + j) * 512 + c_x];
    wb[j] = p.in[I_SCW][(L * 4 + j) * 512 + c_b];
    wcc[j] = p.in[I_SCW][(L * 4 + j) * 512 + c_c];
  }
  const float bx = p.in[I_SCB][L * 512 + c_x], bbv = p.in[I_SCB][L * 512 + c_b], bc = p.in[I_SCB][L * 512 + c_c];
  const float dsk = p.in[I_SDSK][L * 4 + h];
  for (int d = 0; d < 2; ++d) {
    const float Aa = -expf(p.in[I_SALOG][(L * 2 + d) * 4 + h]);
    const float dtb = p.in[I_SDTB][(L * 2 + d) * 4 + h];
    float S[64];
#pragma unroll
    for (int k = 0; k < 64; ++k) S[k] = 0.f;
    for (int seg = 0; seg < 2; ++seg) {
      const int seglen = seg == 0 ? CTXL : SEQ;
      const int rowbase = seg == 0 ? NLAT + b * CTXL : b * SEQ;
      const bool wout = !(L == 1 && seg == 0);
      for (int i = 0; i < seglen; ++i) {
        const int t = d ? seglen - 1 - i : i;
        const size_t row = (size_t)(rowbase + t);
        float xv = bx, Bv = bbv, Cv = bc;
#pragma unroll
        for (int j = 0; j < 4; ++j) {
          int tt = t + j - 2;
          if (tt >= 0 && tt < seglen) {
            const bf16_t* ur = U + (size_t)(rowbase + tt) * INP + 2048;
            xv += bf2f(ur[c_x]) * wx[j];
            Bv += bf2f(ur[c_b]) * wb[j];
            Cv += bf2f(ur[c_c]) * wcc[j];
          }
        }
        xv = siluf_(xv); Bv = siluf_(Bv); Cv = siluf_(Cv);
        const bf16_t* ur0 = U + row * INP;
        float dt = softplusf_(bf2f(ur0[2560 + d * 4 + h]) + dtb);
        float dec = expf(dt * Aa);
        __syncthreads();
        lB[tid] = Bv; lC[tid] = Cv;
        __syncthreads();
        float y = 0.f;
        const float dx = dt * xv;
#pragma unroll
        for (int k = 0; k < 64; ++k) {
          S[k] = dec * S[k] + dx * lB[h * 64 + k];
          y += lC[h * 64 + k] * S[k];
        }
        if (wout) {
          const size_t yi = row * DM + 512 + h * 64 + lane;
          if (d == 0) Y[yi] = f2bf(y);
          else {
            float tot = bf2f(Y[yi]) + y + dsk * xv;
            float z = bf2f(ur0[1792 + h * 64 + lane]);
            Y[yi] = f2bf(tot * siluf_(z));
          }
        }
      }
    }
  }
}

__device__ void attn_item(const Params& p, int L, int item) {
  bf16_t* Kt = (bf16_t*)dynsmem;
  bf16_t* Vt = Kt + 64 * 96;
  const int tid = threadIdx.x;
  int b, h, rowq, nkeys;
  if (item < 512) { int bh = item >> 3, qb = item & 7; b = bh >> 2; h = bh & 3; rowq = b * SEQ + qb * 256 + tid; nkeys = NKEY; }
  else { int bh = item - 512; b = bh >> 2; h = bh & 3; rowq = NLAT + b * CTXL + tid; nkeys = CTXL; }
  const bf16_t* QB = (const bf16_t*)(p.ws + OFF_ACTB + QB_OFF);
  const bf16_t* KB = (const bf16_t*)(p.ws + OFF_ACTB + KB_OFF) + ((size_t)(b * 4 + h)) * NKEY * 96;
  const bf16_t* VB = (const bf16_t*)(p.ws + OFF_ACTB + VB_OFF) + ((size_t)(b * 4 + h)) * NKEY * 64;
  bf16_t* Y = (bf16_t*)(p.ws + OFF_ACTA);
  unsigned qp_[48];
  {
    const uint4* qp = (const uint4*)(QB + ((size_t)rowq * 4 + h) * 96);
#pragma unroll
    for (int i = 0; i < 12; ++i) {
      uint4 v = qp[i];
      qp_[i * 4] = v.x; qp_[i * 4 + 1] = v.y; qp_[i * 4 + 2] = v.z; qp_[i * 4 + 3] = v.w;
    }
  }
  float o[64];
#pragma unroll
  for (int i = 0; i < 64; ++i) o[i] = 0.f;
  float m = -1e30f, l = 0.f;
  for (int k0 = 0; k0 < nkeys; k0 += 64) {
    __syncthreads();
    {
      const uint4* ks = (const uint4*)(KB + (size_t)k0 * 96);
      uint4* kd = (uint4*)Kt;
      for (int i = tid; i < 64 * 96 * 2 / 16; i += 256) kd[i] = ks[i];
      const uint4* vs = (const uint4*)(VB + (size_t)k0 * 64);
      uint4* vd = (uint4*)Vt;
      for (int i = tid; i < 64 * 64 * 2 / 16; i += 256) vd[i] = vs[i];
    }
    __syncthreads();
    for (int kk = 0; kk < 64; ++kk) {
      const uint4* kr = (const uint4*)(Kt + kk * 96);
      float s = 0.f;
#pragma unroll
      for (int i = 0; i < 12; ++i) {
        uint4 v = kr[i];
        unsigned w[4] = {v.x, v.y, v.z, v.w};
#pragma unroll
        for (int j = 0; j < 4; ++j) { unsigned qq = qp_[i * 4 + j]; s += __uint_as_float(qq << 16) * __uint_as_float(w[j] << 16); s += __uint_as_float(qq & 0xffff0000u) * __uint_as_float(w[j] & 0xffff0000u); }
      }
      if (s > m) {
        float corr = expf(m - s);
        l *= corr;
#pragma unroll
        for (int i = 0; i < 64; ++i) o[i] *= corr;
        m = s;
      }
      float pe = expf(s - m);
      l += pe;
      const uint4* vr = (const uint4*)(Vt + kk * 64);
#pragma unroll
      for (int i = 0; i < 8; ++i) {
        uint4 v = vr[i];
        unsigned w[4] = {v.x, v.y, v.z, v.w};
#pragma unroll
        for (int j = 0; j < 4; ++j) { o[i * 8 + j * 2] += pe * __uint_as_float(w[j] << 16); o[i * 8 + j * 2 + 1] += pe * __uint_as_float(w[j] & 0xffff0000u); }
      }
    }
  }
  const float il = 1.f / l;
  bf16_t* yd = Y + (size_t)rowq * DM + 768 + h * 64;
#pragma unroll
  for (int i = 0; i < 64; ++i) yd[i] = f2bf(o[i] * il);
}

__device__ void phase_mix(const Params& p, int L, int bid, int nb) {
  const int nattn = (L == 0) ? 576 : 512;
  for (int it = bid; it < 48 + nattn; it += nb) {
    if (it < 16) chain_hgrn(p, L, it);
    else if (it < 32) chain_ssd(p, L, it - 16);
    else if (it < 48) chain_lru(p, L, it - 32);
    else attn_item(p, L, it - 48);
    __syncthreads();
  }
}

__device__ void phase_ssdnorm(const Params& p, int L, int bid, int nb) {
  const int wave = threadIdx.x >> 6, lane = threadIdx.x & 63;
  bf16_t* Y = (bf16_t*)(p.ws + OFF_ACTA);
  const float* nw = p.in[I_SNW] + L * 256;
  const int nrows = (L == 0) ? NTOK : NLAT;
  for (int row = bid * 4 + wave; row < nrows; row += nb * 4) {
    uint2* yp = (uint2*)(Y + (size_t)row * DM + 512) + lane;
    uint2 v = *yp;
    float a0 = __uint_as_float(v.x << 16), a1 = __uint_as_float(v.x & 0xffff0000u), a2 = __uint_as_float(v.y << 16), a3 = __uint_as_float(v.y & 0xffff0000u);
    float ss = wave_sum(a0 * a0 + a1 * a1 + a2 * a2 + a3 * a3);
    float rn = rsqrtf(ss * (1.f / 256.f) + EPSF);
    float4 w = ((const float4*)nw)[lane];
    uint2 o;
    o.x = (unsigned)f2bf(a0 * rn * w.x) | ((unsigned)f2bf(a1 * rn * w.y) << 16);
    o.y = (unsigned)f2bf(a2 * rn * w.z) | ((unsigned)f2bf(a3 * rn * w.w) << 16);
    *yp = o;
  }
}

__device__ void phase_topk(const Params& p, int L, int bid, int nb) {
  float* a = (float*)dynsmem;
  const int tid = threadIdx.x;
  const float* aff = (const float*)(p.ws + OFF_AFF);
  int* ROWL = (int*)(p.ws + OFF_ROWL);
  float* GATE = (float*)(p.ws + OFF_GATE);
  const int nitems = (L == 0) ? 512 : 256;
  for (int it = bid; it < nitems; it += nb) {
    const bool lat = it < 256;
    const int be = lat ? it : it - 256;
    const int b = be >> 4, e = be & 15;
    const int n = lat ? SEQ : CTXL, cap = lat ? CAPL : CAPC;
    const float* src = lat ? aff + (size_t)be * SEQ : aff + (size_t)NB * NEXP * SEQ + (size_t)be * CTXL;
    __syncthreads();
    for (int i = tid; i < n; i += 256) a[i] = src[i];
    __syncthreads();
    for (int i0 = 0; i0 < n; i0 += 1024) {
      float av[4]; int rk[4];
#pragma unroll
      for (int q = 0; q < 4; ++q) { int i = i0 + q * 256 + tid; av[q] = i < n ? a[i] : 0.f; rk[q] = 0; }
      for (int j = 0; j < n; ++j) {
        float aj = a[j];
#pragma unroll
        for (int q = 0; q < 4; ++q) {
          int i = i0 + q * 256 + tid;
          rk[q] += (aj > av[q] || (aj == av[q] && j < i)) ? 1 : 0;
        }
      }
#pragma unroll
      for (int q = 0; q < 4; ++q) {
        int i = i0 + q * 256 + tid;
        if (i < n && rk[q] < cap) {
          int slot = lat ? (e * SLOTS + b * CAPL + rk[q]) : (e * SLOTS + SLOTS_L + b * CAPC + rk[q]);
          ROWL[slot] = lat ? (b * SEQ + i) : (NLAT + b * CTXL + i);
          GATE[slot] = av[q];
        }
      }
    }
  }
}

enum { PH_PREP = 0, PH_NORM1, PH_INPROJ, PH_MLAPROJ, PH_MIX, PH_SSDNORM, PH_OUTPROJ, PH_NORM2, PH_TOPK, PH_MOE1, PH_MOE2 };

__device__ __forceinline__ void run_phase(const Params& p, int ph, int L, int bid, int nb) {
  switch (ph) {
    case PH_PREP: phase_prep(p, bid, nb); break;
    case PH_NORM1: phase_norm(p, L, 0, L == 0 ? 0 : 1, NTOK, bid, nb); break;
    case PH_INPROJ: phase_inproj(p, L, bid, nb); break;
    case PH_MLAPROJ: phase_mlaproj(p, L, bid, nb); break;
    case PH_MIX: phase_mix(p, L, bid, nb); break;
    case PH_SSDNORM: phase_ssdnorm(p, L, bid, nb); break;
    case PH_OUTPROJ: phase_outproj(p, L, bid, nb); break;
    case PH_NORM2: phase_norm(p, L, 1, 1, L == 0 ? NTOK : NLAT, bid, nb); break;
    case PH_TOPK: phase_topk(p, L, bid, nb); break;
    case PH_MOE1: phase_moe1(p, L, bid, nb); break;
    case PH_MOE2: phase_moe2(p, L, bid, nb); break;
  }
}

#if !MEGA
template <int PH>
__global__ void __launch_bounds__(256, 2) k_phase(Params p, int L) {
  run_phase(p, PH, L, blockIdx.x, gridDim.x);
}
__global__ void __launch_bounds__(256) k_phase_mix(Params p, int L) {
  phase_mix(p, L, blockIdx.x, gridDim.x);
}
#endif

#if MEGA
__global__ void __launch_bounds__(256) k_mega(Params p) {
  cg::grid_group grid = cg::this_grid();
  const int bid = blockIdx.x, nb = gridDim.x;
  phase_prep(p, bid, nb);
  grid.sync();
#define RP(PH, L) run_phase(p, PH, L, bid, nb); grid.sync();
  RP(PH_NORM1, 0) RP(PH_INPROJ, 0) RP(PH_MLAPROJ, 0) RP(PH_MIX, 0) RP(PH_SSDNORM, 0) RP(PH_OUTPROJ, 0) RP(PH_NORM2, 0) RP(PH_TOPK, 0) RP(PH_MOE1, 0) RP(PH_MOE2, 0)
  RP(PH_NORM1, 1) RP(PH_INPROJ, 1) RP(PH_MLAPROJ, 1) RP(PH_MIX, 1) RP(PH_SSDNORM, 1) RP(PH_OUTPROJ, 1) RP(PH_NORM2, 1) RP(PH_TOPK, 1) RP(PH_MOE1, 1) RP(PH_MOE2, 1)
}
#endif

extern "C" void kernel_launch(void* const* d_in, const int* in_sizes, int n_in, void* d_out, int out_size, void* d_ws, size_t ws_size, hipStream_t stream) {
  Params p{};
  for (int i = 0; i < N_IN; ++i) p.in[i] = (const float*)d_in[i];
  p.out = (float*)d_out;
  p.ws = (char*)d_ws;
  if (n_in != N_IN || ws_size < WS_END) { fprintf(stderr, "kernel_launch: bad args n_in=%d ws=%zu need %zu\n", n_in, ws_size, (size_t)WS_END); return; }
#if MEGA
  static int grid = 0;
  if (!grid) {
    int dev = 0, cus = 0, per_cu = 0;
    hipGetDevice(&dev);
    hipDeviceGetAttribute(&cus, hipDeviceAttributeMultiprocessorCount, dev);
    hipFuncSetAttribute((const void*)k_mega, hipFuncAttributeMaxDynamicSharedMemorySize, DYN_LDS);
    hipOccupancyMaxActiveBlocksPerMultiprocessor(&per_cu, (const void*)k_mega, 256, DYN_LDS);
    if (per_cu > 1) per_cu = 1;
    if (per_cu < 1) per_cu = 1;
    grid = cus * per_cu;
  }
  void* args[] = {&p};
  hipError_t e = hipLaunchCooperativeKernel((const void*)k_mega, dim3(grid), dim3(256), args, DYN_LDS, stream);
  if (e != hipSuccess) fprintf(stderr, "cooperative launch failed: %s (grid %d)\n", hipGetErrorString(e), grid);
#else
  const int G = 1024;
#define LAUNCH(PH, L) k_phase<PH><<<G, 256, DYN_LDS, stream>>>(p, L)
  LAUNCH(PH_PREP, 0);
  for (int L = 0; L < 2; ++L) {
    LAUNCH(PH_NORM1, L); LAUNCH(PH_INPROJ, L); LAUNCH(PH_MLAPROJ, L); k_phase_mix<<<G, 256, DYN_LDS, stream>>>(p, L); LAUNCH(PH_SSDNORM, L);
    LAUNCH(PH_OUTPROJ, L); LAUNCH(PH_NORM2, L); LAUNCH(PH_TOPK, L); LAUNCH(PH_MOE1, L); LAUNCH(PH_MOE2, L);
  }
#endif
}
```

```cpp
#include <hip/hip_runtime.h>
#include <hip/hip_cooperative_groups.h>
#include <cstdio>
#include <cstdint>
namespace cg = cooperative_groups;

#ifndef MEGA
#define MEGA 1
#endif
#ifndef MEGA_WPS
#define MEGA_WPS 1
#endif

typedef unsigned short bf16_t;
typedef short bf16x8 __attribute__((ext_vector_type(8)));
typedef float f32x4 __attribute__((ext_vector_type(4)));

#define NB 16
#define SEQ 2048
#define CTXL 256
#define DM 1024
#define NLAT (NB * SEQ)
#define NCTX (NB * CTXL)
#define NTOK (NLAT + NCTX)
#define INC 2920
#define INP 2944
#define NEXP 16
#define FF 512
#define CAPL 256
#define CAPC 32
#define SLOTS_L (NB * CAPL)
#define SLOTS_C (NB * CAPC)
#define SLOTS (SLOTS_L + SLOTS_C)
#define NKEY (CTXL + SEQ)
#define EPSF 1e-6f

enum { I_X = 0, I_C, I_CTX, I_CCTX, I_ADAW, I_ADAB, I_N1W, I_N2W, I_WIN, I_WOUT, I_LCW, I_LCB, I_LWR, I_LBR, I_LWI, I_LBI, I_LLAM,
       I_HLB, I_HNW, I_SCW, I_SCB, I_SALOG, I_SDTB, I_SDSK, I_SNW, I_MQAN, I_MWQ, I_MKVAN, I_MWKV, I_MQN, I_MKN, I_ROUT, I_WG, I_WU, I_WD, N_IN };

struct Params {
  const float* in[N_IN];
  float* out;
  char* ws;
};

constexpr size_t OFF_MOD = 0;
constexpr size_t SZ_MOD = (size_t)2 * 17 * 6144 * 4;
constexpr size_t OFF_WINT = OFF_MOD + SZ_MOD;
constexpr size_t SZ_WINT = (size_t)2 * INP * DM * 2;
constexpr size_t OFF_WOUTT = OFF_WINT + SZ_WINT;
constexpr size_t SZ_WOUTT = (size_t)2 * DM * DM * 2;
constexpr size_t OFF_WGU = OFF_WOUTT + SZ_WOUTT;
constexpr size_t SZ_WGU = (size_t)2 * NEXP * 1024 * DM * 2;
constexpr size_t OFF_WDT = OFF_WGU + SZ_WGU;
constexpr size_t SZ_WDT = (size_t)2 * NEXP * DM * FF * 2;
constexpr size_t OFF_CTXS = OFF_WDT + SZ_WDT;
constexpr size_t SZ_CTXS = (size_t)NCTX * DM * 4;
constexpr size_t OFF_ACTA = OFF_CTXS + SZ_CTXS;
constexpr size_t SZ_ACT = (size_t)NTOK * DM * 2;
constexpr size_t OFF_ACTB = OFF_ACTA + SZ_ACT;
constexpr size_t OFF_U = OFF_ACTB + SZ_ACT;
constexpr size_t SZ_U = (size_t)NTOK * INP * 2;
constexpr size_t OFF_AFF = OFF_U + SZ_U;
constexpr size_t SZ_AFF = (size_t)(NB * NEXP * SEQ + NB * NEXP * CTXL) * 4;
constexpr size_t OFF_ROWL = OFF_AFF + SZ_AFF;
constexpr size_t SZ_ROWL = (size_t)NEXP * SLOTS * 4;
constexpr size_t OFF_GATE = OFF_ROWL + SZ_ROWL;
constexpr size_t OFF_WQT = OFF_GATE + SZ_ROWL;
constexpr size_t SZ_WQT = (size_t)2 * 384 * 192 * 2;
constexpr size_t OFF_WKVT = OFF_WQT + SZ_WQT;
constexpr size_t SZ_WKVT = (size_t)2 * 512 * 128 * 2;
constexpr size_t OFF_LRUW = OFF_WKVT + SZ_WKVT;
constexpr size_t SZ_LRUW = (size_t)2 * 2 * 2 * 4 * 4096 * 2;
constexpr size_t OFF_ROPE = OFF_LRUW + SZ_LRUW;
constexpr size_t SZ_ROPE = (size_t)SEQ * 16 * 2 * 4;
constexpr size_t OFF_CNT = OFF_ROPE + SZ_ROPE;
constexpr size_t WS_END = OFF_CNT + 256;

constexpr size_t QB_OFF = 0;
constexpr size_t KB_OFF = (size_t)NTOK * 384 * 2;
constexpr size_t VB_OFF = KB_OFF + (size_t)NB * 4 * NKEY * 96 * 2;

extern __shared__ __attribute__((aligned(16))) char dynsmem[];
#define DYN_LDS 77824
#define TS 72

__device__ __forceinline__ bf16_t f2bf(float f) {
  unsigned u = __float_as_uint(f);
  u += 0x7fffu + ((u >> 16) & 1u);
  return (bf16_t)(u >> 16);
}
__device__ __forceinline__ float bf2f(bf16_t h) { return __uint_as_float(((unsigned)h) << 16); }
__device__ __forceinline__ float sigmoidf_(float x) { return 1.f / (1.f + expf(-x)); }
__device__ __forceinline__ float siluf_(float x) { return x / (1.f + expf(-x)); }
__device__ __forceinline__ float softplusf_(float x) { return x > 20.f ? x : log1pf(expf(x)); }
__device__ __forceinline__ float gelu_tanh(float x) {
  float t = tanhf(0.7978845608028654f * (x + 0.044715f * x * x * x));
  return 0.5f * x * (1.f + t);
}
__device__ __forceinline__ float wave_sum(float v) {
#pragma unroll
  for (int o = 1; o < 64; o <<= 1) v += __shfl_xor(v, o);
  return v;
}
__device__ __forceinline__ const float* xrow_src(const Params& p, int srcmode, int row) {
  if (srcmode == 0) return row < NLAT ? p.in[I_X] + (size_t)row * DM : p.in[I_CTX] + (size_t)(row - NLAT) * DM;
  return row < NLAT ? p.out + (size_t)row * DM : (const float*)(p.ws + OFF_CTXS) + (size_t)(row - NLAT) * DM;
}
__device__ __forceinline__ float* xrow_dst(const Params& p, int row) {
  return row < NLAT ? p.out + (size_t)row * DM : (float*)(p.ws + OFF_CTXS) + (size_t)(row - NLAT) * DM;
}
__device__ __forceinline__ int modrow(int row) { return row < NLAT ? (row >> 11) : 16; }
__device__ __forceinline__ const float* modptr(const Params& p, int layer, int mrow, int chunk) {
  return (const float*)(p.ws + OFF_MOD) + ((size_t)(layer * 17 + mrow) * 6144 + chunk * 1024);
}

__device__ __forceinline__ void transpose_tile(const float* __restrict__ src, int N, int k0, int n0, bf16_t* __restrict__ dst, int K, int mode) {
  float* tile = (float*)dynsmem;
  const int tid = threadIdx.x;
#pragma unroll
  for (int i = 0; i < 16; ++i) {
    int idx = i * 256 + tid;
    int r = idx >> 6, c = idx & 63;
    int n = n0 + c;
    float v = (n < N) ? src[(size_t)(k0 + r) * N + n] : 0.f;
    tile[r * 65 + c] = v;
  }
  __syncthreads();
#pragma unroll
  for (int i = 0; i < 16; ++i) {
    int idx = i * 256 + tid;
    int nl = idx >> 6, kl = idx & 63;
    int n = n0 + nl;
    int nr = (mode == 0) ? n : ((n >> 4) * 32 + (mode == 2 ? 16 : 0) + (n & 15));
    dst[(size_t)nr * K + k0 + kl] = f2bf(tile[kl * 65 + nl]);
  }
  __syncthreads();
}

__device__ __forceinline__ void mod_item(const Params& p, int j) {
  float* s = (float*)dynsmem;
  float* red = s + 17 * 256;
  const int tid = threadIdx.x;
  const int l = j / 96, cb = (j % 96) * 64;
  const int kg = tid >> 6, col = tid & 63;
  const float* cc = p.in[I_C];
  const float* cctx = p.in[I_CCTX];
  const float* aw = p.in[I_ADAW] + (size_t)l * DM * 6144;
  float acc[17];
#pragma unroll
  for (int r = 0; r < 17; ++r) acc[r] = 0.f;
  for (int kc = 0; kc < 4; ++kc) {
    __syncthreads();
    for (int idx = tid; idx < 17 * 256; idx += 256) {
      int r = idx >> 8, kk = idx & 255;
      int k = kc * 256 + kk;
      float v = (r < 16) ? cc[r * DM + k] : cctx[k];
      s[idx] = siluf_(v);
    }
    __syncthreads();
    for (int kk = 0; kk < 64; ++kk) {
      int kl = kg * 64 + kk;
      float w = aw[(size_t)(kc * 256 + kl) * 6144 + cb + col];
#pragma unroll
      for (int r = 0; r < 17; ++r) acc[r] += s[r * 256 + kl] * w;
    }
  }
#pragma unroll
  for (int r = 0; r < 17; ++r) red[(kg * 17 + r) * 64 + col] = acc[r];
  __syncthreads();
  float* mod = (float*)(p.ws + OFF_MOD);
  for (int idx = tid; idx < 17 * 64; idx += 256) {
    int r = idx >> 6, c2 = idx & 63;
    float v = red[(0 * 17 + r) * 64 + c2] + red[(1 * 17 + r) * 64 + c2] + red[(2 * 17 + r) * 64 + c2] + red[(3 * 17 + r) * 64 + c2];
    v += p.in[I_ADAB][l * 6144 + cb + c2];
    mod[(size_t)(l * 17 + r) * 6144 + cb + c2] = v;
  }
  __syncthreads();
}

__device__ __forceinline__ void phase_prep(const Params& p, int bid, int nb) {
  constexpr int T_PER_LAYER = 736 + 256 + 16 * 384 + 18 + 16 + 16;
  constexpr int NT = 2 * T_PER_LAYER;
  if (bid == 0 && threadIdx.x < 64) ((int*)(p.ws + OFF_CNT))[threadIdx.x] = 0;
  for (int it = bid; it < 192 + 128 + NT; it += nb) {
    if (it < 192) { mod_item(p, it); continue; }
    if (it < 320) {
      int idx = (it - 192) * 256 + threadIdx.x;
      int n = idx >> 4, i = idx & 15;
      float inv = powf(10000.f, -(float)(i & 7) / 8.f);
      float pos = (i < 8) ? (float)(n >> 6) : (float)(n & 63);
      float ang = pos * inv;
      float* rt = (float*)(p.ws + OFF_ROPE);
      rt[idx * 2] = cosf(ang); rt[idx * 2 + 1] = sinf(ang);
      continue;
    }
    int tt = it - 320;
    int l = tt / T_PER_LAYER, r = tt % T_PER_LAYER;
    if (r < 736) {
      int tk = r / 46, tn = r % 46;
      transpose_tile(p.in[I_WIN] + (size_t)l * DM * INC, INC, tk * 64, tn * 64, (bf16_t*)(p.ws + OFF_WINT) + (size_t)l * INP * DM, DM, 0);
    } else if (r < 992) {
      r -= 736;
      int tk = r / 16, tn = r % 16;
      transpose_tile(p.in[I_WOUT] + (size_t)l * DM * DM, DM, tk * 64, tn * 64, (bf16_t*)(p.ws + OFF_WOUTT) + (size_t)l * DM * DM, DM, 0);
    } else if (r >= 992 + 16 * 384) {
      r -= 992 + 16 * 384;
      if (r < 18) {
        int tk = r / 6, tn = r % 6;
        transpose_tile(p.in[I_MWQ] + (size_t)l * 192 * 384, 384, tk * 64, tn * 64, (bf16_t*)(p.ws + OFF_WQT) + (size_t)l * 384 * 192, 192, 0);
      } else if (r < 34) {
        r -= 18;
        int tk = r / 8, tn = r % 8;
        transpose_tile(p.in[I_MWKV] + (size_t)l * 128 * 512, 512, tk * 64, tn * 64, (bf16_t*)(p.ws + OFF_WKVT) + (size_t)l * 512 * 128, 128, 0);
      } else {
        r -= 34;
        int d = r >> 3, gate = (r >> 2) & 1, h = r & 3;
        const float* src = (gate == 0 ? p.in[I_LWR] : p.in[I_LWI]) + (size_t)((l * 2 + d) * 4 + h) * 4096;
        transpose_tile(src, 64, 0, 0, (bf16_t*)(p.ws + OFF_LRUW) + (size_t)(((l * 2 + d) * 2 + gate) * 4 + h) * 4096, 64, 0);
      }
    } else {
      r -= 992;
      int e = r / 384, rr = r % 384, sub = rr / 128, t = rr % 128;
      size_t le = (size_t)(l * NEXP + e);
      if (sub < 2) {
        int tk = t / 8, tn = t % 8;
        const float* src = (sub == 0 ? p.in[I_WG] : p.in[I_WU]) + le * DM * FF;
        transpose_tile(src, FF, tk * 64, tn * 64, (bf16_t*)(p.ws + OFF_WGU) + le * 1024 * DM, DM, sub == 0 ? 1 : 2);
      } else {
        int tk = t / 16, tn = t % 16;
        transpose_tile(p.in[I_WD] + le * FF * DM, DM, tk * 64, tn * 64, (bf16_t*)(p.ws + OFF_WDT) + le * DM * FF, FF, 0);
      }
    }
  }
}

__device__ __forceinline__ void phase_norm(const Params& p, int layer, int which, int srcmode, int nrows, int bid, int nb) {
  const int wave = threadIdx.x >> 6, lane = threadIdx.x & 63;
  const float* nw = (which == 0 ? p.in[I_N1W] : p.in[I_N2W]) + layer * DM;
  bf16_t* dstb = (bf16_t*)(p.ws + (which == 0 ? OFF_ACTA : OFF_ACTB));
  const float* wr = p.in[I_ROUT] + (size_t)layer * DM * NEXP;
  for (int row = bid * 4 + wave; row < nrows; row += nb * 4) {
    const float4* src = (const float4*)xrow_src(p, srcmode, row);
    const int mr = modrow(row);
    const float4* sh = (const float4*)modptr(p, layer, mr, which == 0 ? 0 : 3);
    const float4* sc = (const float4*)modptr(p, layer, mr, which == 0 ? 1 : 4);
    float4 v[4];
    float ss = 0.f;
#pragma unroll
    for (int j = 0; j < 4; ++j) {
      v[j] = src[j * 64 + lane];
      ss += v[j].x * v[j].x + v[j].y * v[j].y + v[j].z * v[j].z + v[j].w * v[j].w;
    }
    ss = wave_sum(ss);
    const float rstd = rsqrtf(ss * (1.f / DM) + EPSF);
    float lg[16];
#pragma unroll
    for (int e = 0; e < 16; ++e) lg[e] = 0.f;
#pragma unroll
    for (int j = 0; j < 4; ++j) {
      float4 w4 = ((const float4*)nw)[j * 64 + lane];
      float4 s4 = sh[j * 64 + lane], c4 = sc[j * 64 + lane];
      float h0 = v[j].x * rstd * w4.x * (1.f + c4.x) + s4.x;
      float h1 = v[j].y * rstd * w4.y * (1.f + c4.y) + s4.y;
      float h2 = v[j].z * rstd * w4.z * (1.f + c4.z) + s4.z;
      float h3 = v[j].w * rstd * w4.w * (1.f + c4.w) + s4.w;
      uint2 o;
      o.x = (unsigned)f2bf(h0) | ((unsigned)f2bf(h1) << 16);
      o.y = (unsigned)f2bf(h2) | ((unsigned)f2bf(h3) << 16);
      ((uint2*)(dstb + (size_t)row * DM))[j * 64 + lane] = o;
      if (which == 1) {
        const int k = j * 256 + lane * 4;
        float hh[4] = {h0, h1, h2, h3};
#pragma unroll
        for (int i = 0; i < 4; ++i) {
          const float4* wp = (const float4*)(wr + (size_t)(k + i) * NEXP);
#pragma unroll
          for (int q = 0; q < 4; ++q) {
            float4 w = wp[q];
            lg[q * 4 + 0] += hh[i] * w.x; lg[q * 4 + 1] += hh[i] * w.y; lg[q * 4 + 2] += hh[i] * w.z; lg[q * 4 + 3] += hh[i] * w.w;
          }
        }
      }
    }
    if (which == 1) {
      float mx = -1e30f;
#pragma unroll
      for (int e = 0; e < 16; ++e) { lg[e] = wave_sum(lg[e]); mx = fmaxf(mx, lg[e]); }
      float den = 0.f, mine = 0.f;
#pragma unroll
      for (int e = 0; e < 16; ++e) { float pe = expf(lg[e] - mx); den += pe; if (lane == e) mine = pe; }
      if (lane < 16) {
        float* aff = (float*)(p.ws + OFF_AFF);
        size_t idx;
        if (row < NLAT) { int b = row >> 11, n = row & 2047; idx = ((size_t)(b * NEXP + lane)) * SEQ + n; }
        else { int rr = row - NLAT; int b = rr >> 8, n = rr & 255; idx = (size_t)NB * NEXP * SEQ + ((size_t)(b * NEXP + lane)) * CTXL + n; }
        aff[idx] = mine / den;
      }
    }
  }
}

template <int EPI>
__device__ __forceinline__ void gemm_tile(const Params& p, int layer, int srcmode, const bf16_t* __restrict__ A, int lda, const int* __restrict__ rowl, int arow0,
                          const bf16_t* __restrict__ Bt, int ldb, int bcol0, int K, int orow0) {
  bf16_t* SA = (bf16_t*)dynsmem;
  bf16_t* SB = SA + 128 * 32;
  const int tid = threadIdx.x, wid = tid >> 6, lane = tid & 63, wr = wid >> 1, wc = wid & 1, fr = lane & 15, fq = lane >> 4;
  const bf16_t* ap[2];
  const bf16_t* bp[2];
#pragma unroll
  for (int i = 0; i < 2; ++i) {
    int b = tid * 16 + i * 4096;
    int r = b >> 6, c = (b & 63) >> 1;
    int ar = arow0 + r;
    if (rowl) ar = rowl[ar];
    ap[i] = A + (size_t)ar * lda + c;
    bp[i] = Bt + (size_t)(bcol0 + r) * ldb + c;
  }
  f32x4 acc[4][4];
#pragma unroll
  for (int m = 0; m < 4; ++m)
#pragma unroll
    for (int n = 0; n < 4; ++n) acc[m][n] = (f32x4){0.f, 0.f, 0.f, 0.f};
  const int nk = K >> 5;
  for (int kt = 0; kt < nk; ++kt) {
#pragma unroll
    for (int i = 0; i < 2; ++i) {
      int b = tid * 16 + i * 4096;
      __builtin_amdgcn_global_load_lds((const unsigned*)(ap[i] + kt * 32), (unsigned*)((char*)SA + b), 16, 0, 0);
      __builtin_amdgcn_global_load_lds((const unsigned*)(bp[i] + kt * 32), (unsigned*)((char*)SB + b), 16, 0, 0);
    }
    asm volatile("s_waitcnt vmcnt(0)" ::: "memory");
    __syncthreads();
    bf16x8 af[4], bfr[4];
#pragma unroll
    for (int m = 0; m < 4; ++m) af[m] = *reinterpret_cast<const bf16x8*>((const char*)SA + (wr * 64 + m * 16 + fr) * 64 + fq * 16);
#pragma unroll
    for (int n = 0; n < 4; ++n) bfr[n] = *reinterpret_cast<const bf16x8*>((const char*)SB + (wc * 64 + n * 16 + fr) * 64 + fq * 16);
#pragma unroll
    for (int m = 0; m < 4; ++m)
#pragma unroll
      for (int n = 0; n < 4; ++n) acc[m][n] = __builtin_amdgcn_mfma_f32_16x16x32_bf16(af[m], bfr[n], acc[m][n], 0, 0, 0);
    __syncthreads();
  }
  if (EPI == 0) {
    bf16_t* U = (bf16_t*)(p.ws + OFF_U);
#pragma unroll
    for (int m = 0; m < 4; ++m)
#pragma unroll
      for (int n = 0; n < 4; ++n)
#pragma unroll
        for (int j = 0; j < 4; ++j) {
          int row = orow0 + wr * 64 + m * 16 + fq * 4 + j, col = bcol0 + wc * 64 + n * 16 + fr;
          U[(size_t)row * INP + col] = f2bf(acc[m][n][j]);
        }
  } else if (EPI == 1) {
#pragma unroll
    for (int m = 0; m < 4; ++m)
#pragma unroll
      for (int j = 0; j < 4; ++j) {
        int row = orow0 + wr * 64 + m * 16 + fq * 4 + j;
        const float* xs = xrow_src(p, srcmode, row);
        float* xd = xrow_dst(p, row);
        const float* g2 = modptr(p, layer, modrow(row), 2);
#pragma unroll
        for (int n = 0; n < 4; ++n) {
          int col = bcol0 + wc * 64 + n * 16 + fr;
          xd[col] = xs[col] + g2[col] * acc[m][n][j];
        }
      }
  } else if (EPI == 2) {
    bf16_t* ACT = (bf16_t*)(p.ws + OFF_ACTA);
#pragma unroll
    for (int m = 0; m < 4; ++m)
#pragma unroll
      for (int j = 0; j < 4; ++j) {
        int sr = orow0 + wr * 64 + m * 16 + fq * 4 + j;
#pragma unroll
        for (int nn = 0; nn < 2; ++nn) {
          int f = (((bcol0 + wc * 64) >> 5) + nn) * 16 + fr;
          float g = acc[m][2 * nn][j], u = acc[m][2 * nn + 1][j];
          ACT[(size_t)sr * FF + f] = f2bf(siluf_(g) * u);
        }
      }
  } else {
    const int* ROWL = (const int*)(p.ws + OFF_ROWL);
    const float* GATE = (const float*)(p.ws + OFF_GATE);
#pragma unroll
    for (int m = 0; m < 4; ++m)
#pragma unroll
      for (int j = 0; j < 4; ++j) {
        int sr = orow0 + wr * 64 + m * 16 + fq * 4 + j;
        int tok = ROWL[sr];
        float gt = GATE[sr];
        float* xd = xrow_dst(p, tok);
        const float* g5 = modptr(p, layer, modrow(tok), 5);
#pragma unroll
        for (int n = 0; n < 4; ++n) {
          int col = bcol0 + wc * 64 + n * 16 + fr;
          unsafeAtomicAdd(xd + col, g5[col] * gt * acc[m][n][j]);
        }
      }
  }
}

__device__ __forceinline__ void phase_inproj(const Params& p, int layer, int bid, int nb) {
  const bf16_t* A = (const bf16_t*)(p.ws + OFF_ACTA);
  const bf16_t* Bt = (const bf16_t*)(p.ws + OFF_WINT) + (size_t)layer * INP * DM;
  constexpr int MT = NTOK / 128, NT = INP / 128;
  for (int t = bid; t < MT * NT; t += nb) {
    int mt = t / NT, nt = t % NT;
    gemm_tile<0>(p, layer, 0, A, DM, nullptr, mt * 128, Bt, DM, nt * 128, DM, mt * 128);
  }
}
__device__ __forceinline__ void phase_outproj(const Params& p, int layer, int bid, int nb) {
  const bf16_t* A = (const bf16_t*)(p.ws + OFF_ACTA);
  const bf16_t* Bt = (const bf16_t*)(p.ws + OFF_WOUTT) + (size_t)layer * DM * DM;
  const int MT = (layer == 0 ? NTOK : NLAT) / 128, NT = DM / 128;
  for (int t = bid; t < MT * NT; t += nb) {
    int mt = t / NT, nt = t % NT;
    gemm_tile<1>(p, layer, layer == 0 ? 0 : 1, A, DM, nullptr, mt * 128, Bt, DM, nt * 128, DM, mt * 128);
  }
}
__device__ __forceinline__ void phase_moe1(const Params& p, int layer, int bid, int nb) {
  const bf16_t* A = (const bf16_t*)(p.ws + OFF_ACTB);
  const int* ROWL = (const int*)(p.ws + OFF_ROWL);
  const int MT = (layer == 0 ? SLOTS : SLOTS_L) / 128;
  for (int t = bid; t < NEXP * MT * 8; t += nb) {
    int e = t / (MT * 8), r = t % (MT * 8), nt = r / MT, mt = r % MT;
    const bf16_t* Bt = (const bf16_t*)(p.ws + OFF_WGU) + (size_t)(layer * NEXP + e) * 1024 * DM;
    gemm_tile<2>(p, layer, 0, A, DM, ROWL, e * SLOTS + mt * 128, Bt, DM, nt * 128, DM, e * SLOTS + mt * 128);
  }
}
__device__ __forceinline__ void phase_moe2(const Params& p, int layer, int bid, int nb) {
  const bf16_t* A = (const bf16_t*)(p.ws + OFF_ACTA);
  const int MT = (layer == 0 ? SLOTS : SLOTS_L) / 128;
  for (int t = bid; t < NEXP * MT * 8; t += nb) {
    int e = t / (MT * 8), r = t % (MT * 8), nt = r / MT, mt = r % MT;
    const bf16_t* Bt = (const bf16_t*)(p.ws + OFF_WDT) + (size_t)(layer * NEXP + e) * DM * FF;
    gemm_tile<3>(p, layer, 0, A, FF, nullptr, e * SLOTS + mt * 128, Bt, FF, nt * 128, FF, e * SLOTS + mt * 128);
  }
}

__device__ __forceinline__ void phase_mlaproj(const Params& p, int layer, int bid, int nb) {
  float* cq = (float*)dynsmem;
  float* ckv = cq + 192;
  float* kr = ckv + 128;
  float* qv = kr + 32;
  float* kvv = qv + 384;
  float* sc = kvv + 512;
  const int tid = threadIdx.x, wave = tid >> 6, lane = tid & 63;
  const bf16_t* U = (const bf16_t*)(p.ws + OFF_U);
  const float* qan = p.in[I_MQAN] + layer * 192;
  const float* kvan = p.in[I_MKVAN] + layer * 128;
  const float* wq = p.in[I_MWQ] + (size_t)layer * 192 * 384;
  const float* wkv = p.in[I_MWKV] + (size_t)layer * 128 * 512;
  const float* qn = p.in[I_MQN] + layer * 96;
  const float* kn = p.in[I_MKN] + layer * 96;
  bf16_t* QB = (bf16_t*)(p.ws + OFF_ACTB + QB_OFF);
  bf16_t* KB = (bf16_t*)(p.ws + OFF_ACTB + KB_OFF);
  bf16_t* VB = (bf16_t*)(p.ws + OFF_ACTB + VB_OFF);
  for (int row = bid; row < NTOK; row += nb) {
    const bool lat = row < NLAT;
    const int b = lat ? (row >> 11) : ((row - NLAT) >> 8);
    const int n = lat ? (row & 2047) : ((row - NLAT) & 255);
    const int key = lat ? (CTXL + n) : n;
    const bf16_t* ur = U + (size_t)row * INP + 2568;
    __syncthreads();
    if (tid < 192) cq[tid] = bf2f(ur[tid]);
    if (tid < 128) ckv[tid] = bf2f(ur[192 + tid]);
    if (tid < 32) kr[tid] = bf2f(ur[320 + tid]);
    __syncthreads();
    if (wave == 0) {
      float s = cq[lane] * cq[lane] + cq[64 + lane] * cq[64 + lane] + cq[128 + lane] * cq[128 + lane];
      s = wave_sum(s);
      if (lane == 0) sc[0] = rsqrtf(s * (1.f / 192.f) + EPSF);
    } else if (wave == 1) {
      float s = ckv[lane] * ckv[lane] + ckv[64 + lane] * ckv[64 + lane];
      s = wave_sum(s);
      if (lane == 0) sc[1] = rsqrtf(s * (1.f / 128.f) + EPSF);
    } else if (wave == 2) {
      float s = lane < 32 ? kr[lane] * kr[lane] : 0.f;
      s = wave_sum(s);
      if (lane == 0) sc[2] = rsqrtf(s * (1.f / 32.f) + EPSF);
    }
    __syncthreads();
    if (tid < 192) cq[tid] = cq[tid] * sc[0] * qan[tid];
    if (tid < 128) ckv[tid] = ckv[tid] * sc[1] * kvan[tid];
    __syncthreads();
    {
      float a0 = 0.f, a1 = 0.f;
      for (int k = 0; k < 192; ++k) {
        float x = cq[k];
        a0 += x * wq[k * 384 + tid];
        if (tid < 128) a1 += x * wq[k * 384 + 256 + tid];
      }
      qv[tid] = a0;
      if (tid < 128) qv[256 + tid] = a1;
      float b0 = 0.f, b1 = 0.f;
      for (int k = 0; k < 128; ++k) {
        float x = ckv[k];
        b0 += x * wkv[k * 512 + tid];
        b1 += x * wkv[k * 512 + 256 + tid];
      }
      kvv[tid] = b0;
      kvv[256 + tid] = b1;
    }
    __syncthreads();
    {
      const int h = wave;
      const int pi = (lane & 31) >> 1;
      const float inv = powf(10000.f, -(float)(pi & 7) / 8.f);
      const float pos = (pi < 8) ? (float)(n >> 6) : (float)(n & 63);
      const float ang = pos * inv;
      const float cs = cosf(ang), sn = sinf(ang);
      float x = qv[h * 96 + lane];
      float s = wave_sum(x * x);
      float qn_v = x * rsqrtf(s * (1.f / 64.f) + EPSF) * qn[lane];
      float xr = lane < 32 ? qv[h * 96 + 64 + lane] : 0.f;
      float s2 = wave_sum(xr * xr);
      float qr_v = lane < 32 ? xr * rsqrtf(s2 * (1.f / 32.f) + EPSF) * qn[64 + lane] : 0.f;
      float y = kvv[h * 128 + lane];
      float s3 = wave_sum(y * y);
      float kn_v = y * rsqrtf(s3 * (1.f / 64.f) + EPSF) * kn[lane];
      float kk = lane < 32 ? kr[lane] * sc[2] * kn[64 + lane] : 0.f;
      if (lat) {
        float qo = __shfl_xor(qr_v, 1), ko = __shfl_xor(kk, 1);
        if (lane & 1) { qr_v = qo * sn + qr_v * cs; kk = ko * sn + kk * cs; }
        else { qr_v = qr_v * cs - qo * sn; kk = kk * cs - ko * sn; }
      }
      const float qscale = 0.10206207261596577f;
      bf16_t* qd = QB + ((size_t)row * 4 + h) * 96;
      bf16_t* kd = KB + (((size_t)(b * 4 + h)) * NKEY + key) * 96;
      bf16_t* vd = VB + (((size_t)(b * 4 + h)) * NKEY + key) * 64;
      qd[lane] = f2bf(qn_v * qscale);
      kd[lane] = f2bf(kn_v);
      if (lane < 32) { qd[64 + lane] = f2bf(qr_v * qscale); kd[64 + lane] = f2bf(kk); }
      vd[lane] = f2bf(kvv[h * 128 + 64 + lane]);
    }
  }
}

__device__ __forceinline__ void chain_lru(const Params& p, int L, int b) {
  float* xs = (float*)dynsmem;
  const int tid = threadIdx.x, h = tid >> 6, lane = tid & 63, ch = h * 64 + lane;
  const bf16_t* U = (const bf16_t*)(p.ws + OFF_U);
  bf16_t* Y = (bf16_t*)(p.ws + OFF_ACTA);
  float cw[4];
#pragma unroll
  for (int j = 0; j < 4; ++j) cw[j] = p.in[I_LCW][(L * 4 + j) * 256 + ch];
  const float cb = p.in[I_LCB][L * 256 + ch];
  for (int d = 0; d < 2; ++d) {
    float wrc[64], wic[64];
    const float* wr = p.in[I_LWR] + (size_t)((L * 2 + d) * 4 + h) * 4096;
    const float* wi = p.in[I_LWI] + (size_t)((L * 2 + d) * 4 + h) * 4096;
#pragma unroll
    for (int k = 0; k < 64; ++k) { wrc[k] = wr[k * 64 + lane]; wic[k] = wi[k * 64 + lane]; }
    const float br = p.in[I_LBR][(L * 2 + d) * 256 + ch], bi = p.in[I_LBI][(L * 2 + d) * 256 + ch];
    const float lam = p.in[I_LLAM][(L * 2 + d) * 256 + ch];
    const float sp = softplusf_(-lam);
    float hst = 0.f;
    for (int seg = 0; seg < 2; ++seg) {
      const int seglen = seg == 0 ? CTXL : SEQ;
      const int rowbase = seg == 0 ? NLAT + b * CTXL : b * SEQ;
      const bool wout = !(L == 1 && seg == 0);
      for (int i = 0; i < seglen; ++i) {
        const int t = d ? seglen - 1 - i : i;
        float xc = cb;
#pragma unroll
        for (int j = 0; j < 4; ++j) {
          int tt = t + j - 2;
          if (tt >= 0 && tt < seglen) xc += bf2f(U[(size_t)(rowbase + tt) * INP + ch]) * cw[j];
        }
        __syncthreads();
        xs[tid] = xc;
        __syncthreads();
        float r = br, ii = bi;
#pragma unroll
        for (int k = 0; k < 64; ++k) { float xv = xs[h * 64 + k]; r += xv * wrc[k]; ii += xv * wic[k]; }
        r = sigmoidf_(r); ii = sigmoidf_(ii);
        float log_a = -8.f * r * sp;
        float a = expf(log_a);
        float bb = sqrtf(-expm1f(2.f * log_a)) * (ii * xc);
        hst = a * hst + bb;
        if (wout) {
          const size_t row = (size_t)(rowbase + t);
          if (d == 0) Y[row * DM + ch] = f2bf(hst);
          else {
            float tot = bf2f(Y[row * DM + ch]) + hst;
            float gate = bf2f(U[row * INP + 256 + ch]);
            Y[row * DM + ch] = f2bf(tot * gelu_tanh(gate));
          }
        }
      }
    }
  }
}

__device__ __forceinline__ void chain_hgrn(const Params& p, int L, int b) {
  float* lq = (float*)dynsmem;
  float* lf = lq + 256;
  const int tid = threadIdx.x, h = tid >> 6, lane = tid & 63, ch = h * 64 + lane;
  const bf16_t* U = (const bf16_t*)(p.ws + OFF_U);
  bf16_t* Y = (bf16_t*)(p.ws + OFF_ACTA);
  float lb = 0.f;
  if (L == 1) lb = sigmoidf_(p.in[I_HLB][256 + ch] - p.in[I_HLB][ch]);
  const float nwv = p.in[I_HNW][L * 256 + ch];
  for (int d = 0; d < 2; ++d) {
    float S[64];
#pragma unroll
    for (int k = 0; k < 64; ++k) S[k] = 0.f;
    for (int seg = 0; seg < 2; ++seg) {
      const int seglen = seg == 0 ? CTXL : SEQ;
      const int rowbase = seg == 0 ? NLAT + b * CTXL : b * SEQ;
      const bool wout = !(L == 1 && seg == 0);
      for (int i = 0; i < seglen; ++i) {
        const int t = d ? seglen - 1 - i : i;
        const size_t row = (size_t)(rowbase + t);
        const bf16_t* ur = U + row * INP;
        float qv = siluf_(bf2f(ur[512 + ch]));
        float f = lb + (1.f - lb) * sigmoidf_(bf2f(ur[768 + d * 256 + ch]));
        float vv = bf2f(ur[1280 + ch]);
        __syncthreads();
        lq[tid] = qv; lf[tid] = f;
        __syncthreads();
        float o = 0.f;
#pragma unroll
        for (int k = 0; k < 64; ++k) {
          float fk = lf[h * 64 + k];
          S[k] = fk * S[k] + (1.f - fk) * vv;
          o += lq[h * 64 + k] * S[k];
        }
        if (wout) {
          if (d == 0) Y[row * DM + 256 + ch] = f2bf(o);
          else {
            float tot = bf2f(Y[row * DM + 256 + ch]) + o;
            float ss = wave_sum(tot * tot);
            float rn = rsqrtf(ss * (1.f / 64.f) + EPSF);
            float g = bf2f(ur[1536 + ch]);
            Y[row * DM + 256 + ch] = f2bf(tot * rn * nwv * siluf_(g));
          }
        }
      }
    }
  }
}

__device__ __forceinline__ void chain_ssd(const Params& p, int L, int b) {
  float* lB = (float*)dynsmem;
  float* lC = lB + 256;
  const int tid = threadIdx.x, h = tid >> 6, lane = tid & 63, g = h >> 1;
  const bf16_t* U = (const bf16_t*)(p.ws + OFF_U);
  bf16_t* Y = (bf16_t*)(p.ws + OFF_ACTA);
  const int c_x = h * 64 + lane, c_b = 256 + g * 64 + lane, c_c = 384 + g * 64 + lane;
  float wx[4], wb[4], wcc[4];
#pragma unroll
  for (int j = 0; j < 4; ++j) {
    wx[j] = p.in[I_SCW][(L * 4 + j) * 512 + c_x];
    wb[j] = p.in[I_SCW][(L * 4 + j) * 512 + c_b];
    wcc[j] = p.in[I_SCW][(L * 4 + j) * 512 + c_c];
  }
  const float bx = p.in[I_SCB][L * 512 + c_x], bbv = p.in[I_SCB][L * 512 + c_b], bc = p.in[I_SCB][L * 512 + c_c];
  const float dsk = p.in[I_SDSK][L * 4 + h];
  for (int d = 0; d < 2; ++d) {
    const float Aa = -expf(p.in[I_SALOG][(L * 2 + d) * 4 + h]);
    const float dtb = p.in[I_SDTB][(L * 2 + d) * 4 + h];
    float S[64];
#pragma unroll
    for (int k = 0; k < 64; ++k) S[k] = 0.f;
    for (int seg = 0; seg < 2; ++seg) {
      const int seglen = seg == 0 ? CTXL : SEQ;
      const int rowbase = seg == 0 ? NLAT + b * CTXL : b * SEQ;
      const bool wout = !(L == 1 && seg == 0);
      for (int i = 0; i < seglen; ++i) {
        const int t = d ? seglen - 1 - i : i;
        const size_t row = (size_t)(rowbase + t);
        float xv = bx, Bv = bbv, Cv = bc;
#pragma unroll
        for (int j = 0; j < 4; ++j) {
          int tt = t + j - 2;
          if (tt >= 0 && tt < seglen) {
            const bf16_t* ur = U + (size_t)(rowbase + tt) * INP + 2048;
            xv += bf2f(ur[c_x]) * wx[j];
            Bv += bf2f(ur[c_b]) * wb[j];
            Cv += bf2f(ur[c_c]) * wcc[j];
          }
        }
        xv = siluf_(xv); Bv = siluf_(Bv); Cv = siluf_(Cv);
        const bf16_t* ur0 = U + row * INP;
        float dt = softplusf_(bf2f(ur0[2560 + d * 4 + h]) + dtb);
        float dec = expf(dt * Aa);
        __syncthreads();
        lB[tid] = Bv; lC[tid] = Cv;
        __syncthreads();
        float y = 0.f;
        const float dx = dt * xv;
#pragma unroll
        for (int k = 0; k < 64; ++k) {
          S[k] = dec * S[k] + dx * lB[h * 64 + k];
          y += lC[h * 64 + k] * S[k];
        }
        if (wout) {
          const size_t yi = row * DM + 512 + h * 64 + lane;
          if (d == 0) Y[yi] = f2bf(y);
          else {
            float tot = bf2f(Y[yi]) + y + dsk * xv;
            float z = bf2f(ur0[1792 + h * 64 + lane]);
            Y[yi] = f2bf(tot * siluf_(z));
          }
        }
      }
    }
  }
}

__device__ __forceinline__ unsigned pack2(float a, float b) { return (unsigned)f2bf(a) | ((unsigned)f2bf(b) << 16); }
__device__ __forceinline__ float unpk(const uint4* v, int e) {
  const unsigned* w = (const unsigned*)v;
  unsigned x = w[e >> 1];
  return (e & 1) ? __uint_as_float(x & 0xffff0000u) : __uint_as_float(x << 16);
}
__device__ __forceinline__ bf16_t unpk_raw(const uint4* v, int e) {
  const unsigned* w = (const unsigned*)v;
  unsigned x = w[e >> 1];
  return (bf16_t)((e & 1) ? (x >> 16) : (x & 0xffffu));
}
__device__ __forceinline__ void mma16(const bf16_t* At, int r0, const bf16_t* Bt, f32x4* acc, int fr, int fq) {
#pragma unroll
  for (int ks = 0; ks < 2; ++ks) {
    bf16x8 a = *(const bf16x8*)(At + (r0 + fr) * TS + ks * 32 + fq * 8);
#pragma unroll
    for (int nf = 0; nf < 4; ++nf) {
      bf16x8 b = *(const bf16x8*)(Bt + (nf * 16 + fr) * TS + ks * 32 + fq * 8);
      acc[nf] = __builtin_amdgcn_mfma_f32_16x16x32_bf16(a, b, acc[nf], 0, 0, 0);
    }
  }
}
#define CFENCE() asm volatile("" ::: "memory")

struct StepGeo { int rowbase, seglen, T0; bool wout; };
__device__ __forceinline__ StepGeo step_geo(int L, int b, int d, int s) {
  StepGeo g;
  const bool ctx = s < 4;
  const int c = ctx ? s : s - 4;
  const int nch = ctx ? (CTXL / 64) : (SEQ / 64);
  g.seglen = ctx ? CTXL : SEQ;
  g.rowbase = ctx ? NLAT + b * CTXL : b * SEQ;
  g.T0 = (d ? nch - 1 - c : c) * 64;
  g.wout = !(L == 1 && ctx);
  return g;
}

__device__ __forceinline__ void chain_hgrn_fast(const Params& p, int L, int bh) {
  const int b = bh >> 2, h = bh & 3;
  char* sm = dynsmem;
  float* CUM = (float*)sm;
  bf16_t* QT = (bf16_t*)(sm + 16640);
  bf16_t* KT = QT + 64 * TS;
  bf16_t* KE = KT + 64 * TS;
  bf16_t* VT = KE + 64 * TS;
  bf16_t* ST = VT + 64 * TS;
  float* SEG = (float*)(ST + 64 * TS);
  const int tid = threadIdx.x, w = tid >> 6, lane = tid & 63, fr = lane & 15, fq = lane >> 4;
  const int ti = tid >> 2, kq = (tid & 3) * 16;
  const bf16_t* U = (const bf16_t*)(p.ws + OFF_U);
  bf16_t* Y = (bf16_t*)(p.ws + OFF_ACTA);
  float lb[16];
#pragma unroll
  for (int e = 0; e < 16; ++e) lb[e] = (L == 1) ? sigmoidf_(p.in[I_HLB][256 + h * 64 + kq + e] - p.in[I_HLB][h * 64 + kq + e]) : 0.f;
  float nwv[4];
#pragma unroll
  for (int nf = 0; nf < 4; ++nf) nwv[nf] = p.in[I_HNW][L * 256 + h * 64 + nf * 16 + fr];
  for (int d = 0; d < 2; ++d) {
    f32x4 S[4];
#pragma unroll
    for (int nf = 0; nf < 4; ++nf) S[nf] = (f32x4){0.f, 0.f, 0.f, 0.f};
    uint4 nq[2], nfr[2], nv[2];
    {
      StepGeo g = step_geo(L, b, d, 0);
      const bf16_t* ur = U + (size_t)(g.rowbase + (d ? g.T0 + 63 - ti : g.T0 + ti)) * INP + h * 64 + kq;
      nq[0] = ((const uint4*)(ur + 512))[0]; nq[1] = ((const uint4*)(ur + 512))[1];
      nfr[0] = ((const uint4*)(ur + 768 + d * 256))[0]; nfr[1] = ((const uint4*)(ur + 768 + d * 256))[1];
      nv[0] = ((const uint4*)(ur + 1280))[0]; nv[1] = ((const uint4*)(ur + 1280))[1];
    }
    for (int s = 0; s < 36; ++s) {
      const StepGeo g = step_geo(L, b, d, s);
      uint4 cq[2] = {nq[0], nq[1]}, cf[2] = {nfr[0], nfr[1]}, cv[2] = {nv[0], nv[1]};
      if (s + 1 < 36) {
        StepGeo g2 = step_geo(L, b, d, s + 1);
        const bf16_t* ur = U + (size_t)(g2.rowbase + (d ? g2.T0 + 63 - ti : g2.T0 + ti)) * INP + h * 64 + kq;
        nq[0] = ((const uint4*)(ur + 512))[0]; nq[1] = ((const uint4*)(ur + 512))[1];
        nfr[0] = ((const uint4*)(ur + 768 + d * 256))[0]; nfr[1] = ((const uint4*)(ur + 768 + d * 256))[1];
        nv[0] = ((const uint4*)(ur + 1280))[0]; nv[1] = ((const uint4*)(ur + 1280))[1];
      }
      float qv[16], kkv[16];
#pragma unroll
      for (int e = 0; e < 16; ++e) {
        float qr = unpk(cq, e), fr_ = unpk(cf, e);
        qv[e] = siluf_(qr);
        float f = lb[e] + (1.f - lb[e]) * sigmoidf_(fr_);
        kkv[e] = 1.f - f;
        CUM[ti * 65 + kq + e] = logf(f);
      }
      __syncthreads();
      {
        float run = 0.f;
#pragma unroll
        for (int r = 0; r < 16; ++r) { int idx = (w * 16 + r) * 65 + lane; run += CUM[idx]; CUM[idx] = run; }
        SEG[w * 64 + lane] = run;
      }
      __syncthreads();
      {
        float off = 0.f;
        for (int s2 = 0; s2 < w; ++s2) off += SEG[s2 * 64 + lane];
        if (w > 0) {
#pragma unroll
          for (int r = 0; r < 16; ++r) CUM[(w * 16 + r) * 65 + lane] += off;
        }
      }
      __syncthreads();
      {
        unsigned qp[8], kp[8];
#pragma unroll
        for (int e2 = 0; e2 < 8; ++e2) {
          float qa[2], ka[2];
#pragma unroll
          for (int u = 0; u < 2; ++u) {
            const int e = e2 * 2 + u, k = kq + e;
            float ci = CUM[ti * 65 + k], cm = CUM[31 * 65 + k], ce = CUM[63 * 65 + k];
            qa[u] = qv[e] * expf(fminf(ci - cm, 80.f));
            ka[u] = kkv[e] * expf(fminf(cm - ci, 80.f));
            KE[k * TS + ti] = f2bf(kkv[e] * expf(ce - ci));
            VT[k * TS + ti] = unpk_raw(cv, e);
          }
          qp[e2] = pack2(qa[0], qa[1]);
          kp[e2] = pack2(ka[0], ka[1]);
        }
        uint4* qd = (uint4*)(QT + ti * TS + kq);
        uint4* kd = (uint4*)(KT + ti * TS + kq);
        qd[0] = make_uint4(qp[0], qp[1], qp[2], qp[3]); qd[1] = make_uint4(qp[4], qp[5], qp[6], qp[7]);
        kd[0] = make_uint4(kp[0], kp[1], kp[2], kp[3]); kd[1] = make_uint4(kp[4], kp[5], kp[6], kp[7]);
      }
      float dec[4];
#pragma unroll
      for (int nf = 0; nf < 4; ++nf) {
        const int k = nf * 16 + fr;
        float em = expf(CUM[31 * 65 + k]);
        dec[nf] = expf(CUM[63 * 65 + k]);
#pragma unroll
        for (int jj = 0; jj < 4; ++jj) ST[(16 * w + 4 * fq + jj) * TS + k] = f2bf(S[nf][jj] * em);
      }
      __syncthreads();
      f32x4 aP[4], aY[4];
#pragma unroll
      for (int nf = 0; nf < 4; ++nf) { aP[nf] = (f32x4){0.f, 0.f, 0.f, 0.f}; aY[nf] = (f32x4){0.f, 0.f, 0.f, 0.f}; }
      mma16(QT, 16 * w, KT, aP, fr, fq);
      mma16(QT, 16 * w, ST, aY, fr, fq);
      CFENCE();
#pragma unroll
      for (int nf = 0; nf < 4; ++nf)
#pragma unroll
        for (int jj = 0; jj < 4; ++jj) {
          const int t = 16 * w + 4 * fq + jj, sc = nf * 16 + fr;
          QT[t * TS + sc] = f2bf(sc <= t ? aP[nf][jj] : 0.f);
        }
      CFENCE();
      mma16(QT, 16 * w, VT, aY, fr, fq);
#pragma unroll
      for (int nf = 0; nf < 4; ++nf)
#pragma unroll
        for (int jj = 0; jj < 4; ++jj) S[nf][jj] *= dec[nf];
      mma16(VT, 16 * w, KE, S, fr, fq);
      if (g.wout) {
        if (d == 0) {
#pragma unroll
          for (int jj = 0; jj < 4; ++jj) {
            const int t = 16 * w + 4 * fq + jj;
            bf16_t* yr = Y + (size_t)(g.rowbase + g.T0 + t) * DM + 256 + h * 64;
#pragma unroll
            for (int nf = 0; nf < 4; ++nf) yr[nf * 16 + fr] = f2bf(aY[nf][jj]);
          }
        } else {
#pragma unroll
          for (int jj = 0; jj < 4; ++jj) {
            const int t = 16 * w + 4 * fq + jj;
            const size_t row = (size_t)(g.rowbase + g.T0 + 63 - t);
            bf16_t* yr = Y + row * DM + 256 + h * 64;
            const bf16_t* gr = U + row * INP + 1536 + h * 64;
            float tot[4], ss = 0.f;
#pragma unroll
            for (int nf = 0; nf < 4; ++nf) { tot[nf] = bf2f(yr[nf * 16 + fr]) + aY[nf][jj]; ss += tot[nf] * tot[nf]; }
            ss += __shfl_xor(ss, 1); ss += __shfl_xor(ss, 2); ss += __shfl_xor(ss, 4); ss += __shfl_xor(ss, 8);
            const float rn = rsqrtf(ss * (1.f / 64.f) + EPSF);
#pragma unroll
            for (int nf = 0; nf < 4; ++nf) yr[nf * 16 + fr] = f2bf(tot[nf] * rn * nwv[nf] * siluf_(bf2f(gr[nf * 16 + fr])));
          }
        }
      }
    }
    __syncthreads();
  }
}

__device__ __forceinline__ void chain_ssd_fast(const Params& p, int L, int bh) {
  const int b = bh >> 2, h = bh & 3, gg = h >> 1;
  char* sm = dynsmem;
  bf16_t* RAW = (bf16_t*)sm;
  bf16_t* CM = (bf16_t*)(sm + 26112);
  bf16_t* BM = CM + 64 * TS;
  bf16_t* XT = BM + 64 * TS;
  bf16_t* BW = XT + 64 * TS;
  bf16_t* SS = BW + 64 * TS;
  float* DT = (float*)(SS + 64 * TS);
  float* CUMV = DT + 64;
  float* CW = CUMV + 64;
  float* CB = CW + 768;
  const int tid = threadIdx.x, w = tid >> 6, lane = tid & 63, fr = lane & 15, fq = lane >> 4;
  const int ti = tid >> 2, kq = (tid & 3) * 16;
  const bf16_t* U = (const bf16_t*)(p.ws + OFF_U);
  bf16_t* Y = (bf16_t*)(p.ws + OFF_ACTA);
  __syncthreads();
  for (int i = tid; i < 960; i += 256) {
    if (i < 768) {
      int grp = i >> 8, j = (i >> 6) & 3, c = i & 63;
      int col = grp == 0 ? h * 64 + c : (grp == 1 ? 256 + gg * 64 + c : 384 + gg * 64 + c);
      CW[i] = p.in[I_SCW][(L * 4 + j) * 512 + col];
    } else {
      int i2 = i - 768; int grp = i2 >> 6, c = i2 & 63;
      int col = grp == 0 ? h * 64 + c : (grp == 1 ? 256 + gg * 64 + c : 384 + gg * 64 + c);
      CB[i2] = p.in[I_SCB][L * 512 + col];
    }
  }
  const float dsk = p.in[I_SDSK][L * 4 + h];
  for (int d = 0; d < 2; ++d) {
    const float Aa = -expf(p.in[I_SALOG][(L * 2 + d) * 4 + h]);
    const float dtb = p.in[I_SDTB][(L * 2 + d) * 4 + h];
    f32x4 S[4];
#pragma unroll
    for (int nf = 0; nf < 4; ++nf) S[nf] = (f32x4){0.f, 0.f, 0.f, 0.f};
    uint4 nraw[7];
    bf16_t ndt = 0;
#define SSD_LOAD(G)                                                                                         \
    {                                                                                                       \
      _Pragma("unroll") for (int i = 0; i < 7; ++i) {                                                       \
        int c16 = tid + 256 * i;                                                                            \
        uint4 v = make_uint4(0u, 0u, 0u, 0u);                                                               \
        if (c16 < 1632) {                                                                                   \
          int grp = c16 / 544, rem = c16 % 544, r = rem >> 3, part = rem & 7;                               \
          int t = (G).T0 - 2 + r;                                                                           \
          int gcol = grp == 0 ? 2048 + h * 64 : (grp == 1 ? 2304 + gg * 64 : 2432 + gg * 64);              \
          if (t >= 0 && t < (G).seglen) v = *(const uint4*)(U + (size_t)((G).rowbase + t) * INP + gcol + part * 8); \
        }                                                                                                   \
        nraw[i] = v;                                                                                        \
      }                                                                                                     \
      if (tid < 64) ndt = U[(size_t)((G).rowbase + (d ? (G).T0 + 63 - tid : (G).T0 + tid)) * INP + 2560 + d * 4 + h]; \
    }
    { StepGeo g0 = step_geo(L, b, d, 0); SSD_LOAD(g0); }
    for (int s = 0; s < 36; ++s) {
      const StepGeo g = step_geo(L, b, d, s);
      __syncthreads();
#pragma unroll
      for (int i = 0; i < 7; ++i) {
        int c16 = tid + 256 * i;
        if (c16 < 1632) *(uint4*)(RAW + c16 * 8) = nraw[i];
      }
      if (tid < 64) {
        float dt = softplusf_(bf2f(ndt) + dtb);
        float v = dt * Aa;
#pragma unroll
        for (int o = 1; o < 64; o <<= 1) { float n = __shfl_up(v, o); if (lane >= o) v += n; }
        DT[tid] = dt; CUMV[tid] = v;
      }
      if (s + 1 < 36) { StepGeo g2 = step_geo(L, b, d, s + 1); SSD_LOAD(g2); }
      __syncthreads();
      {
        const int tn = d ? 63 - ti : ti;
        const float cend = CUMV[63];
        const float wend = DT[ti] * expf(cend - CUMV[ti]);
#pragma unroll
        for (int grp = 0; grp < 3; ++grp) {
          float val[16];
#pragma unroll
          for (int e = 0; e < 16; ++e) val[e] = CB[grp * 64 + kq + e];
#pragma unroll
          for (int j = 0; j < 4; ++j) {
            const uint4* rp = (const uint4*)(RAW + (grp * 68 + tn + j) * 64 + kq);
            uint4 rr[2] = {rp[0], rp[1]};
#pragma unroll
            for (int e = 0; e < 16; ++e) val[e] += unpk(rr, e) * CW[(grp * 4 + j) * 64 + kq + e];
          }
#pragma unroll
          for (int e = 0; e < 16; ++e) val[e] = siluf_(val[e]);
          if (grp == 0) {
#pragma unroll
            for (int e = 0; e < 16; ++e) XT[(kq + e) * TS + ti] = f2bf(val[e]);
          } else {
            unsigned pk[8];
#pragma unroll
            for (int e2 = 0; e2 < 8; ++e2) pk[e2] = pack2(val[2 * e2], val[2 * e2 + 1]);
            uint4* dst = (uint4*)((grp == 1 ? BM : CM) + ti * TS + kq);
            dst[0] = make_uint4(pk[0], pk[1], pk[2], pk[3]); dst[1] = make_uint4(pk[4], pk[5], pk[6], pk[7]);
            if (grp == 1) {
#pragma unroll
              for (int e = 0; e < 16; ++e) BW[(kq + e) * TS + ti] = f2bf(val[e] * wend);
            }
          }
        }
      }
      float cumt[4], cums[4], dts[4];
      const float cend = CUMV[63];
#pragma unroll
      for (int jj = 0; jj < 4; ++jj) cumt[jj] = CUMV[16 * w + 4 * fq + jj];
#pragma unroll
      for (int nf = 0; nf < 4; ++nf) {
        cums[nf] = CUMV[nf * 16 + fr]; dts[nf] = DT[nf * 16 + fr];
#pragma unroll
        for (int jj = 0; jj < 4; ++jj) SS[(16 * w + 4 * fq + jj) * TS + nf * 16 + fr] = f2bf(S[nf][jj]);
      }
      __syncthreads();
      f32x4 aP[4], aY[4];
#pragma unroll
      for (int nf = 0; nf < 4; ++nf) { aP[nf] = (f32x4){0.f, 0.f, 0.f, 0.f}; aY[nf] = (f32x4){0.f, 0.f, 0.f, 0.f}; }
      mma16(CM, 16 * w, BM, aP, fr, fq);
      mma16(CM, 16 * w, SS, aY, fr, fq);
      CFENCE();
#pragma unroll
      for (int nf = 0; nf < 4; ++nf)
#pragma unroll
        for (int jj = 0; jj < 4; ++jj) {
          const int t = 16 * w + 4 * fq + jj, sc = nf * 16 + fr;
          float pv = sc <= t ? aP[nf][jj] * expf(cumt[jj] - cums[nf]) * dts[nf] : 0.f;
          CM[t * TS + sc] = f2bf(pv);
          aY[nf][jj] *= expf(cumt[jj]);
        }
      CFENCE();
      mma16(CM, 16 * w, XT, aY, fr, fq);
      {
        const float de = expf(cend);
#pragma unroll
        for (int nf = 0; nf < 4; ++nf)
#pragma unroll
          for (int jj = 0; jj < 4; ++jj) S[nf][jj] *= de;
      }
      mma16(XT, 16 * w, BW, S, fr, fq);
      if (g.wout) {
#pragma unroll
        for (int jj = 0; jj < 4; ++jj) {
          const int t = 16 * w + 4 * fq + jj;
          const size_t row = (size_t)(g.rowbase + (d ? g.T0 + 63 - t : g.T0 + t));
          bf16_t* yr = Y + row * DM + 512 + h * 64;
          if (d == 0) {
#pragma unroll
            for (int nf = 0; nf < 4; ++nf) yr[nf * 16 + fr] = f2bf(aY[nf][jj]);
          } else {
            const bf16_t* zr = U + row * INP + 1792 + h * 64;
#pragma unroll
            for (int nf = 0; nf < 4; ++nf) {
              const int pc = nf * 16 + fr;
              float tot = bf2f(yr[pc]) + aY[nf][jj] + dsk * bf2f(XT[pc * TS + t]);
              yr[pc] = f2bf(tot * siluf_(bf2f(zr[pc])));
            }
          }
        }
      }
    }
    __syncthreads();
  }
#undef SSD_LOAD
}

__device__ __forceinline__ void chain_lru_fast(const Params& p, int L, int bh) {
  const int b = bh >> 2, h = bh & 3;
  char* sm = dynsmem;
  bf16_t* RAW = (bf16_t*)sm;
  bf16_t* XC = (bf16_t*)(sm + 8704);
  bf16_t* WR = XC + 64 * TS;
  bf16_t* WI = WR + 64 * TS;
  float* AA = (float*)(WI + 64 * TS);
  float* BB = AA + 64 * 65;
  float* SEGA = BB + 64 * 65;
  float* SEGB = SEGA + 256;
  float* CW = SEGB + 256;
  float* CB = CW + 256;
  const int tid = threadIdx.x, w = tid >> 6, lane = tid & 63, fr = lane & 15, fq = lane >> 4;
  const int ti = tid >> 2, kq = (tid & 3) * 16;
  const bf16_t* U = (const bf16_t*)(p.ws + OFF_U);
  bf16_t* Y = (bf16_t*)(p.ws + OFF_ACTA);
  __syncthreads();
  for (int i = tid; i < 320; i += 256) {
    if (i < 256) CW[i] = p.in[I_LCW][(L * 4 + (i >> 6)) * 256 + h * 64 + (i & 63)];
    else CB[i - 256] = p.in[I_LCB][L * 256 + h * 64 + (i - 256)];
  }
  for (int d = 0; d < 2; ++d) {
    __syncthreads();
    {
      const bf16_t* wrs = (const bf16_t*)(p.ws + OFF_LRUW) + (size_t)(((L * 2 + d) * 2 + 0) * 4 + h) * 4096;
      const bf16_t* wis = (const bf16_t*)(p.ws + OFF_LRUW) + (size_t)(((L * 2 + d) * 2 + 1) * 4 + h) * 4096;
      for (int c = tid; c < 512; c += 256) {
        int r = c >> 3, part = c & 7;
        *(uint4*)(WR + r * TS + part * 8) = *(const uint4*)(wrs + r * 64 + part * 8);
        *(uint4*)(WI + r * TS + part * 8) = *(const uint4*)(wis + r * 64 + part * 8);
      }
    }
    float br[4], bi[4], sp[4];
#pragma unroll
    for (int nf = 0; nf < 4; ++nf) {
      const int ch = (L * 2 + d) * 256 + h * 64 + nf * 16 + fr;
      br[nf] = p.in[I_LBR][ch]; bi[nf] = p.in[I_LBI][ch]; sp[nf] = softplusf_(-p.in[I_LLAM][ch]);
    }
    float hst = 0.f;
    uint4 nraw[3];
#define LRU_LOAD(G)                                                                                         \
    {                                                                                                       \
      _Pragma("unroll") for (int i = 0; i < 3; ++i) {                                                       \
        int c16 = tid + 256 * i;                                                                            \
        uint4 v = make_uint4(0u, 0u, 0u, 0u);                                                               \
        if (c16 < 544) {                                                                                    \
          int r = c16 >> 3, part = c16 & 7;                                                                 \
          int t = (G).T0 - 2 + r;                                                                           \
          if (t >= 0 && t < (G).seglen) v = *(const uint4*)(U + (size_t)((G).rowbase + t) * INP + h * 64 + part * 8); \
        }                                                                                                   \
        nraw[i] = v;                                                                                        \
      }                                                                                                     \
    }
    { StepGeo g0 = step_geo(L, b, d, 0); LRU_LOAD(g0); }
    for (int s = 0; s < 36; ++s) {
      const StepGeo g = step_geo(L, b, d, s);
      __syncthreads();
#pragma unroll
      for (int i = 0; i < 3; ++i) {
        int c16 = tid + 256 * i;
        if (c16 < 544) *(uint4*)(RAW + c16 * 8) = nraw[i];
      }
      if (s + 1 < 36) { StepGeo g2 = step_geo(L, b, d, s + 1); LRU_LOAD(g2); }
      __syncthreads();
      {
        const int tn = d ? 63 - ti : ti;
        float val[16];
#pragma unroll
        for (int e = 0; e < 16; ++e) val[e] = CB[kq + e];
#pragma unroll
        for (int j = 0; j < 4; ++j) {
          const uint4* rp = (const uint4*)(RAW + (tn + j) * 64 + kq);
          uint4 rr[2] = {rp[0], rp[1]};
#pragma unroll
          for (int e = 0; e < 16; ++e) val[e] += unpk(rr, e) * CW[j * 64 + kq + e];
        }
        unsigned pk[8];
#pragma unroll
        for (int e2 = 0; e2 < 8; ++e2) pk[e2] = pack2(val[2 * e2], val[2 * e2 + 1]);
        uint4* dst = (uint4*)(XC + ti * TS + kq);
        dst[0] = make_uint4(pk[0], pk[1], pk[2], pk[3]); dst[1] = make_uint4(pk[4], pk[5], pk[6], pk[7]);
      }
      __syncthreads();
      {
        f32x4 aR[4], aI[4];
#pragma unroll
        for (int nf = 0; nf < 4; ++nf) { aR[nf] = (f32x4){0.f, 0.f, 0.f, 0.f}; aI[nf] = (f32x4){0.f, 0.f, 0.f, 0.f}; }
        mma16(XC, 16 * w, WR, aR, fr, fq);
        mma16(XC, 16 * w, WI, aI, fr, fq);
#pragma unroll
        for (int nf = 0; nf < 4; ++nf)
#pragma unroll
          for (int jj = 0; jj < 4; ++jj) {
            const int t = 16 * w + 4 * fq + jj, e = nf * 16 + fr;
            float r = sigmoidf_(aR[nf][jj] + br[nf]);
            float ig = sigmoidf_(aI[nf][jj] + bi[nf]);
            float la = -8.f * r * sp[nf];
            float xcv = bf2f(XC[t * TS + e]);
            AA[t * 65 + e] = expf(la);
            BB[t * 65 + e] = sqrtf(-expm1f(2.f * la)) * (ig * xcv);
          }
      }
      __syncthreads();
      {
        float A = 1.f, B = 0.f;
#pragma unroll
        for (int r = 0; r < 16; ++r) { float a = AA[(w * 16 + r) * 65 + lane], bb = BB[(w * 16 + r) * 65 + lane]; B = a * B + bb; A = a * A; }
        SEGA[w * 64 + lane] = A; SEGB[w * 64 + lane] = B;
      }
      __syncthreads();
      {
        float hin = hst, hall = hst;
#pragma unroll
        for (int s2 = 0; s2 < 4; ++s2) {
          float a = SEGA[s2 * 64 + lane], bb = SEGB[s2 * 64 + lane];
          hall = a * hall + bb;
          if (s2 < w) hin = a * hin + bb;
        }
        hst = hall;
        float hv = hin;
#pragma unroll
        for (int r = 0; r < 16; ++r) {
          const int t = w * 16 + r;
          hv = AA[t * 65 + lane] * hv + BB[t * 65 + lane];
          if (g.wout) {
            const size_t row = (size_t)(g.rowbase + (d ? g.T0 + 63 - t : g.T0 + t));
            bf16_t* yp = Y + row * DM + h * 64 + lane;
            if (d == 0) *yp = f2bf(hv);
            else {
              float tot = bf2f(*yp) + hv;
              float gate = bf2f(U[row * INP + 256 + h * 64 + lane]);
              *yp = f2bf(tot * gelu_tanh(gate));
            }
          }
        }
      }
    }
    __syncthreads();
  }
#undef LRU_LOAD
}

__device__ __forceinline__ void mlaproj_item_fast(const Params& p, int L, int item) {
  char* sm = dynsmem;
  bf16_t* AQ = (bf16_t*)sm;
  bf16_t* AKV = AQ + 64 * 200;
  const int tid = threadIdx.x, w = tid >> 6, lane = tid & 63, fr = lane & 15, fq = lane >> 4;
  const int ti = tid >> 2, part = tid & 3;
  const bf16_t* U = (const bf16_t*)(p.ws + OFF_U);
  const bf16_t* WQT = (const bf16_t*)(p.ws + OFF_WQT) + (size_t)L * 384 * 192;
  const bf16_t* WKVT = (const bf16_t*)(p.ws + OFF_WKVT) + (size_t)L * 512 * 128;
  const float* ROPE = (const float*)(p.ws + OFF_ROPE);
  const float* qan = p.in[I_MQAN] + L * 192;
  const float* kvan = p.in[I_MKVAN] + L * 128;
  const float* qn = p.in[I_MQN] + L * 96;
  const float* kn = p.in[I_MKN] + L * 96;
  bf16_t* QB = (bf16_t*)(p.ws + OFF_ACTB + QB_OFF);
  bf16_t* KB = (bf16_t*)(p.ws + OFF_ACTB + KB_OFF);
  bf16_t* VB = (bf16_t*)(p.ws + OFF_ACTB + VB_OFF);
  const int row0 = item * 64;
  const bool lat = row0 < NLAT;
  const int b = lat ? (row0 >> 11) : ((row0 - NLAT) >> 8);
  const int n0 = lat ? (row0 & 2047) : ((row0 - NLAT) & 255);
  const int key0 = lat ? CTXL + n0 : n0;
  __syncthreads();
  {
    const bf16_t* ur = U + (size_t)(row0 + ti) * INP + 2568;
    uint4 q6[6], k4[4], r1;
#pragma unroll
    for (int i = 0; i < 6; ++i) q6[i] = *(const uint4*)(ur + part * 48 + i * 8);
#pragma unroll
    for (int i = 0; i < 4; ++i) k4[i] = *(const uint4*)(ur + 192 + part * 32 + i * 8);
    r1 = *(const uint4*)(ur + 320 + part * 8);
    float sq = 0.f, sk = 0.f, sr = 0.f;
    float qf[48], kf[32], rf[8];
#pragma unroll
    for (int i = 0; i < 6; ++i) {
      const unsigned* wv = (const unsigned*)&q6[i];
#pragma unroll
      for (int j = 0; j < 4; ++j) { float a = __uint_as_float(wv[j] << 16), c = __uint_as_float(wv[j] & 0xffff0000u); qf[i * 8 + 2 * j] = a; qf[i * 8 + 2 * j + 1] = c; sq += a * a + c * c; }
    }
#pragma unroll
    for (int i = 0; i < 4; ++i) {
      const unsigned* wv = (const unsigned*)&k4[i];
#pragma unroll
      for (int j = 0; j < 4; ++j) { float a = __uint_as_float(wv[j] << 16), c = __uint_as_float(wv[j] & 0xffff0000u); kf[i * 8 + 2 * j] = a; kf[i * 8 + 2 * j + 1] = c; sk += a * a + c * c; }
    }
    {
      const unsigned* wv = (const unsigned*)&r1;
#pragma unroll
      for (int j = 0; j < 4; ++j) { float a = __uint_as_float(wv[j] << 16), c = __uint_as_float(wv[j] & 0xffff0000u); rf[2 * j] = a; rf[2 * j + 1] = c; sr += a * a + c * c; }
    }
    sq += __shfl_xor(sq, 1); sq += __shfl_xor(sq, 2);
    sk += __shfl_xor(sk, 1); sk += __shfl_xor(sk, 2);
    sr += __shfl_xor(sr, 1); sr += __shfl_xor(sr, 2);
    const float rq = rsqrtf(sq * (1.f / 192.f) + EPSF), rk = rsqrtf(sk * (1.f / 128.f) + EPSF), rr = rsqrtf(sr * (1.f / 32.f) + EPSF);
#pragma unroll
    for (int i = 0; i < 6; ++i) {
      unsigned pk[4];
#pragma unroll
      for (int j = 0; j < 4; ++j) { int c = part * 48 + i * 8 + 2 * j; pk[j] = pack2(qf[i * 8 + 2 * j] * rq * qan[c], qf[i * 8 + 2 * j + 1] * rq * qan[c + 1]); }
      *(uint4*)(AQ + ti * 200 + part * 48 + i * 8) = make_uint4(pk[0], pk[1], pk[2], pk[3]);
    }
#pragma unroll
    for (int i = 0; i < 4; ++i) {
      unsigned pk[4];
#pragma unroll
      for (int j = 0; j < 4; ++j) { int c = part * 32 + i * 8 + 2 * j; pk[j] = pack2(kf[i * 8 + 2 * j] * rk * kvan[c], kf[i * 8 + 2 * j + 1] * rk * kvan[c + 1]); }
      *(uint4*)(AKV + ti * 136 + part * 32 + i * 8) = make_uint4(pk[0], pk[1], pk[2], pk[3]);
    }
    {
      const int n = n0 + ti;
      unsigned pk[4];
#pragma unroll
      for (int j = 0; j < 4; ++j) {
        const int c = part * 8 + 2 * j, pi = c >> 1;
        float t1 = rf[2 * j] * rr * kn[64 + c], t2 = rf[2 * j + 1] * rr * kn[64 + c + 1];
        if (lat) {
          float cs = ROPE[(n * 16 + pi) * 2], sn = ROPE[(n * 16 + pi) * 2 + 1];
          float o1 = t1 * cs - t2 * sn, o2 = t1 * sn + t2 * cs;
          t1 = o1; t2 = o2;
        }
        pk[j] = pack2(t1, t2);
      }
      const uint4 kv4 = make_uint4(pk[0], pk[1], pk[2], pk[3]);
#pragma unroll
      for (int hh = 0; hh < 4; ++hh) *(uint4*)(KB + (((size_t)(b * 4 + hh)) * NKEY + key0 + ti) * 96 + 64 + part * 8) = kv4;
    }
  }
  __syncthreads();
  const float qscale = 0.10206207261596577f;
  for (int hh = 0; hh < 4; ++hh) {
    f32x4 acc[6];
#pragma unroll
    for (int nf = 0; nf < 6; ++nf) acc[nf] = (f32x4){0.f, 0.f, 0.f, 0.f};
#pragma unroll
    for (int ks = 0; ks < 6; ++ks) {
      bf16x8 a = *(const bf16x8*)(AQ + (16 * w + fr) * 200 + ks * 32 + fq * 8);
#pragma unroll
      for (int nf = 0; nf < 6; ++nf) {
        bf16x8 bb = *(const bf16x8*)(WQT + (size_t)(hh * 96 + nf * 16 + fr) * 192 + ks * 32 + fq * 8);
        acc[nf] = __builtin_amdgcn_mfma_f32_16x16x32_bf16(a, bb, acc[nf], 0, 0, 0);
      }
    }
#pragma unroll
    for (int jj = 0; jj < 4; ++jj) {
      const int rl = 16 * w + 4 * fq + jj;
      float s1 = 0.f, s2 = 0.f;
#pragma unroll
      for (int nf = 0; nf < 4; ++nf) s1 += acc[nf][jj] * acc[nf][jj];
      s2 = acc[4][jj] * acc[4][jj] + acc[5][jj] * acc[5][jj];
      s1 += __shfl_xor(s1, 1); s1 += __shfl_xor(s1, 2); s1 += __shfl_xor(s1, 4); s1 += __shfl_xor(s1, 8);
      s2 += __shfl_xor(s2, 1); s2 += __shfl_xor(s2, 2); s2 += __shfl_xor(s2, 4); s2 += __shfl_xor(s2, 8);
      const float r1 = rsqrtf(s1 * (1.f / 64.f) + EPSF) * qscale, r2 = rsqrtf(s2 * (1.f / 32.f) + EPSF) * qscale;
      bf16_t* qd = QB + ((size_t)(row0 + rl) * 4 + hh) * 96;
#pragma unroll
      for (int nf = 0; nf < 4; ++nf) qd[nf * 16 + fr] = f2bf(acc[nf][jj] * r1 * qn[nf * 16 + fr]);
#pragma unroll
      for (int nf = 4; nf < 6; ++nf) {
        const int c = (nf - 4) * 16 + fr;
        float v = acc[nf][jj] * r2 * qn[64 + c];
        float o = __shfl_xor(v, 1);
        if (lat) {
          const int n = n0 + rl, pi = c >> 1;
          float cs = ROPE[(n * 16 + pi) * 2], sn = ROPE[(n * 16 + pi) * 2 + 1];
          v = (fr & 1) ? (o * sn + v * cs) : (v * cs - o * sn);
        }
        qd[64 + c] = f2bf(v);
      }
    }
  }
  for (int hh = 0; hh < 4; ++hh) {
    f32x4 acc[8];
#pragma unroll
    for (int nf = 0; nf < 8; ++nf) acc[nf] = (f32x4){0.f, 0.f, 0.f, 0.f};
#pragma unroll
    for (int ks = 0; ks < 4; ++ks) {
      bf16x8 a = *(const bf16x8*)(AKV + (16 * w + fr) * 136 + ks * 32 + fq * 8);
#pragma unroll
      for (int nf = 0; nf < 8; ++nf) {
        bf16x8 bb = *(const bf16x8*)(WKVT + (size_t)(hh * 128 + nf * 16 + fr) * 128 + ks * 32 + fq * 8);
        acc[nf] = __builtin_amdgcn_mfma_f32_16x16x32_bf16(a, bb, acc[nf], 0, 0, 0);
      }
    }
#pragma unroll
    for (int jj = 0; jj < 4; ++jj) {
      const int rl = 16 * w + 4 * fq + jj;
      float s1 = 0.f;
#pragma unroll
      for (int nf = 0; nf < 4; ++nf) s1 += acc[nf][jj] * acc[nf][jj];
      s1 += __shfl_xor(s1, 1); s1 += __shfl_xor(s1, 2); s1 += __shfl_xor(s1, 4); s1 += __shfl_xor(s1, 8);
      const float r1 = rsqrtf(s1 * (1.f / 64.f) + EPSF);
      bf16_t* kd = KB + (((size_t)(b * 4 + hh)) * NKEY + key0 + rl) * 96;
#pragma unroll
      for (int nf = 0; nf < 4; ++nf) kd[nf * 16 + fr] = f2bf(acc[nf][jj] * r1 * kn[nf * 16 + fr]);
    }
#pragma unroll
    for (int nf = 4; nf < 8; ++nf) {
      const int dd = (nf - 4) * 16 + fr;
      uint2 o;
      o.x = pack2(acc[nf][0], acc[nf][1]); o.y = pack2(acc[nf][2], acc[nf][3]);
      *(uint2*)(VB + (((size_t)(b * 4 + hh)) * 64 + dd) * NKEY + key0 + 16 * w + 4 * fq) = o;
    }
  }
}

__device__ __forceinline__ void attn_item_fast(const Params& p, int L, int item) {
  char* sm = dynsmem;
  bf16_t* KT = (bf16_t*)sm;
  bf16_t* VT = (bf16_t*)(sm + 13312);
  bf16_t* PW = (bf16_t*)(sm + 22528);
  const int tid = threadIdx.x, w = tid >> 6, lane = tid & 63, fr = lane & 15, fq = lane >> 4;
  int b, h, rowq0, nkeys;
  if (item < 1024) { int bh = item >> 4, qb = item & 15; b = bh >> 2; h = bh & 3; rowq0 = b * SEQ + qb * 128; nkeys = NKEY; }
  else { int it2 = item - 1024; int bh = it2 >> 1, qb = it2 & 1; b = bh >> 2; h = bh & 3; rowq0 = NLAT + b * CTXL + qb * 128; nkeys = CTXL; }
  const bf16_t* QB = (const bf16_t*)(p.ws + OFF_ACTB + QB_OFF);
  const bf16_t* KB = (const bf16_t*)(p.ws + OFF_ACTB + KB_OFF) + ((size_t)(b * 4 + h)) * NKEY * 96;
  const bf16_t* VB = (const bf16_t*)(p.ws + OFF_ACTB + VB_OFF) + ((size_t)(b * 4 + h)) * 64 * NKEY;
  bf16_t* Y = (bf16_t*)(p.ws + OFF_ACTA);
  bf16_t* PWw = PW + w * 32 * TS;
  bf16x8 qf[2][3];
#pragma unroll
  for (int m = 0; m < 2; ++m)
#pragma unroll
    for (int ks = 0; ks < 3; ++ks) qf[m][ks] = *(const bf16x8*)(QB + ((size_t)(rowq0 + w * 32 + m * 16 + fr) * 4 + h) * 96 + ks * 32 + fq * 8);
  f32x4 o[2][4];
  float mrow[2][4], lrow[2][4];
#pragma unroll
  for (int m = 0; m < 2; ++m)
#pragma unroll
    for (int j = 0; j < 4; ++j) { mrow[m][j] = -1e30f; lrow[m][j] = 0.f; o[m][j] = (f32x4){0.f, 0.f, 0.f, 0.f}; }
  uint4 pk0, pk1, pk2, pv0, pv1;
  const int kr0 = tid / 12, kp0 = tid % 12, kr1 = (tid + 256) / 12, kp1 = (tid + 256) % 12, kr2 = (tid + 512) / 12, kp2 = (tid + 512) % 12;
  const int vd0 = tid >> 3, vp0 = tid & 7, vd1 = (tid + 256) >> 3;
#define ATT_LOAD(K0)                                                                 \
  {                                                                                  \
    pk0 = *(const uint4*)(KB + (size_t)((K0) + kr0) * 96 + kp0 * 8);                 \
    pk1 = *(const uint4*)(KB + (size_t)((K0) + kr1) * 96 + kp1 * 8);                 \
    pk2 = *(const uint4*)(KB + (size_t)((K0) + kr2) * 96 + kp2 * 8);                 \
    pv0 = *(const uint4*)(VB + (size_t)vd0 * NKEY + (K0) + vp0 * 8);                 \
    pv1 = *(const uint4*)(VB + (size_t)vd1 * NKEY + (K0) + vp0 * 8);                 \
  }
  ATT_LOAD(0);
  const int ntiles = nkeys >> 6;
  for (int t = 0; t < ntiles; ++t) {
    __syncthreads();
    *(uint4*)(KT + kr0 * 104 + kp0 * 8) = pk0;
    *(uint4*)(KT + kr1 * 104 + kp1 * 8) = pk1;
    *(uint4*)(KT + kr2 * 104 + kp2 * 8) = pk2;
    *(uint4*)(VT + vd0 * TS + vp0 * 8) = pv0;
    *(uint4*)(VT + vd1 * TS + vp0 * 8) = pv1;
    __syncthreads();
    if (t + 1 < ntiles) ATT_LOAD((t + 1) * 64);
    f32x4 sacc[2][4];
#pragma unroll
    for (int m = 0; m < 2; ++m)
#pragma unroll
      for (int nf = 0; nf < 4; ++nf) sacc[m][nf] = (f32x4){0.f, 0.f, 0.f, 0.f};
#pragma unroll
    for (int ks = 0; ks < 3; ++ks)
#pragma unroll
      for (int nf = 0; nf < 4; ++nf) {
        bf16x8 kb = *(const bf16x8*)(KT + (nf * 16 + fr) * 104 + ks * 32 + fq * 8);
#pragma unroll
        for (int m = 0; m < 2; ++m) sacc[m][nf] = __builtin_amdgcn_mfma_f32_16x16x32_bf16(qf[m][ks], kb, sacc[m][nf], 0, 0, 0);
      }
#pragma unroll
    for (int m = 0; m < 2; ++m)
#pragma unroll
      for (int j = 0; j < 4; ++j) {
        float mx = fmaxf(fmaxf(sacc[m][0][j], sacc[m][1][j]), fmaxf(sacc[m][2][j], sacc[m][3][j]));
        mx = fmaxf(mx, __shfl_xor(mx, 1)); mx = fmaxf(mx, __shfl_xor(mx, 2)); mx = fmaxf(mx, __shfl_xor(mx, 4)); mx = fmaxf(mx, __shfl_xor(mx, 8));
        const float mn = fmaxf(mrow[m][j], mx);
        const float al = expf(mrow[m][j] - mn);
        mrow[m][j] = mn;
        float ps = 0.f;
#pragma unroll
        for (int nf = 0; nf < 4; ++nf) {
          float pe = expf(sacc[m][nf][j] - mn);
          ps += pe;
          PWw[(m * 16 + 4 * fq + j) * TS + nf * 16 + fr] = f2bf(pe);
          o[m][nf][j] *= al;
        }
        lrow[m][j] = lrow[m][j] * al + ps;
      }
    CFENCE();
#pragma unroll
    for (int ks = 0; ks < 2; ++ks) {
      bf16x8 pa[2];
#pragma unroll
      for (int m = 0; m < 2; ++m) pa[m] = *(const bf16x8*)(PWw + (m * 16 + fr) * TS + ks * 32 + fq * 8);
#pragma unroll
      for (int nf = 0; nf < 4; ++nf) {
        bf16x8 vb = *(const bf16x8*)(VT + (nf * 16 + fr) * TS + ks * 32 + fq * 8);
#pragma unroll
        for (int m = 0; m < 2; ++m) o[m][nf] = __builtin_amdgcn_mfma_f32_16x16x32_bf16(pa[m], vb, o[m][nf], 0, 0, 0);
      }
    }
    CFENCE();
  }
#undef ATT_LOAD
#pragma unroll
  for (int m = 0; m < 2; ++m)
#pragma unroll
    for (int j = 0; j < 4; ++j) {
      float l = lrow[m][j];
      l += __shfl_xor(l, 1); l += __shfl_xor(l, 2); l += __shfl_xor(l, 4); l += __shfl_xor(l, 8);
      const float il = 1.f / l;
      bf16_t* yd = Y + (size_t)(rowq0 + w * 32 + m * 16 + 4 * fq + j) * DM + 768 + h * 64;
#pragma unroll
      for (int nf = 0; nf < 4; ++nf) yd[nf * 16 + fr] = f2bf(o[m][nf][j] * il);
    }
}

__device__ __forceinline__ void attn_item(const Params& p, int L, int item) {
  bf16_t* Kt = (bf16_t*)dynsmem;
  bf16_t* Vt = Kt + 64 * 96;
  const int tid = threadIdx.x;
  int b, h, rowq, nkeys;
  if (item < 512) { int bh = item >> 3, qb = item & 7; b = bh >> 2; h = bh & 3; rowq = b * SEQ + qb * 256 + tid; nkeys = NKEY; }
  else { int bh = item - 512; b = bh >> 2; h = bh & 3; rowq = NLAT + b * CTXL + tid; nkeys = CTXL; }
  const bf16_t* QB = (const bf16_t*)(p.ws + OFF_ACTB + QB_OFF);
  const bf16_t* KB = (const bf16_t*)(p.ws + OFF_ACTB + KB_OFF) + ((size_t)(b * 4 + h)) * NKEY * 96;
  const bf16_t* VB = (const bf16_t*)(p.ws + OFF_ACTB + VB_OFF) + ((size_t)(b * 4 + h)) * NKEY * 64;
  bf16_t* Y = (bf16_t*)(p.ws + OFF_ACTA);
  float q[96];
  {
    const uint4* qp = (const uint4*)(QB + ((size_t)rowq * 4 + h) * 96);
#pragma unroll
    for (int i = 0; i < 12; ++i) {
      uint4 v = qp[i];
      unsigned w[4] = {v.x, v.y, v.z, v.w};
#pragma unroll
      for (int j = 0; j < 4; ++j) { q[i * 8 + j * 2] = __uint_as_float(w[j] << 16); q[i * 8 + j * 2 + 1] = __uint_as_float(w[j] & 0xffff0000u); }
    }
  }
  float o[64];
#pragma unroll
  for (int i = 0; i < 64; ++i) o[i] = 0.f;
  float m = -1e30f, l = 0.f;
  for (int k0 = 0; k0 < nkeys; k0 += 64) {
    __syncthreads();
    {
      const uint4* ks = (const uint4*)(KB + (size_t)k0 * 96);
      uint4* kd = (uint4*)Kt;
      for (int i = tid; i < 64 * 96 * 2 / 16; i += 256) kd[i] = ks[i];
      const uint4* vs = (const uint4*)(VB + (size_t)k0 * 64);
      uint4* vd = (uint4*)Vt;
      for (int i = tid; i < 64 * 64 * 2 / 16; i += 256) vd[i] = vs[i];
    }
    __syncthreads();
    for (int kk = 0; kk < 64; ++kk) {
      const uint4* kr = (const uint4*)(Kt + kk * 96);
      float s = 0.f;
#pragma unroll
      for (int i = 0; i < 12; ++i) {
        uint4 v = kr[i];
        unsigned w[4] = {v.x, v.y, v.z, v.w};
#pragma unroll
        for (int j = 0; j < 4; ++j) { s += q[i * 8 + j * 2] * __uint_as_float(w[j] << 16); s += q[i * 8 + j * 2 + 1] * __uint_as_float(w[j] & 0xffff0000u); }
      }
      if (s > m) {
        float corr = expf(m - s);
        l *= corr;
#pragma unroll
        for (int i = 0; i < 64; ++i) o[i] *= corr;
        m = s;
      }
      float pe = expf(s - m);
      l += pe;
      const uint4* vr = (const uint4*)(Vt + kk * 64);
#pragma unroll
      for (int i = 0; i < 8; ++i) {
        uint4 v = vr[i];
        unsigned w[4] = {v.x, v.y, v.z, v.w};
#pragma unroll
        for (int j = 0; j < 4; ++j) { o[i * 8 + j * 2] += pe * __uint_as_float(w[j] << 16); o[i * 8 + j * 2 + 1] += pe * __uint_as_float(w[j] & 0xffff0000u); }
      }
    }
  }
  const float il = 1.f / l;
  bf16_t* yd = Y + (size_t)rowq * DM + 768 + h * 64;
#pragma unroll
  for (int i = 0; i < 64; ++i) yd[i] = f2bf(o[i] * il);
}

#ifndef FAST_ATTN
#define FAST_ATTN 1
#endif
#ifndef FAST_HGRN
#define FAST_HGRN 1
#endif
#ifndef FAST_SSD
#define FAST_SSD 1
#endif
#ifndef FAST_LRU
#define FAST_LRU 1
#endif
__device__ __forceinline__ void phase_mix(const Params& p, int L, int bid, int nb) {
  volatile int* s_itemp = (volatile int*)(dynsmem + DYN_LDS - 64);
  int* cnt = (int*)(p.ws + OFF_CNT) + L;
#if FAST_ATTN
  const int nattn = (L == 0) ? 1152 : 1024;
#else
  const int nattn = (L == 0) ? 576 : 512;
#endif
  const int total = 192 + nattn;
  for (;;) {
    __syncthreads();
    if (threadIdx.x == 0) *s_itemp = atomicAdd(cnt, 1);
    __syncthreads();
    const int it = *s_itemp;
    if (it >= total) break;
    if (it < 64) {
#if FAST_HGRN
      chain_hgrn_fast(p, L, it);
#else
      if ((it & 3) == 0) chain_hgrn(p, L, it >> 2);
#endif
    } else if (it < 128) {
#if FAST_SSD
      chain_ssd_fast(p, L, it - 64);
#else
      if ((it & 3) == 0) chain_ssd(p, L, (it - 64) >> 2);
#endif
    } else if (it < 192) {
#if FAST_LRU
      chain_lru_fast(p, L, it - 128);
#else
      if ((it & 3) == 0) chain_lru(p, L, (it - 128) >> 2);
#endif
    } else {
#if FAST_ATTN
      attn_item_fast(p, L, it - 192);
#else
      attn_item(p, L, it - 192);
#endif
    }
  }
}

__device__ __forceinline__ void phase_ssdnorm(const Params& p, int L, int bid, int nb) {
  const int wave = threadIdx.x >> 6, lane = threadIdx.x & 63;
  bf16_t* Y = (bf16_t*)(p.ws + OFF_ACTA);
  const float* nw = p.in[I_SNW] + L * 256;
  const int nrows = (L == 0) ? NTOK : NLAT;
  for (int row = bid * 4 + wave; row < nrows; row += nb * 4) {
    uint2* yp = (uint2*)(Y + (size_t)row * DM + 512) + lane;
    uint2 v = *yp;
    float a0 = __uint_as_float(v.x << 16), a1 = __uint_as_float(v.x & 0xffff0000u), a2 = __uint_as_float(v.y << 16), a3 = __uint_as_float(v.y & 0xffff0000u);
    float ss = wave_sum(a0 * a0 + a1 * a1 + a2 * a2 + a3 * a3);
    float rn = rsqrtf(ss * (1.f / 256.f) + EPSF);
    float4 w = ((const float4*)nw)[lane];
    uint2 o;
    o.x = (unsigned)f2bf(a0 * rn * w.x) | ((unsigned)f2bf(a1 * rn * w.y) << 16);
    o.y = (unsigned)f2bf(a2 * rn * w.z) | ((unsigned)f2bf(a3 * rn * w.w) << 16);
    *yp = o;
  }
}

__device__ __forceinline__ void phase_topk(const Params& p, int L, int bid, int nb) {
  float* a = (float*)dynsmem;
  const int tid = threadIdx.x;
  const float* aff = (const float*)(p.ws + OFF_AFF);
  int* ROWL = (int*)(p.ws + OFF_ROWL);
  float* GATE = (float*)(p.ws + OFF_GATE);
  const int nitems = (L == 0) ? 512 : 256;
  for (int it = bid; it < nitems; it += nb) {
    const bool lat = it < 256;
    const int be = lat ? it : it - 256;
    const int b = be >> 4, e = be & 15;
    const int n = lat ? SEQ : CTXL, cap = lat ? CAPL : CAPC;
    const float* src = lat ? aff + (size_t)be * SEQ : aff + (size_t)NB * NEXP * SEQ + (size_t)be * CTXL;
    __syncthreads();
    for (int i = tid; i < n; i += 256) a[i] = src[i];
    __syncthreads();
    for (int i0 = 0; i0 < n; i0 += 1024) {
      float av[4]; int rk[4];
#pragma unroll
      for (int q = 0; q < 4; ++q) { int i = i0 + q * 256 + tid; av[q] = i < n ? a[i] : 0.f; rk[q] = 0; }
      for (int j = 0; j < n; ++j) {
        float aj = a[j];
#pragma unroll
        for (int q = 0; q < 4; ++q) {
          int i = i0 + q * 256 + tid;
          rk[q] += (aj > av[q] || (aj == av[q] && j < i)) ? 1 : 0;
        }
      }
#pragma unroll
      for (int q = 0; q < 4; ++q) {
        int i = i0 + q * 256 + tid;
        if (i < n && rk[q] < cap) {
          int slot = lat ? (e * SLOTS + b * CAPL + rk[q]) : (e * SLOTS + SLOTS_L + b * CAPC + rk[q]);
          ROWL[slot] = lat ? (b * SEQ + i) : (NLAT + b * CTXL + i);
          GATE[slot] = av[q];
        }
      }
    }
  }
}

enum { PH_PREP = 0, PH_NORM1, PH_INPROJ, PH_MLAPROJ, PH_MIX, PH_SSDNORM, PH_OUTPROJ, PH_NORM2, PH_TOPK, PH_MOE1, PH_MOE2 };

__device__ __forceinline__ void run_phase(const Params& p, int ph, int L, int bid, int nb) {
  switch (ph) {
    case PH_PREP: phase_prep(p, bid, nb); break;
    case PH_NORM1: phase_norm(p, L, 0, L == 0 ? 0 : 1, NTOK, bid, nb); break;
    case PH_INPROJ: phase_inproj(p, L, bid, nb); break;
#if FAST_ATTN
    case PH_MLAPROJ: for (int it = bid; it < NTOK / 64; it += nb) mlaproj_item_fast(p, L, it); break;
#else
    case PH_MLAPROJ: phase_mlaproj(p, L, bid, nb); break;
#endif
    case PH_MIX: phase_mix(p, L, bid, nb); break;
    case PH_SSDNORM: phase_ssdnorm(p, L, bid, nb); break;
    case PH_OUTPROJ: phase_outproj(p, L, bid, nb); break;
    case PH_NORM2: phase_norm(p, L, 1, 1, L == 0 ? NTOK : NLAT, bid, nb); break;
    case PH_TOPK: phase_topk(p, L, bid, nb); break;
    case PH_MOE1: phase_moe1(p, L, bid, nb); break;
    case PH_MOE2: phase_moe2(p, L, bid, nb); break;
  }
}

#if !MEGA
template <int PH>
__global__ void __launch_bounds__(256, 2) k_phase(Params p, int L) {
  run_phase(p, PH, L, blockIdx.x, gridDim.x);
}
__global__ void __launch_bounds__(256) k_phase_mix(Params p, int L) {
  phase_mix(p, L, blockIdx.x, gridDim.x);
}
#endif

#if MEGA
__global__ void __launch_bounds__(256, MEGA_WPS) k_mega(Params p) {
  cg::grid_group grid = cg::this_grid();
  const int bid = blockIdx.x, nb = gridDim.x;
  phase_prep(p, bid, nb);
  grid.sync();
#define RP(PH, L) run_phase(p, PH, L, bid, nb); grid.sync();
  RP(PH_NORM1, 0) RP(PH_INPROJ, 0) RP(PH_MLAPROJ, 0) RP(PH_MIX, 0) RP(PH_SSDNORM, 0) RP(PH_OUTPROJ, 0) RP(PH_NORM2, 0) RP(PH_TOPK, 0) RP(PH_MOE1, 0) RP(PH_MOE2, 0)
  RP(PH_NORM1, 1) RP(PH_INPROJ, 1) RP(PH_MLAPROJ, 1) RP(PH_MIX, 1) RP(PH_SSDNORM, 1) RP(PH_OUTPROJ, 1) RP(PH_NORM2, 1) RP(PH_TOPK, 1) RP(PH_MOE1, 1) RP(PH_MOE2, 1)
}
#endif

extern "C" void kernel_launch(void* const* d_in, const int* in_sizes, int n_in, void* d_out, int out_size, void* d_ws, size_t ws_size, hipStream_t stream) {
  Params p{};
  for (int i = 0; i < N_IN; ++i) p.in[i] = (const float*)d_in[i];
  p.out = (float*)d_out;
  p.ws = (char*)d_ws;
  if (n_in != N_IN || ws_size < WS_END) { fprintf(stderr, "kernel_launch: bad args n_in=%d ws=%zu need %zu\n", n_in, ws_size, (size_t)WS_END); return; }
#if MEGA
  static int grid = 0;
  if (!grid) {
    int dev = 0, cus = 0, per_cu = 0;
    hipGetDevice(&dev);
    hipDeviceGetAttribute(&cus, hipDeviceAttributeMultiprocessorCount, dev);
    hipFuncSetAttribute((const void*)k_mega, hipFuncAttributeMaxDynamicSharedMemorySize, DYN_LDS);
    hipOccupancyMaxActiveBlocksPerMultiprocessor(&per_cu, (const void*)k_mega, 256, DYN_LDS);
    if (per_cu > MEGA_WPS) per_cu = MEGA_WPS;
    if (per_cu < 1) per_cu = 1;
    grid = cus * per_cu;
  }
  void* args[] = {&p};
  hipError_t e = hipLaunchCooperativeKernel((const void*)k_mega, dim3(grid), dim3(256), args, DYN_LDS, stream);
  if (e != hipSuccess) fprintf(stderr, "cooperative launch failed: %s (grid %d)\n", hipGetErrorString(e), grid);
#else
  const int G = 1024;
#define LAUNCH(PH, L) k_phase<PH><<<G, 256, DYN_LDS, stream>>>(p, L)
  LAUNCH(PH_PREP, 0);
  for (int L = 0; L < 2; ++L) {
    LAUNCH(PH_NORM1, L); LAUNCH(PH_INPROJ, L); LAUNCH(PH_MLAPROJ, L); k_phase_mix<<<G, 256, DYN_LDS, stream>>>(p, L); LAUNCH(PH_SSDNORM, L);
    LAUNCH(PH_OUTPROJ, L); LAUNCH(PH_NORM2, L); LAUNCH(PH_TOPK, L); LAUNCH(PH_MOE1, L); LAUNCH(PH_MOE2, L);
  }
#endif
}
```

```cpp
#include <hip/hip_runtime.h>
#include <hip/hip_cooperative_groups.h>
#include <cstdio>
#include <cstdint>
namespace cg = cooperative_groups;

#ifndef MEGA
#define MEGA 1
#endif

typedef unsigned short bf16_t;
typedef short bf16x8 __attribute__((ext_vector_type(8)));
typedef float f32x4 __attribute__((ext_vector_type(4)));

#define NT 512
#define NB 16
#define SEQ 2048
#define CTXL 256
#define DM 1024
#define NLAT (NB * SEQ)
#define NCTX (NB * CTXL)
#define NTOK (NLAT + NCTX)
#define INC 2920
#define INP 3072
#define NEXP 16
#define FF 512
#define CAPL 256
#define CAPC 32
#define SLOTS_L (NB * CAPL)
#define SLOTS_C (NB * CAPC)
#define SLOTS (SLOTS_L + SLOTS_C)
#define NKEY (CTXL + SEQ)
#define EPSF 1e-6f

enum { I_X = 0, I_C, I_CTX, I_CCTX, I_ADAW, I_ADAB, I_N1W, I_N2W, I_WIN, I_WOUT, I_LCW, I_LCB, I_LWR, I_LBR, I_LWI, I_LBI, I_LLAM,
       I_HLB, I_HNW, I_SCW, I_SCB, I_SALOG, I_SDTB, I_SDSK, I_SNW, I_MQAN, I_MWQ, I_MKVAN, I_MWKV, I_MQN, I_MKN, I_ROUT, I_WG, I_WU, I_WD, N_IN };

struct Params {
  const float* in[N_IN];
  float* out;
  char* ws;
};

constexpr size_t OFF_MOD = 0;
constexpr size_t SZ_MOD = (size_t)2 * 17 * 6144 * 4;
constexpr size_t OFF_WINT = OFF_MOD + SZ_MOD;
constexpr size_t SZ_WINT = (size_t)2 * INP * DM * 2;
constexpr size_t OFF_WOUTT = OFF_WINT + SZ_WINT;
constexpr size_t SZ_WOUTT = (size_t)2 * DM * DM * 2;
constexpr size_t OFF_WGU = OFF_WOUTT + SZ_WOUTT;
constexpr size_t SZ_WGU = (size_t)2 * NEXP * 1024 * DM * 2;
constexpr size_t OFF_WDT = OFF_WGU + SZ_WGU;
constexpr size_t SZ_WDT = (size_t)2 * NEXP * DM * FF * 2;
constexpr size_t OFF_CTXS = OFF_WDT + SZ_WDT;
constexpr size_t SZ_CTXS = (size_t)NCTX * DM * 4;
constexpr size_t OFF_ACTA = OFF_CTXS + SZ_CTXS;
constexpr size_t SZ_ACT = (size_t)NTOK * DM * 2;
constexpr size_t OFF_ACTB = OFF_ACTA + SZ_ACT;
constexpr size_t OFF_U = OFF_ACTB + SZ_ACT;
constexpr size_t SZ_U = (size_t)NTOK * INP * 2;
constexpr size_t OFF_AFF = OFF_U + SZ_U;
constexpr size_t SZ_AFF = (size_t)(NB * NEXP * SEQ + NB * NEXP * CTXL) * 4;
constexpr size_t OFF_ROWL = OFF_AFF + SZ_AFF;
constexpr size_t SZ_ROWL = (size_t)NEXP * SLOTS * 4;
constexpr size_t OFF_SEL = OFF_ROWL + SZ_ROWL;
constexpr size_t SZ_SEL = (size_t)NTOK * 16 * 4;
constexpr size_t OFF_GSEL = OFF_SEL + SZ_SEL;
constexpr size_t OFF_WQT = OFF_GSEL + SZ_SEL;
constexpr size_t SZ_WQT = (size_t)2 * 384 * 192 * 2;
constexpr size_t OFF_WKVT = OFF_WQT + SZ_WQT;
constexpr size_t SZ_WKVT = (size_t)2 * 512 * 128 * 2;
constexpr size_t OFF_LRUW = OFF_WKVT + SZ_WKVT;
constexpr size_t SZ_LRUW = (size_t)2 * 2 * 2 * 4 * 4096 * 2;
constexpr size_t OFF_ROPE = OFF_LRUW + SZ_LRUW;
constexpr size_t SZ_ROPE = (size_t)SEQ * 16 * 2 * 4;
constexpr size_t OFF_CNT = OFF_ROPE + SZ_ROPE;
constexpr size_t WS_END = OFF_CNT + 256;

constexpr size_t QB_OFF = 0;
constexpr size_t KB_OFF = (size_t)NTOK * 384 * 2;
constexpr size_t VB_OFF = KB_OFF + (size_t)NB * 4 * NKEY * 96 * 2;

extern __shared__ __attribute__((aligned(16))) char dynsmem[];
#define GROUP_LDS 77824
#define DYN_LDS (2 * GROUP_LDS + 256)
#define TS 72

__device__ __forceinline__ bf16_t f2bf(float f) {
  unsigned u = __float_as_uint(f);
  u += 0x7fffu + ((u >> 16) & 1u);
  return (bf16_t)(u >> 16);
}
__device__ __forceinline__ float bf2f(bf16_t h) { return __uint_as_float(((unsigned)h) << 16); }
__device__ __forceinline__ unsigned pack2(float a, float b) { return (unsigned)f2bf(a) | ((unsigned)f2bf(b) << 16); }
__device__ __forceinline__ float sigmoidf_(float x) { return 1.f / (1.f + expf(-x)); }
__device__ __forceinline__ float siluf_(float x) { return x / (1.f + expf(-x)); }
__device__ __forceinline__ float softplusf_(float x) { return x > 20.f ? x : log1pf(expf(x)); }
__device__ __forceinline__ float gelu_tanh(float x) {
  float t = tanhf(0.7978845608028654f * (x + 0.044715f * x * x * x));
  return 0.5f * x * (1.f + t);
}
__device__ __forceinline__ float wave_sum(float v) {
#pragma unroll
  for (int o = 1; o < 64; o <<= 1) v += __shfl_xor(v, o);
  return v;
}
__device__ __forceinline__ float sum16(float v) {
  v += __shfl_xor(v, 1); v += __shfl_xor(v, 2); v += __shfl_xor(v, 4); v += __shfl_xor(v, 8);
  return v;
}
__device__ __forceinline__ const float* xrow_src(const Params& p, int srcmode, int row) {
  if (srcmode == 0) return row < NLAT ? p.in[I_X] + (size_t)row * DM : p.in[I_CTX] + (size_t)(row - NLAT) * DM;
  return row < NLAT ? p.out + (size_t)row * DM : (const float*)(p.ws + OFF_CTXS) + (size_t)(row - NLAT) * DM;
}
__device__ __forceinline__ float* xrow_dst(const Params& p, int row) {
  return row < NLAT ? p.out + (size_t)row * DM : (float*)(p.ws + OFF_CTXS) + (size_t)(row - NLAT) * DM;
}
__device__ __forceinline__ int modrow(int row) { return row < NLAT ? (row >> 11) : 16; }
__device__ __forceinline__ const float* modptr(const Params& p, int layer, int mrow, int chunk) {
  return (const float*)(p.ws + OFF_MOD) + ((size_t)(layer * 17 + mrow) * 6144 + chunk * 1024);
}
__device__ __forceinline__ float unpk(const uint4* v, int e) {
  const unsigned* w = (const unsigned*)v;
  unsigned x = w[e >> 1];
  return (e & 1) ? __uint_as_float(x & 0xffff0000u) : __uint_as_float(x << 16);
}
__device__ __forceinline__ bf16_t unpk_raw(const uint4* v, int e) {
  const unsigned* w = (const unsigned*)v;
  unsigned x = w[e >> 1];
  return (bf16_t)((e & 1) ? (x >> 16) : (x & 0xffffu));
}
#define CFENCE() asm volatile("" ::: "memory")

__device__ __forceinline__ void transpose_tile(const float* __restrict__ src, int N, int k0, int n0, bf16_t* __restrict__ dst, int K, int mode) {
  float* tile = (float*)dynsmem;
  const int tid = threadIdx.x;
#pragma unroll
  for (int i = 0; i < 8; ++i) {
    int idx = i * NT + tid;
    int r = idx >> 6, c = idx & 63;
    int n = n0 + c;
    float v = (n < N) ? src[(size_t)(k0 + r) * N + n] : 0.f;
    tile[r * 65 + c] = v;
  }
  __syncthreads();
#pragma unroll
  for (int i = 0; i < 8; ++i) {
    int idx = i * NT + tid;
    int nl = idx >> 6, kl = idx & 63;
    int n = n0 + nl;
    int nr = (mode == 0) ? n : ((n >> 4) * 32 + (mode == 2 ? 16 : 0) + (n & 15));
    dst[(size_t)nr * K + k0 + kl] = f2bf(tile[kl * 65 + nl]);
  }
  __syncthreads();
}

__device__ __forceinline__ void mod_item(const Params& p, int j) {
  float* s = (float*)dynsmem;
  float* red = s + 17 * 256;
  const int tid = threadIdx.x;
  const int l = j / 96, cb = (j % 96) * 64;
  const int kg = tid >> 6, col = tid & 63;
  const float* cc = p.in[I_C];
  const float* cctx = p.in[I_CCTX];
  const float* aw = p.in[I_ADAW] + (size_t)l * DM * 6144;
  float acc[17];
#pragma unroll
  for (int r = 0; r < 17; ++r) acc[r] = 0.f;
  for (int kc = 0; kc < 4; ++kc) {
    __syncthreads();
    for (int idx = tid; idx < 17 * 256; idx += NT) {
      int r = idx >> 8, kk = idx & 255;
      int k = kc * 256 + kk;
      float v = (r < 16) ? cc[r * DM + k] : cctx[k];
      s[idx] = siluf_(v);
    }
    __syncthreads();
#pragma unroll 4
    for (int kk = 0; kk < 32; ++kk) {
      int kl = kg * 32 + kk;
      float w = aw[(size_t)(kc * 256 + kl) * 6144 + cb + col];
#pragma unroll
      for (int r = 0; r < 17; ++r) acc[r] += s[r * 256 + kl] * w;
    }
  }
#pragma unroll
  for (int r = 0; r < 17; ++r) red[(kg * 17 + r) * 64 + col] = acc[r];
  __syncthreads();
  float* mod = (float*)(p.ws + OFF_MOD);
  for (int idx = tid; idx < 17 * 64; idx += NT) {
    int r = idx >> 6, c2 = idx & 63;
    float v = 0.f;
#pragma unroll
    for (int g = 0; g < 8; ++g) v += red[(g * 17 + r) * 64 + c2];
    v += p.in[I_ADAB][l * 6144 + cb + c2];
    mod[(size_t)(l * 17 + r) * 6144 + cb + c2] = v;
  }
  __syncthreads();
}

__device__ __forceinline__ void phase_prep(const Params& p, int bid, int nb) {
  constexpr int T_WIN = 16 * 48;
  constexpr int T_PER_LAYER = T_WIN + 256 + 16 * 384 + 18 + 16 + 16;
  constexpr int NTL = 2 * T_PER_LAYER;
  if (bid == 0 && threadIdx.x < 64) ((int*)(p.ws + OFF_CNT))[threadIdx.x] = 0;
  for (int it = bid; it < 192 + 64 + NTL; it += nb) {
    if (it < 192) { mod_item(p, it); continue; }
    if (it < 256) {
      int idx = (it - 192) * NT + threadIdx.x;
      int n = idx >> 4, i = idx & 15;
      float inv = powf(10000.f, -(float)(i & 7) / 8.f);
      float pos = (i < 8) ? (float)(n >> 6) : (float)(n & 63);
      float ang = pos * inv;
      float* rt = (float*)(p.ws + OFF_ROPE);
      rt[idx * 2] = cosf(ang); rt[idx * 2 + 1] = sinf(ang);
      continue;
    }
    int tt = it - 256;
    int l = tt / T_PER_LAYER, r = tt % T_PER_LAYER;
    if (r < T_WIN) {
      int tk = r / 48, tn = r % 48;
      transpose_tile(p.in[I_WIN] + (size_t)l * DM * INC, INC, tk * 64, tn * 64, (bf16_t*)(p.ws + OFF_WINT) + (size_t)l * INP * DM, DM, 0);
    } else if (r < T_WIN + 256) {
      r -= T_WIN;
      int tk = r / 16, tn = r % 16;
      transpose_tile(p.in[I_WOUT] + (size_t)l * DM * DM, DM, tk * 64, tn * 64, (bf16_t*)(p.ws + OFF_WOUTT) + (size_t)l * DM * DM, DM, 0);
    } else if (r >= T_WIN + 256 + 16 * 384) {
      r -= T_WIN + 256 + 16 * 384;
      if (r < 18) {
        int tk = r / 6, tn = r % 6;
        transpose_tile(p.in[I_MWQ] + (size_t)l * 192 * 384, 384, tk * 64, tn * 64, (bf16_t*)(p.ws + OFF_WQT) + (size_t)l * 384 * 192, 192, 0);
      } else if (r < 34) {
        r -= 18;
        int tk = r / 8, tn = r % 8;
        transpose_tile(p.in[I_MWKV] + (size_t)l * 128 * 512, 512, tk * 64, tn * 64, (bf16_t*)(p.ws + OFF_WKVT) + (size_t)l * 512 * 128, 128, 0);
      } else {
        r -= 34;
        int d = r >> 3, gate = (r >> 2) & 1, h = r & 3;
        const float* src = (gate == 0 ? p.in[I_LWR] : p.in[I_LWI]) + (size_t)((l * 2 + d) * 4 + h) * 4096;
        transpose_tile(src, 64, 0, 0, (bf16_t*)(p.ws + OFF_LRUW) + (size_t)(((l * 2 + d) * 2 + gate) * 4 + h) * 4096, 64, 0);
      }
    } else {
      r -= T_WIN + 256;
      int e = r / 384, rr = r % 384, sub = rr / 128, t = rr % 128;
      size_t le = (size_t)(l * NEXP + e);
      if (sub < 2) {
        int tk = t / 8, tn = t % 8;
        const float* src = (sub == 0 ? p.in[I_WG] : p.in[I_WU]) + le * DM * FF;
        transpose_tile(src, FF, tk * 64, tn * 64, (bf16_t*)(p.ws + OFF_WGU) + le * 1024 * DM, DM, sub == 0 ? 1 : 2);
      } else {
        int tk = t / 16, tn = t % 16;
        transpose_tile(p.in[I_WD] + le * FF * DM, DM, tk * 64, tn * 64, (bf16_t*)(p.ws + OFF_WDT) + le * DM * FF, FF, 0);
      }
    }
  }
}

__device__ __forceinline__ void phase_norm(const Params& p, int layer, int which, int srcmode, int comb, int nrows, int bid, int nb) {
  const int wave = threadIdx.x >> 6, lane = threadIdx.x & 63;
  const float* nw = (which == 1 ? p.in[I_N2W] : p.in[I_N1W]) + layer * DM;
  bf16_t* dstb = (bf16_t*)(p.ws + (which == 0 ? OFF_ACTA : OFF_ACTB));
  const float* wr = p.in[I_ROUT] + (size_t)layer * DM * NEXP;
  const int* SEL = (const int*)(p.ws + OFF_SEL);
  const float* GSEL = (const float*)(p.ws + OFF_GSEL);
  const bf16_t* YS = (const bf16_t*)(p.ws + OFF_U);
  for (int row = bid * 8 + wave; row < nrows; row += nb * 8) {
    const float4* src = (const float4*)xrow_src(p, srcmode, row);
    const int mr = modrow(row);
    float4 v[4];
#pragma unroll
    for (int j = 0; j < 4; ++j) v[j] = src[j * 64 + lane];
    if (comb >= 0) {
      int sl = -1; float gl = 0.f;
      if (lane < 16) { sl = SEL[(size_t)row * 16 + lane]; gl = GSEL[(size_t)row * 16 + lane]; }
      float4 a[4];
#pragma unroll
      for (int j = 0; j < 4; ++j) a[j] = make_float4(0.f, 0.f, 0.f, 0.f);
      for (int e = 0; e < 16; ++e) {
        const int s = __shfl(sl, e);
        const float g = __shfl(gl, e);
        if (s >= 0) {
          const uint2* yr = (const uint2*)(YS + (size_t)s * DM);
#pragma unroll
          for (int j = 0; j < 4; ++j) {
            uint2 y = yr[j * 64 + lane];
            a[j].x += g * __uint_as_float(y.x << 16); a[j].y += g * __uint_as_float(y.x & 0xffff0000u);
            a[j].z += g * __uint_as_float(y.y << 16); a[j].w += g * __uint_as_float(y.y & 0xffff0000u);
          }
        }
      }
      const float4* g5 = (const float4*)modptr(p, comb, mr, 5);
      float4* xd = (float4*)xrow_dst(p, row);
#pragma unroll
      for (int j = 0; j < 4; ++j) {
        float4 m = g5[j * 64 + lane];
        v[j].x += m.x * a[j].x; v[j].y += m.y * a[j].y; v[j].z += m.z * a[j].z; v[j].w += m.w * a[j].w;
        xd[j * 64 + lane] = v[j];
      }
    }
    if (which == 2) continue;
    const float4* sh = (const float4*)modptr(p, layer, mr, which == 0 ? 0 : 3);
    const float4* sc = (const float4*)modptr(p, layer, mr, which == 0 ? 1 : 4);
    float ss = 0.f;
#pragma unroll
    for (int j = 0; j < 4; ++j) ss += v[j].x * v[j].x + v[j].y * v[j].y + v[j].z * v[j].z + v[j].w * v[j].w;
    ss = wave_sum(ss);
    const float rstd = rsqrtf(ss * (1.f / DM) + EPSF);
    float lg[16];
#pragma unroll
    for (int e = 0; e < 16; ++e) lg[e] = 0.f;
#pragma unroll
    for (int j = 0; j < 4; ++j) {
      float4 w4 = ((const float4*)nw)[j * 64 + lane];
      float4 s4 = sh[j * 64 + lane], c4 = sc[j * 64 + lane];
      float h0 = v[j].x * rstd * w4.x * (1.f + c4.x) + s4.x;
      float h1 = v[j].y * rstd * w4.y * (1.f + c4.y) + s4.y;
      float h2 = v[j].z * rstd * w4.z * (1.f + c4.z) + s4.z;
      float h3 = v[j].w * rstd * w4.w * (1.f + c4.w) + s4.w;
      uint2 o;
      o.x = pack2(h0, h1);
      o.y = pack2(h2, h3);
      ((uint2*)(dstb + (size_t)row * DM))[j * 64 + lane] = o;
      if (which == 1) {
        const int k = j * 256 + lane * 4;
        float hh[4] = {h0, h1, h2, h3};
#pragma unroll
        for (int i = 0; i < 4; ++i) {
          const float4* wp = (const float4*)(wr + (size_t)(k + i) * NEXP);
#pragma unroll
          for (int q = 0; q < 4; ++q) {
            float4 w = wp[q];
            lg[q * 4 + 0] += hh[i] * w.x; lg[q * 4 + 1] += hh[i] * w.y; lg[q * 4 + 2] += hh[i] * w.z; lg[q * 4 + 3] += hh[i] * w.w;
          }
        }
      }
    }
    if (which == 1) {
      float mx = -1e30f;
#pragma unroll
      for (int e = 0; e < 16; ++e) { lg[e] = wave_sum(lg[e]); mx = fmaxf(mx, lg[e]); }
      float den = 0.f, mine = 0.f;
#pragma unroll
      for (int e = 0; e < 16; ++e) { float pe = expf(lg[e] - mx); den += pe; if (lane == e) mine = pe; }
      if (lane < 16) {
        float* aff = (float*)(p.ws + OFF_AFF);
        size_t idx;
        if (row < NLAT) { int b = row >> 11, n = row & 2047; idx = ((size_t)(b * NEXP + lane)) * SEQ + n; }
        else { int rr = row - NLAT; int b = rr >> 8, n = rr & 255; idx = (size_t)NB * NEXP * SEQ + ((size_t)(b * NEXP + lane)) * CTXL + n; }
        aff[idx] = mine / den;
      }
    }
  }
}

__device__ __forceinline__ int lds_byte(int r, int c) {
  int st = (r >> 4) * 2 + (c >> 5), rr = r & 15, cc = c & 31, ob = rr * 64 + cc * 2;
  return st * 1024 + (ob ^ (((ob >> 9) & 1) << 5));
}
__device__ __forceinline__ void stage_rc(int b, int& R, int& C) {
  int st = b / 1024, sb = b % 1024, swz = sb ^ (((sb >> 9) & 1) << 5);
  R = (st >> 1) * 16 + swz / 64; C = (st & 1) * 32 + (swz % 64) / 2;
}
#define G_LAS __attribute__((address_space(3)))
#define G_HTB (128 * 64 * 2)
#define G_SA(b, h) (((b) * 2 + (h)) * G_HTB)
#define G_SB(b, h) ((4 + (b) * 2 + (h)) * G_HTB)
#define G_STAGE(bufoff, gbase, voff) do { _Pragma("unroll") for (int _i = 0; _i < 2; ++_i) \
    __builtin_amdgcn_global_load_lds((const unsigned*)((const char*)(gbase) + (voff)[_i]), (G_LAS unsigned*)(lds + (bufoff) + ldsw + _i * 8192), 16, 0, 0); } while (0)
#define G_LDA(dst, b, h) do { _Pragma("unroll") for (int m = 0; m < 4; ++m) _Pragma("unroll") for (int k = 0; k < 2; ++k) dst[m][k] = *(const G_LAS bf16x8*)(lds + G_SA(b, h) + aoff + m * 2048 + k * 1024); } while (0)
#define G_LDB(dst, b, h) do { _Pragma("unroll") for (int n = 0; n < 2; ++n) _Pragma("unroll") for (int k = 0; k < 2; ++k) dst[n][k] = *(const G_LAS bf16x8*)(lds + G_SB(b, h) + boff + n * 2048 + k * 1024); } while (0)
#define G_MMA(ai, bj, At_, Bt_) do { __builtin_amdgcn_s_setprio(1); _Pragma("unroll") for (int m = 0; m < 4; ++m) _Pragma("unroll") for (int n = 0; n < 2; ++n) _Pragma("unroll") for (int k = 0; k < 2; ++k) \
    acc[ai][bj][m][n] = __builtin_amdgcn_mfma_f32_16x16x32_bf16(Bt_[n][k], At_[m][k], acc[ai][bj][m][n], 0, 0, 0); __builtin_amdgcn_s_setprio(0); } while (0)
#define G_WAIT_V(n) asm volatile("s_waitcnt vmcnt(" #n ")" ::: "memory")
#define G_WAIT_L(n) asm volatile("s_waitcnt lgkmcnt(" #n ")" ::: "memory")
#define G_BAR __builtin_amdgcn_s_barrier()
#define G_SCHED __builtin_amdgcn_sched_barrier(0)

template <int EPI>
__device__ __forceinline__ void gemm256(const Params& p, int layer, int srcmode, const bf16_t* __restrict__ A, const int* __restrict__ rowl, int arow0,
                                        const bf16_t* __restrict__ Bt, int bcol, int K, int orow0) {
  G_LAS unsigned char* lds = (G_LAS unsigned char*)dynsmem;
  int tx_ = threadIdx.x; asm volatile("" : "+v"(tx_));
  const int tid = tx_, wid = __builtin_amdgcn_readfirstlane(tid >> 6), lane = tid & 63, wr = wid >> 2, wc = wid & 3, fr = lane & 15, fq = lane >> 4;
  const int nt = K / 64;
  unsigned voffA0[2], voffA1[2], voffB[2];
#pragma unroll
  for (int i = 0; i < 2; ++i) {
    int R, C;
    stage_rc(tid * 16 + i * 8192, R, C);
    int r0 = arow0 + R, r1 = arow0 + 128 + R;
    if (rowl) { r0 = rowl[r0]; r1 = rowl[r1]; }
    voffA0[i] = (unsigned)(r0 * K + C) * 2u;
    voffA1[i] = (unsigned)(r1 * K + C) * 2u;
    voffB[i] = (unsigned)(R * K + C) * 2u;
  }
  const size_t kstep = 128;
  const size_t hstep = (size_t)128 * K * 2;
  const unsigned ldsw = (unsigned)wid * 1024u;
  const int aoff = lds_byte(wr * 64 + fr, fq * 8), boff = lds_byte(wc * 32 + fr, fq * 8);
  const char* cA = (const char*)A;
  const char* cB = (const char*)Bt + (size_t)bcol * K * 2;
  f32x4 acc[2][2][4][2];
#pragma unroll
  for (int a = 0; a < 2; ++a)
#pragma unroll
    for (int b = 0; b < 2; ++b)
#pragma unroll
      for (int m = 0; m < 4; ++m)
#pragma unroll
        for (int n = 0; n < 2; ++n) acc[a][b][m][n] = (f32x4){0.f, 0.f, 0.f, 0.f};
  bf16x8 At[4][2], B0[2][2], B1[2][2];
  G_STAGE(G_SB(0, 0), cB, voffB); G_STAGE(G_SA(0, 0), cA, voffA0); G_STAGE(G_SB(0, 1), cB + hstep, voffB); G_STAGE(G_SA(0, 1), cA, voffA1);
  if (wr == 1) G_BAR;
  G_WAIT_V(4); G_BAR;
  G_STAGE(G_SB(1, 0), cB + kstep, voffB); G_STAGE(G_SA(1, 0), cA + kstep, voffA0); G_STAGE(G_SB(1, 1), cB + hstep + kstep, voffB);
  G_WAIT_V(6); G_BAR;
  for (int t = 0; t < nt - 2; t += 2) {
    const char* a1 = cA + (size_t)(t + 1) * kstep;
    const char* a2 = cA + (size_t)(t + 2) * kstep; const char* b2 = cB + (size_t)(t + 2) * kstep;
    const char* a3 = a2 + kstep; const char* b3 = b2 + kstep;
    G_LDB(B0, 0, 0); G_SCHED; G_LDA(At, 0, 0); G_STAGE(G_SA(1, 1), a1, voffA1);
    G_WAIT_L(8); G_BAR; G_WAIT_L(0); G_MMA(0, 0, At, B0); G_BAR; G_SCHED;
    G_LDB(B1, 0, 1); G_STAGE(G_SB(0, 0), b2, voffB);
    G_BAR; G_WAIT_L(0); G_MMA(0, 1, At, B1); G_BAR;
    G_LDA(At, 0, 1); G_STAGE(G_SA(0, 0), a2, voffA0);
    G_BAR; G_WAIT_L(0); G_MMA(1, 0, At, B0); G_BAR; G_SCHED;
    G_STAGE(G_SB(0, 1), b2 + hstep, voffB);
    G_WAIT_V(6); G_BAR; G_MMA(1, 1, At, B1); G_BAR;
    G_LDB(B0, 1, 0); G_SCHED; G_LDA(At, 1, 0); G_STAGE(G_SA(0, 1), a2, voffA1);
    G_WAIT_L(8); G_BAR; G_WAIT_L(0); G_MMA(0, 0, At, B0); G_BAR; G_SCHED;
    G_LDB(B1, 1, 1); G_STAGE(G_SB(1, 0), b3, voffB);
    G_BAR; G_WAIT_L(0); G_MMA(0, 1, At, B1); G_BAR;
    G_LDA(At, 1, 1); G_STAGE(G_SA(1, 0), a3, voffA0);
    G_BAR; G_WAIT_L(0); G_MMA(1, 0, At, B0); G_BAR; G_SCHED;
    G_STAGE(G_SB(1, 1), b3 + hstep, voffB);
    G_WAIT_V(6); G_BAR; G_MMA(1, 1, At, B1); G_BAR;
  }
  { const char* a1 = cA + (size_t)(nt - 1) * kstep;
    G_LDB(B0, 0, 0); G_LDA(At, 0, 0); G_STAGE(G_SA(1, 1), a1, voffA1);
    G_BAR; G_WAIT_L(0); G_MMA(0, 0, At, B0); G_BAR;
    G_LDB(B1, 0, 1); G_BAR; G_WAIT_L(0); G_MMA(0, 1, At, B1); G_BAR;
    G_LDA(At, 0, 1); G_WAIT_V(4); G_BAR; G_WAIT_L(0); G_MMA(1, 0, At, B0); G_MMA(1, 1, At, B1); G_BAR; }
  { G_LDB(B0, 1, 0); G_LDA(At, 1, 0); G_WAIT_V(2); G_BAR; G_WAIT_L(0); G_MMA(0, 0, At, B0); G_BAR;
    G_LDB(B1, 1, 1); G_WAIT_V(0); G_BAR; G_WAIT_L(0); G_MMA(0, 1, At, B1); G_BAR;
    G_LDA(At, 1, 1); G_BAR; G_WAIT_L(0); G_MMA(1, 0, At, B0); G_MMA(1, 1, At, B1); G_BAR; }
  if (wr == 0) G_BAR;
#pragma unroll
  for (int ai = 0; ai < 2; ++ai)
#pragma unroll
    for (int m = 0; m < 4; ++m) {
      const int row = orow0 + ai * 128 + wr * 64 + m * 16 + fr;
      if (EPI == 0) {
        bf16_t* U = (bf16_t*)(p.ws + OFF_U) + (size_t)row * INP;
#pragma unroll
        for (int bj = 0; bj < 2; ++bj)
#pragma unroll
          for (int n = 0; n < 2; ++n) {
            const int col = bcol + bj * 128 + wc * 32 + n * 16 + fq * 4;
            f32x4 a = acc[ai][bj][m][n];
            uint2 o; o.x = pack2(a[0], a[1]); o.y = pack2(a[2], a[3]);
            *(uint2*)(U + col) = o;
          }
      } else if (EPI == 1) {
        const float* xs = xrow_src(p, srcmode, row);
        float* xd = xrow_dst(p, row);
        const float* g2 = modptr(p, layer, modrow(row), 2);
#pragma unroll
        for (int bj = 0; bj < 2; ++bj)
#pragma unroll
          for (int n = 0; n < 2; ++n) {
            const int col = bcol + bj * 128 + wc * 32 + n * 16 + fq * 4;
            f32x4 a = acc[ai][bj][m][n];
            float4 x = *(const float4*)(xs + col), g = *(const float4*)(g2 + col);
            x.x += g.x * a[0]; x.y += g.y * a[1]; x.z += g.z * a[2]; x.w += g.w * a[3];
            *(float4*)(xd + col) = x;
          }
      } else if (EPI == 2) {
        bf16_t* ACT = (bf16_t*)(p.ws + OFF_ACTA) + (size_t)row * FF;
#pragma unroll
        for (int bj = 0; bj < 2; ++bj) {
          const int f = (((bcol + bj * 128 + wc * 32) >> 5) << 4) + fq * 4;
          f32x4 g = acc[ai][bj][m][0], u = acc[ai][bj][m][1];
          uint2 o;
          o.x = pack2(siluf_(g[0]) * u[0], siluf_(g[1]) * u[1]);
          o.y = pack2(siluf_(g[2]) * u[2], siluf_(g[3]) * u[3]);
          *(uint2*)(ACT + f) = o;
        }
      } else {
        bf16_t* YS = (bf16_t*)(p.ws + OFF_U) + (size_t)row * DM;
#pragma unroll
        for (int bj = 0; bj < 2; ++bj)
#pragma unroll
          for (int n = 0; n < 2; ++n) {
            const int col = bcol + bj * 128 + wc * 32 + n * 16 + fq * 4;
            f32x4 a = acc[ai][bj][m][n];
            uint2 o; o.x = pack2(a[0], a[1]); o.y = pack2(a[2], a[3]);
            *(uint2*)(YS + col) = o;
          }
      }
    }
}

__device__ __forceinline__ void phase_inproj(const Params& p, int layer, int bid, int nb) {
  const bf16_t* A = (const bf16_t*)(p.ws + OFF_ACTA);
  const bf16_t* Bt = (const bf16_t*)(p.ws + OFF_WINT) + (size_t)layer * INP * DM;
  constexpr int MT = NTOK / 256, NTL = INP / 256;
  for (int t = bid; t < MT * NTL; t += nb) {
    int mt = t / NTL, nt = t % NTL;
    gemm256<0>(p, layer, 0, A, nullptr, mt * 256, Bt, nt * 256, DM, mt * 256);
  }
}
__device__ __forceinline__ void phase_outproj(const Params& p, int layer, int bid, int nb) {
  const bf16_t* A = (const bf16_t*)(p.ws + OFF_ACTA);
  const bf16_t* Bt = (const bf16_t*)(p.ws + OFF_WOUTT) + (size_t)layer * DM * DM;
  const int MT = (layer == 0 ? NTOK : NLAT) / 256, NTL = DM / 256;
  for (int t = bid; t < MT * NTL; t += nb) {
    int mt = t / NTL, nt = t % NTL;
    gemm256<1>(p, layer, layer == 0 ? 0 : 1, A, nullptr, mt * 256, Bt, nt * 256, DM, mt * 256);
  }
}
__device__ __forceinline__ void phase_moe1(const Params& p, int layer, int bid, int nb) {
  const bf16_t* A = (const bf16_t*)(p.ws + OFF_ACTB);
  const int* ROWL = (const int*)(p.ws + OFF_ROWL);
  const int MT = (layer == 0 ? SLOTS : SLOTS_L) / 256;
  for (int t = bid; t < NEXP * MT * 4; t += nb) {
    int e = t / (MT * 4), r = t % (MT * 4), nt = r / MT, mt = r % MT;
    const bf16_t* Bt = (const bf16_t*)(p.ws + OFF_WGU) + (size_t)(layer * NEXP + e) * 1024 * DM;
    gemm256<2>(p, layer, 0, A, ROWL, e * SLOTS + mt * 256, Bt, nt * 256, DM, e * SLOTS + mt * 256);
  }
}
__device__ __forceinline__ void phase_moe2(const Params& p, int layer, int bid, int nb) {
  const bf16_t* A = (const bf16_t*)(p.ws + OFF_ACTA);
  const int MT = (layer == 0 ? SLOTS : SLOTS_L) / 256;
  for (int t = bid; t < NEXP * MT * 4; t += nb) {
    int e = t / (MT * 4), r = t % (MT * 4), nt = r / MT, mt = r % MT;
    const bf16_t* Bt = (const bf16_t*)(p.ws + OFF_WDT) + (size_t)(layer * NEXP + e) * DM * FF;
    gemm256<3>(p, layer, 0, A, nullptr, e * SLOTS + mt * 256, Bt, nt * 256, FF, e * SLOTS + mt * 256);
  }
}

__device__ __forceinline__ void mma16(const bf16_t* At, int r0, const bf16_t* Bt, f32x4* acc, int fr, int fq) {
#pragma unroll
  for (int ks = 0; ks < 2; ++ks) {
    bf16x8 a = *(const bf16x8*)(At + (r0 + fr) * TS + ks * 32 + fq * 8);
#pragma unroll
    for (int nf = 0; nf < 4; ++nf) {
      bf16x8 b = *(const bf16x8*)(Bt + (nf * 16 + fr) * TS + ks * 32 + fq * 8);
      acc[nf] = __builtin_amdgcn_mfma_f32_16x16x32_bf16(a, b, acc[nf], 0, 0, 0);
    }
  }
}

struct StepGeo { int rowbase, seglen, T0; bool wout, second; };
__device__ __forceinline__ StepGeo step_geo(int L, int b, int d, int s) {
  StepGeo g;
  const bool ctx = s < 4;
  const int c = ctx ? s : s - 4;
  const int nch = ctx ? (CTXL / 64) : (SEQ / 64);
  const int nc = d ? nch - 1 - c : c;
  g.seglen = ctx ? CTXL : SEQ;
  g.rowbase = ctx ? NLAT + b * CTXL : b * SEQ;
  g.T0 = nc * 64;
  g.wout = !(L == 1 && ctx);
  const int base = ctx ? 0 : 4;
  const int s_other = d ? base + nc : base + (nch - 1 - nc);
  g.second = s_other < s;
  return g;
}

__device__ __forceinline__ void chain_hgrn_fast(const Params& p, int L, int bh) {
  const int b = bh >> 2, h = bh & 3;
  int tx_ = threadIdx.x; asm volatile("" : "+v"(tx_));
  const int d = tx_ >> 8, tid = tx_ & 255;
  char* sm = dynsmem + d * GROUP_LDS;
  float* CUM = (float*)sm;
  bf16_t* QT = (bf16_t*)(sm + 16640);
  bf16_t* KT = QT + 64 * TS;
  bf16_t* KE = KT + 64 * TS;
  bf16_t* VT = KE + 64 * TS;
  bf16_t* ST = VT + 64 * TS;
  float* SEG = (float*)(ST + 64 * TS);
  const int w = tid >> 6, lane = tid & 63, fr = lane & 15, fq = lane >> 4;
  const int ti = tid >> 2, kq = (tid & 3) * 16;
  const bf16_t* U = (const bf16_t*)(p.ws + OFF_U);
  bf16_t* Y = (bf16_t*)(p.ws + OFF_ACTA);
  float lb[16];
#pragma unroll
  for (int e = 0; e < 16; ++e) lb[e] = (L == 1) ? sigmoidf_(p.in[I_HLB][256 + h * 64 + kq + e] - p.in[I_HLB][h * 64 + kq + e]) : 0.f;
  float nwv[4];
#pragma unroll
  for (int nf = 0; nf < 4; ++nf) nwv[nf] = p.in[I_HNW][L * 256 + h * 64 + nf * 16 + fr];
  f32x4 S[4];
#pragma unroll
  for (int nf = 0; nf < 4; ++nf) S[nf] = (f32x4){0.f, 0.f, 0.f, 0.f};
  uint4 cq0, cq1, cf0, cf1, cv0, cv1;
  {
    StepGeo g = step_geo(L, b, d, 0);
    const bf16_t* ur = U + (size_t)(g.rowbase + (d ? g.T0 + 63 - ti : g.T0 + ti)) * INP + h * 64 + kq;
    cq0 = ((const uint4*)(ur + 512))[0]; cq1 = ((const uint4*)(ur + 512))[1];
    cf0 = ((const uint4*)(ur + 768 + d * 256))[0]; cf1 = ((const uint4*)(ur + 768 + d * 256))[1];
    cv0 = ((const uint4*)(ur + 1280))[0]; cv1 = ((const uint4*)(ur + 1280))[1];
  }
  for (int s = 0; s < 36; ++s) {
    const StepGeo g = step_geo(L, b, d, s);
    const bf16_t* urn = U;
    if (s + 1 < 36) {
      StepGeo g2 = step_geo(L, b, d, s + 1);
      urn = U + (size_t)(g2.rowbase + (d ? g2.T0 + 63 - ti : g2.T0 + ti)) * INP + h * 64 + kq;
    }
    float qv[16], kkv[16];
    {
      uint4 cq[2] = {cq0, cq1}, cf[2] = {cf0, cf1};
#pragma unroll
      for (int e = 0; e < 16; ++e) {
        float qr = unpk(cq, e), fr_ = unpk(cf, e);
        qv[e] = siluf_(qr);
        float f = lb[e] + (1.f - lb[e]) * sigmoidf_(fr_);
        kkv[e] = 1.f - f;
        CUM[ti * 65 + kq + e] = logf(f);
      }
    }
    if (s + 1 < 36) {
      cq0 = ((const uint4*)(urn + 512))[0]; cq1 = ((const uint4*)(urn + 512))[1];
      cf0 = ((const uint4*)(urn + 768 + d * 256))[0]; cf1 = ((const uint4*)(urn + 768 + d * 256))[1];
    }
    __syncthreads();
    {
      float run = 0.f;
#pragma unroll
      for (int r = 0; r < 16; ++r) { int idx = (w * 16 + r) * 65 + lane; run += CUM[idx]; CUM[idx] = run; }
      SEG[w * 64 + lane] = run;
    }
    __syncthreads();
    {
      float off = 0.f;
      for (int s2 = 0; s2 < w; ++s2) off += SEG[s2 * 64 + lane];
      if (w > 0) {
#pragma unroll
        for (int r = 0; r < 16; ++r) CUM[(w * 16 + r) * 65 + lane] += off;
      }
    }
    __syncthreads();
    {
      uint4 cv[2] = {cv0, cv1};
      unsigned qp[8], kp[8];
#pragma unroll
      for (int e2 = 0; e2 < 8; ++e2) {
        float qa[2], ka[2];
#pragma unroll
        for (int u = 0; u < 2; ++u) {
          const int e = e2 * 2 + u, k = kq + e;
          float ci = CUM[ti * 65 + k], cm = CUM[31 * 65 + k], ce = CUM[63 * 65 + k];
          qa[u] = qv[e] * expf(fminf(ci - cm, 80.f));
          ka[u] = kkv[e] * expf(fminf(cm - ci, 80.f));
          KE[k * TS + ti] = f2bf(kkv[e] * expf(ce - ci));
          VT[k * TS + ti] = unpk_raw(cv, e);
        }
        qp[e2] = pack2(qa[0], qa[1]);
        kp[e2] = pack2(ka[0], ka[1]);
      }
      uint4* qd = (uint4*)(QT + ti * TS + kq);
      uint4* kd = (uint4*)(KT + ti * TS + kq);
      qd[0] = make_uint4(qp[0], qp[1], qp[2], qp[3]); qd[1] = make_uint4(qp[4], qp[5], qp[6], qp[7]);
      kd[0] = make_uint4(kp[0], kp[1], kp[2], kp[3]); kd[1] = make_uint4(kp[4], kp[5], kp[6], kp[7]);
    }
    if (s + 1 < 36) { cv0 = ((const uint4*)(urn + 1280))[0]; cv1 = ((const uint4*)(urn + 1280))[1]; }
    float dec[4];
#pragma unroll
    for (int nf = 0; nf < 4; ++nf) {
      const int k = nf * 16 + fr;
      float em = expf(CUM[31 * 65 + k]);
      dec[nf] = expf(CUM[63 * 65 + k]);
#pragma unroll
      for (int jj = 0; jj < 4; ++jj) ST[(16 * w + 4 * fq + jj) * TS + k] = f2bf(S[nf][jj] * em);
    }
    __syncthreads();
    f32x4 aP[4], aY[4];
#pragma unroll
    for (int nf = 0; nf < 4; ++nf) { aP[nf] = (f32x4){0.f, 0.f, 0.f, 0.f}; aY[nf] = (f32x4){0.f, 0.f, 0.f, 0.f}; }
    mma16(QT, 16 * w, KT, aP, fr, fq);
    mma16(QT, 16 * w, ST, aY, fr, fq);
    CFENCE();
#pragma unroll
    for (int nf = 0; nf < 4; ++nf)
#pragma unroll
      for (int jj = 0; jj < 4; ++jj) {
        const int t = 16 * w + 4 * fq + jj, sc = nf * 16 + fr;
        QT[t * TS + sc] = f2bf(sc <= t ? aP[nf][jj] : 0.f);
      }
    CFENCE();
    mma16(QT, 16 * w, VT, aY, fr, fq);
#pragma unroll
    for (int nf = 0; nf < 4; ++nf)
#pragma unroll
      for (int jj = 0; jj < 4; ++jj) S[nf][jj] *= dec[nf];
    mma16(VT, 16 * w, KE, S, fr, fq);
    if (g.wout) {
#pragma unroll
      for (int jj = 0; jj < 4; ++jj) {
        const int t = 16 * w + 4 * fq + jj;
        const size_t row = (size_t)(g.rowbase + (d ? g.T0 + 63 - t : g.T0 + t));
        bf16_t* yr = Y + row * DM + 256 + h * 64;
        if (!g.second) {
#pragma unroll
          for (int nf = 0; nf < 4; ++nf) yr[nf * 16 + fr] = f2bf(aY[nf][jj]);
        } else {
          const bf16_t* gr = U + row * INP + 1536 + h * 64;
          float tot[4], ss = 0.f;
#pragma unroll
          for (int nf = 0; nf < 4; ++nf) { tot[nf] = bf2f(yr[nf * 16 + fr]) + aY[nf][jj]; ss += tot[nf] * tot[nf]; }
          ss = sum16(ss);
          const float rn = rsqrtf(ss * (1.f / 64.f) + EPSF);
#pragma unroll
          for (int nf = 0; nf < 4; ++nf) yr[nf * 16 + fr] = f2bf(tot[nf] * rn * nwv[nf] * siluf_(bf2f(gr[nf * 16 + fr])));
        }
      }
    }
  }
  __syncthreads();
}

__device__ __forceinline__ void chain_ssd_fast(const Params& p, int L, int bh) {
  const int b = bh >> 2, h = bh & 3, gg = h >> 1;
  int tx_ = threadIdx.x; asm volatile("" : "+v"(tx_));
  const int d = tx_ >> 8, tid = tx_ & 255;
  char* sm = dynsmem + d * GROUP_LDS;
  bf16_t* RAW = (bf16_t*)sm;
  bf16_t* CM = (bf16_t*)(sm + 26112);
  bf16_t* BM = CM + 64 * TS;
  bf16_t* XT = BM + 64 * TS;
  bf16_t* BW = XT + 64 * TS;
  bf16_t* SS = BW + 64 * TS;
  float* DT = (float*)(SS + 64 * TS);
  float* CUMV = DT + 64;
  float* CW = CUMV + 64;
  float* CB = CW + 768;
  const int w = tid >> 6, lane = tid & 63, fr = lane & 15, fq = lane >> 4;
  const int ti = tid >> 2, kq = (tid & 3) * 16;
  const bf16_t* U = (const bf16_t*)(p.ws + OFF_U);
  bf16_t* Y = (bf16_t*)(p.ws + OFF_ACTA);
  __syncthreads();
  for (int i = tid; i < 960; i += 256) {
    if (i < 768) {
      int grp = i >> 8, j = (i >> 6) & 3, c = i & 63;
      int col = grp == 0 ? h * 64 + c : (grp == 1 ? 256 + gg * 64 + c : 384 + gg * 64 + c);
      CW[i] = p.in[I_SCW][(L * 4 + j) * 512 + col];
    } else {
      int i2 = i - 768; int grp = i2 >> 6, c = i2 & 63;
      int col = grp == 0 ? h * 64 + c : (grp == 1 ? 256 + gg * 64 + c : 384 + gg * 64 + c);
      CB[i2] = p.in[I_SCB][L * 512 + col];
    }
  }
  const float dsk = p.in[I_SDSK][L * 4 + h];
  const float Aa = -expf(p.in[I_SALOG][(L * 2 + d) * 4 + h]);
  const float dtb = p.in[I_SDTB][(L * 2 + d) * 4 + h];
  f32x4 S[4];
#pragma unroll
  for (int nf = 0; nf < 4; ++nf) S[nf] = (f32x4){0.f, 0.f, 0.f, 0.f};
  uint4 nr0, nr1, nr2, nr3, nr4, nr5, nr6;
  bf16_t ndt = 0;
#define SSD_LD1(I, DST)                                                                                  \
  {                                                                                                      \
    int c16 = tid + 256 * (I);                                                                           \
    uint4 v = make_uint4(0u, 0u, 0u, 0u);                                                                \
    if (c16 < 1632) {                                                                                    \
      int grp = c16 / 544, rem = c16 % 544, r = rem >> 3, part = rem & 7;                                \
      int t = G_.T0 - 2 + r;                                                                             \
      int gcol = grp == 0 ? 2048 + h * 64 : (grp == 1 ? 2304 + gg * 64 : 2432 + gg * 64);               \
      if (t >= 0 && t < G_.seglen) v = *(const uint4*)(U + (size_t)(G_.rowbase + t) * INP + gcol + part * 8); \
    }                                                                                                    \
    DST = v;                                                                                             \
  }
#define SSD_LOAD()                                                                                       \
  {                                                                                                      \
    SSD_LD1(0, nr0) SSD_LD1(1, nr1) SSD_LD1(2, nr2) SSD_LD1(3, nr3) SSD_LD1(4, nr4) SSD_LD1(5, nr5) SSD_LD1(6, nr6) \
    if (tid < 64) ndt = U[(size_t)(G_.rowbase + (d ? G_.T0 + 63 - tid : G_.T0 + tid)) * INP + 2560 + d * 4 + h]; \
  }
#define SSD_ST1(I, SRC) { int c16 = tid + 256 * (I); if (c16 < 1632) *(uint4*)(RAW + c16 * 8) = SRC; }
  { StepGeo G_ = step_geo(L, b, d, 0); SSD_LOAD(); }
  for (int s = 0; s < 36; ++s) {
    const StepGeo g = step_geo(L, b, d, s);
    __syncthreads();
    SSD_ST1(0, nr0) SSD_ST1(1, nr1) SSD_ST1(2, nr2) SSD_ST1(3, nr3) SSD_ST1(4, nr4) SSD_ST1(5, nr5) SSD_ST1(6, nr6)
    if (tid < 64) {
      float dt = softplusf_(bf2f(ndt) + dtb);
      float v = dt * Aa;
#pragma unroll
      for (int o = 1; o < 64; o <<= 1) { float n = __shfl_up(v, o); if (lane >= o) v += n; }
      DT[tid] = dt; CUMV[tid] = v;
    }
    if (s + 1 < 36) { StepGeo G_ = step_geo(L, b, d, s + 1); SSD_LOAD(); }
    __syncthreads();
    {
      const int tn = d ? 63 - ti : ti;
      const float cend = CUMV[63];
      const float wend = DT[ti] * expf(cend - CUMV[ti]);
#pragma unroll
      for (int grp = 0; grp < 3; ++grp) {
        float val[16];
#pragma unroll
        for (int e = 0; e < 16; ++e) val[e] = CB[grp * 64 + kq + e];
#pragma unroll
        for (int j = 0; j < 4; ++j) {
          const uint4* rp = (const uint4*)(RAW + (grp * 68 + tn + j) * 64 + kq);
          uint4 rr[2] = {rp[0], rp[1]};
#pragma unroll
          for (int e = 0; e < 16; ++e) val[e] += unpk(rr, e) * CW[(grp * 4 + j) * 64 + kq + e];
        }
#pragma unroll
        for (int e = 0; e < 16; ++e) val[e] = siluf_(val[e]);
        if (grp == 0) {
#pragma unroll
          for (int e = 0; e < 16; ++e) XT[(kq + e) * TS + ti] = f2bf(val[e]);
        } else {
          unsigned pk[8];
#pragma unroll
          for (int e2 = 0; e2 < 8; ++e2) pk[e2] = pack2(val[2 * e2], val[2 * e2 + 1]);
          uint4* dst = (uint4*)((grp == 1 ? BM : CM) + ti * TS + kq);
          dst[0] = make_uint4(pk[0], pk[1], pk[2], pk[3]); dst[1] = make_uint4(pk[4], pk[5], pk[6], pk[7]);
          if (grp == 1) {
#pragma unroll
            for (int e = 0; e < 16; ++e) BW[(kq + e) * TS + ti] = f2bf(val[e] * wend);
          }
        }
      }
    }
    float cumt[4], cums[4], dts[4];
    const float cend = CUMV[63];
#pragma unroll
    for (int jj = 0; jj < 4; ++jj) cumt[jj] = CUMV[16 * w + 4 * fq + jj];
#pragma unroll
    for (int nf = 0; nf < 4; ++nf) {
      cums[nf] = CUMV[nf * 16 + fr]; dts[nf] = DT[nf * 16 + fr];
#pragma unroll
      for (int jj = 0; jj < 4; ++jj) SS[(16 * w + 4 * fq + jj) * TS + nf * 16 + fr] = f2bf(S[nf][jj]);
    }
    __syncthreads();
    f32x4 aP[4], aY[4];
#pragma unroll
    for (int nf = 0; nf < 4; ++nf) { aP[nf] = (f32x4){0.f, 0.f, 0.f, 0.f}; aY[nf] = (f32x4){0.f, 0.f, 0.f, 0.f}; }
    mma16(CM, 16 * w, BM, aP, fr, fq);
    mma16(CM, 16 * w, SS, aY, fr, fq);
    CFENCE();
#pragma unroll
    for (int nf = 0; nf < 4; ++nf)
#pragma unroll
      for (int jj = 0; jj < 4; ++jj) {
        const int t = 16 * w + 4 * fq + jj, sc = nf * 16 + fr;
        float pv = sc <= t ? aP[nf][jj] * expf(cumt[jj] - cums[nf]) * dts[nf] : 0.f;
        CM[t * TS + sc] = f2bf(pv);
        aY[nf][jj] *= expf(cumt[jj]);
      }
    CFENCE();
    mma16(CM, 16 * w, XT, aY, fr, fq);
    {
      const float de = expf(cend);
#pragma unroll
      for (int nf = 0; nf < 4; ++nf)
#pragma unroll
        for (int jj = 0; jj < 4; ++jj) S[nf][jj] *= de;
    }
    mma16(XT, 16 * w, BW, S, fr, fq);
    if (g.wout) {
#pragma unroll
      for (int jj = 0; jj < 4; ++jj) {
        const int t = 16 * w + 4 * fq + jj;
        const size_t row = (size_t)(g.rowbase + (d ? g.T0 + 63 - t : g.T0 + t));
        bf16_t* yr = Y + row * DM + 512 + h * 64;
        if (!g.second) {
#pragma unroll
          for (int nf = 0; nf < 4; ++nf) yr[nf * 16 + fr] = f2bf(aY[nf][jj]);
        } else {
          const bf16_t* zr = U + row * INP + 1792 + h * 64;
#pragma unroll
          for (int nf = 0; nf < 4; ++nf) {
            const int pc = nf * 16 + fr;
            float tot = bf2f(yr[pc]) + aY[nf][jj] + dsk * bf2f(XT[pc * TS + t]);
            yr[pc] = f2bf(tot * siluf_(bf2f(zr[pc])));
          }
        }
      }
    }
  }
  __syncthreads();
#undef SSD_LOAD
#undef SSD_LD1
#undef SSD_ST1
}

__device__ __forceinline__ void chain_lru_fast(const Params& p, int L, int bh) {
  const int b = bh >> 2, h = bh & 3;
  int tx_ = threadIdx.x; asm volatile("" : "+v"(tx_));
  const int d = tx_ >> 8, tid = tx_ & 255;
  char* sm = dynsmem + d * GROUP_LDS;
  bf16_t* RAW = (bf16_t*)sm;
  bf16_t* XC = (bf16_t*)(sm + 8704);
  bf16_t* WR = XC + 64 * TS;
  bf16_t* WI = WR + 64 * TS;
  float* AA = (float*)(WI + 64 * TS);
  float* BB = AA + 64 * 65;
  float* SEGA = BB + 64 * 65;
  float* SEGB = SEGA + 256;
  float* CW = SEGB + 256;
  float* CB = CW + 256;
  const int w = tid >> 6, lane = tid & 63, fr = lane & 15, fq = lane >> 4;
  const int ti = tid >> 2, kq = (tid & 3) * 16;
  const bf16_t* U = (const bf16_t*)(p.ws + OFF_U);
  bf16_t* Y = (bf16_t*)(p.ws + OFF_ACTA);
  __syncthreads();
  for (int i = tid; i < 320; i += 256) {
    if (i < 256) CW[i] = p.in[I_LCW][(L * 4 + (i >> 6)) * 256 + h * 64 + (i & 63)];
    else CB[i - 256] = p.in[I_LCB][L * 256 + h * 64 + (i - 256)];
  }
  {
    const bf16_t* wrs = (const bf16_t*)(p.ws + OFF_LRUW) + (size_t)(((L * 2 + d) * 2 + 0) * 4 + h) * 4096;
    const bf16_t* wis = (const bf16_t*)(p.ws + OFF_LRUW) + (size_t)(((L * 2 + d) * 2 + 1) * 4 + h) * 4096;
    for (int c = tid; c < 512; c += 256) {
      int r = c >> 3, part = c & 7;
      *(uint4*)(WR + r * TS + part * 8) = *(const uint4*)(wrs + r * 64 + part * 8);
      *(uint4*)(WI + r * TS + part * 8) = *(const uint4*)(wis + r * 64 + part * 8);
    }
  }
  float br[4], bi[4], sp[4];
#pragma unroll
  for (int nf = 0; nf < 4; ++nf) {
    const int ch = (L * 2 + d) * 256 + h * 64 + nf * 16 + fr;
    br[nf] = p.in[I_LBR][ch]; bi[nf] = p.in[I_LBI][ch]; sp[nf] = softplusf_(-p.in[I_LLAM][ch]);
  }
  float hst = 0.f;
  uint4 nr0, nr1, nr2;
#define LRU_LD1(I, DST)                                                                                  \
  {                                                                                                      \
    int c16 = tid + 256 * (I);                                                                           \
    uint4 v = make_uint4(0u, 0u, 0u, 0u);                                                                \
    if (c16 < 544) {                                                                                     \
      int r = c16 >> 3, part = c16 & 7;                                                                  \
      int t = G_.T0 - 2 + r;                                                                             \
      if (t >= 0 && t < G_.seglen) v = *(const uint4*)(U + (size_t)(G_.rowbase + t) * INP + h * 64 + part * 8); \
    }                                                                                                    \
    DST = v;                                                                                             \
  }
#define LRU_ST1(I, SRC) { int c16 = tid + 256 * (I); if (c16 < 544) *(uint4*)(RAW + c16 * 8) = SRC; }
  { StepGeo G_ = step_geo(L, b, d, 0); LRU_LD1(0, nr0) LRU_LD1(1, nr1) LRU_LD1(2, nr2) }
  for (int s = 0; s < 36; ++s) {
    const StepGeo g = step_geo(L, b, d, s);
    __syncthreads();
    LRU_ST1(0, nr0) LRU_ST1(1, nr1) LRU_ST1(2, nr2)
    if (s + 1 < 36) { StepGeo G_ = step_geo(L, b, d, s + 1); LRU_LD1(0, nr0) LRU_LD1(1, nr1) LRU_LD1(2, nr2) }
    __syncthreads();
    {
      const int tn = d ? 63 - ti : ti;
      float val[16];
#pragma unroll
      for (int e = 0; e < 16; ++e) val[e] = CB[kq + e];
#pragma unroll
      for (int j = 0; j < 4; ++j) {
        const uint4* rp = (const uint4*)(RAW + (tn + j) * 64 + kq);
        uint4 rr[2] = {rp[0], rp[1]};
#pragma unroll
        for (int e = 0; e < 16; ++e) val[e] += unpk(rr, e) * CW[j * 64 + kq + e];
      }
      unsigned pk[8];
#pragma unroll
      for (int e2 = 0; e2 < 8; ++e2) pk[e2] = pack2(val[2 * e2], val[2 * e2 + 1]);
      uint4* dst = (uint4*)(XC + ti * TS + kq);
      dst[0] = make_uint4(pk[0], pk[1], pk[2], pk[3]); dst[1] = make_uint4(pk[4], pk[5], pk[6], pk[7]);
    }
    __syncthreads();
    {
      f32x4 aR[4], aI[4];
#pragma unroll
      for (int nf = 0; nf < 4; ++nf) { aR[nf] = (f32x4){0.f, 0.f, 0.f, 0.f}; aI[nf] = (f32x4){0.f, 0.f, 0.f, 0.f}; }
      mma16(XC, 16 * w, WR, aR, fr, fq);
      mma16(XC, 16 * w, WI, aI, fr, fq);
#pragma unroll
      for (int nf = 0; nf < 4; ++nf)
#pragma unroll
        for (int jj = 0; jj < 4; ++jj) {
          const int t = 16 * w + 4 * fq + jj, e = nf * 16 + fr;
          float r = sigmoidf_(aR[nf][jj] + br[nf]);
          float ig = sigmoidf_(aI[nf][jj] + bi[nf]);
          float la = -8.f * r * sp[nf];
          float xcv = bf2f(XC[t * TS + e]);
          AA[t * 65 + e] = expf(la);
          BB[t * 65 + e] = sqrtf(-expm1f(2.f * la)) * (ig * xcv);
        }
    }
    __syncthreads();
    {
      float A = 1.f, B = 0.f;
#pragma unroll
      for (int r = 0; r < 16; ++r) { float a = AA[(w * 16 + r) * 65 + lane], bb = BB[(w * 16 + r) * 65 + lane]; B = a * B + bb; A = a * A; }
      SEGA[w * 64 + lane] = A; SEGB[w * 64 + lane] = B;
    }
    __syncthreads();
    {
      float hin = hst, hall = hst;
#pragma unroll
      for (int s2 = 0; s2 < 4; ++s2) {
        float a = SEGA[s2 * 64 + lane], bb = SEGB[s2 * 64 + lane];
        hall = a * hall + bb;
        if (s2 < w) hin = a * hin + bb;
      }
      hst = hall;
      float hv = hin;
#pragma unroll
      for (int r = 0; r < 16; ++r) {
        const int t = w * 16 + r;
        hv = AA[t * 65 + lane] * hv + BB[t * 65 + lane];
        if (g.wout) {
          const size_t row = (size_t)(g.rowbase + (d ? g.T0 + 63 - t : g.T0 + t));
          bf16_t* yp = Y + row * DM + h * 64 + lane;
          if (!g.second) *yp = f2bf(hv);
          else {
            float tot = bf2f(*yp) + hv;
            float gate = bf2f(U[row * INP + 256 + h * 64 + lane]);
            *yp = f2bf(tot * gelu_tanh(gate));
          }
        }
      }
    }
  }
  __syncthreads();
#undef LRU_LD1
#undef LRU_ST1
}

__device__ __forceinline__ void mlaproj_item_fast(const Params& p, int L, int item) {
  char* sm = dynsmem;
  bf16_t* AQ = (bf16_t*)sm;
  bf16_t* AKV = AQ + 128 * 200;
  int tx_ = threadIdx.x; asm volatile("" : "+v"(tx_));
  const int tid = tx_, w = tid >> 6, lane = tid & 63, fr = lane & 15, fq = lane >> 4;
  const int ti = tid >> 2, part = tid & 3;
  const bf16_t* U = (const bf16_t*)(p.ws + OFF_U);
  const bf16_t* WQT = (const bf16_t*)(p.ws + OFF_WQT) + (size_t)L * 384 * 192;
  const bf16_t* WKVT = (const bf16_t*)(p.ws + OFF_WKVT) + (size_t)L * 512 * 128;
  const float* ROPE = (const float*)(p.ws + OFF_ROPE);
  const float* qan = p.in[I_MQAN] + L * 192;
  const float* kvan = p.in[I_MKVAN] + L * 128;
  const float* qn = p.in[I_MQN] + L * 96;
  const float* kn = p.in[I_MKN] + L * 96;
  bf16_t* QB = (bf16_t*)(p.ws + OFF_ACTB + QB_OFF);
  bf16_t* KB = (bf16_t*)(p.ws + OFF_ACTB + KB_OFF);
  bf16_t* VB = (bf16_t*)(p.ws + OFF_ACTB + VB_OFF);
  const int row0 = item * 128;
  const bool lat = row0 < NLAT;
  const int b = lat ? (row0 >> 11) : ((row0 - NLAT) >> 8);
  const int n0 = lat ? (row0 & 2047) : ((row0 - NLAT) & 255);
  const int key0 = lat ? CTXL + n0 : n0;
  __syncthreads();
  {
    const bf16_t* ur = U + (size_t)(row0 + ti) * INP + 2568;
    uint4 q6[6], k4[4], r1;
#pragma unroll
    for (int i = 0; i < 6; ++i) q6[i] = *(const uint4*)(ur + part * 48 + i * 8);
#pragma unroll
    for (int i = 0; i < 4; ++i) k4[i] = *(const uint4*)(ur + 192 + part * 32 + i * 8);
    r1 = *(const uint4*)(ur + 320 + part * 8);
    float sq = 0.f, sk = 0.f, sr = 0.f;
    float qf[48], kf[32], rf[8];
#pragma unroll
    for (int i = 0; i < 6; ++i) {
      const unsigned wv[4] = {q6[i].x, q6[i].y, q6[i].z, q6[i].w};
#pragma unroll
      for (int j = 0; j < 4; ++j) { float a = __uint_as_float(wv[j] << 16), c = __uint_as_float(wv[j] & 0xffff0000u); qf[i * 8 + 2 * j] = a; qf[i * 8 + 2 * j + 1] = c; sq += a * a + c * c; }
    }
#pragma unroll
    for (int i = 0; i < 4; ++i) {
      const unsigned wv[4] = {k4[i].x, k4[i].y, k4[i].z, k4[i].w};
#pragma unroll
      for (int j = 0; j < 4; ++j) { float a = __uint_as_float(wv[j] << 16), c = __uint_as_float(wv[j] & 0xffff0000u); kf[i * 8 + 2 * j] = a; kf[i * 8 + 2 * j + 1] = c; sk += a * a + c * c; }
    }
    {
      const unsigned wv[4] = {r1.x, r1.y, r1.z, r1.w};
#pragma unroll
      for (int j = 0; j < 4; ++j) { float a = __uint_as_float(wv[j] << 16), c = __uint_as_float(wv[j] & 0xffff0000u); rf[2 * j] = a; rf[2 * j + 1] = c; sr += a * a + c * c; }
    }
    sq += __shfl_xor(sq, 1); sq += __shfl_xor(sq, 2);
    sk += __shfl_xor(sk, 1); sk += __shfl_xor(sk, 2);
    sr += __shfl_xor(sr, 1); sr += __shfl_xor(sr, 2);
    const float rq = rsqrtf(sq * (1.f / 192.f) + EPSF), rk = rsqrtf(sk * (1.f / 128.f) + EPSF), rr = rsqrtf(sr * (1.f / 32.f) + EPSF);
#pragma unroll
    for (int i = 0; i < 6; ++i) {
      unsigned pk[4];
#pragma unroll
      for (int j = 0; j < 4; ++j) { int c = part * 48 + i * 8 + 2 * j; pk[j] = pack2(qf[i * 8 + 2 * j] * rq * qan[c], qf[i * 8 + 2 * j + 1] * rq * qan[c + 1]); }
      *(uint4*)(AQ + ti * 200 + part * 48 + i * 8) = make_uint4(pk[0], pk[1], pk[2], pk[3]);
    }
#pragma unroll
    for (int i = 0; i < 4; ++i) {
      unsigned pk[4];
#pragma unroll
      for (int j = 0; j < 4; ++j) { int c = part * 32 + i * 8 + 2 * j; pk[j] = pack2(kf[i * 8 + 2 * j] * rk * kvan[c], kf[i * 8 + 2 * j + 1] * rk * kvan[c + 1]); }
      *(uint4*)(AKV + ti * 136 + part * 32 + i * 8) = make_uint4(pk[0], pk[1], pk[2], pk[3]);
    }
    {
      const int n = n0 + ti;
      unsigned pk[4];
#pragma unroll
      for (int j = 0; j < 4; ++j) {
        const int c = part * 8 + 2 * j, pi = c >> 1;
        float t1 = rf[2 * j] * rr * kn[64 + c], t2 = rf[2 * j + 1] * rr * kn[64 + c + 1];
        if (lat) {
          float cs = ROPE[(n * 16 + pi) * 2], sn = ROPE[(n * 16 + pi) * 2 + 1];
          float o1 = t1 * cs - t2 * sn, o2 = t1 * sn + t2 * cs;
          t1 = o1; t2 = o2;
        }
        pk[j] = pack2(t1, t2);
      }
      const uint4 kv4 = make_uint4(pk[0], pk[1], pk[2], pk[3]);
#pragma unroll
      for (int hh = 0; hh < 4; ++hh) *(uint4*)(KB + (((size_t)(b * 4 + hh)) * NKEY + key0 + ti) * 96 + 64 + part * 8) = kv4;
    }
  }
  __syncthreads();
  const float qscale = 0.10206207261596577f;
  for (int hh = 0; hh < 4; ++hh) {
    f32x4 acc[6];
#pragma unroll
    for (int nf = 0; nf < 6; ++nf) acc[nf] = (f32x4){0.f, 0.f, 0.f, 0.f};
#pragma unroll
    for (int ks = 0; ks < 6; ++ks) {
      bf16x8 a = *(const bf16x8*)(AQ + (16 * w + fr) * 200 + ks * 32 + fq * 8);
#pragma unroll
      for (int nf = 0; nf < 6; ++nf) {
        bf16x8 bb = *(const bf16x8*)(WQT + (size_t)(hh * 96 + nf * 16 + fr) * 192 + ks * 32 + fq * 8);
        acc[nf] = __builtin_amdgcn_mfma_f32_16x16x32_bf16(a, bb, acc[nf], 0, 0, 0);
      }
    }
#pragma unroll
    for (int jj = 0; jj < 4; ++jj) {
      const int rl = 16 * w + 4 * fq + jj;
      float s1 = 0.f, s2 = 0.f;
#pragma unroll
      for (int nf = 0; nf < 4; ++nf) s1 += acc[nf][jj] * acc[nf][jj];
      s2 = acc[4][jj] * acc[4][jj] + acc[5][jj] * acc[5][jj];
      s1 = sum16(s1); s2 = sum16(s2);
      const float r1 = rsqrtf(s1 * (1.f / 64.f) + EPSF) * qscale, r2 = rsqrtf(s2 * (1.f / 32.f) + EPSF) * qscale;
      bf16_t* qd = QB + ((size_t)(row0 + rl) * 4 + hh) * 96;
#pragma unroll
      for (int nf = 0; nf < 4; ++nf) qd[nf * 16 + fr] = f2bf(acc[nf][jj] * r1 * qn[nf * 16 + fr]);
#pragma unroll
      for (int nf = 4; nf < 6; ++nf) {
        const int c = (nf - 4) * 16 + fr;
        float v = acc[nf][jj] * r2 * qn[64 + c];
        float o = __shfl_xor(v, 1);
        if (lat) {
          const int n = n0 + rl, pi = c >> 1;
          float cs = ROPE[(n * 16 + pi) * 2], sn = ROPE[(n * 16 + pi) * 2 + 1];
          v = (fr & 1) ? (o * sn + v * cs) : (v * cs - o * sn);
        }
        qd[64 + c] = f2bf(v);
      }
    }
  }
  for (int hh = 0; hh < 4; ++hh) {
    f32x4 acc[8];
#pragma unroll
    for (int nf = 0; nf < 8; ++nf) acc[nf] = (f32x4){0.f, 0.f, 0.f, 0.f};
#pragma unroll
    for (int ks = 0; ks < 4; ++ks) {
      bf16x8 a = *(const bf16x8*)(AKV + (16 * w + fr) * 136 + ks * 32 + fq * 8);
#pragma unroll
      for (int nf = 0; nf < 8; ++nf) {
        bf16x8 bb = *(const bf16x8*)(WKVT + (size_t)(hh * 128 + nf * 16 + fr) * 128 + ks * 32 + fq * 8);
        acc[nf] = __builtin_amdgcn_mfma_f32_16x16x32_bf16(a, bb, acc[nf], 0, 0, 0);
      }
    }
#pragma unroll
    for (int jj = 0; jj < 4; ++jj) {
      const int rl = 16 * w + 4 * fq + jj;
      float s1 = 0.f;
#pragma unroll
      for (int nf = 0; nf < 4; ++nf) s1 += acc[nf][jj] * acc[nf][jj];
      s1 = sum16(s1);
      const float r1 = rsqrtf(s1 * (1.f / 64.f) + EPSF);
      bf16_t* kd = KB + (((size_t)(b * 4 + hh)) * NKEY + key0 + rl) * 96;
#pragma unroll
      for (int nf = 0; nf < 4; ++nf) kd[nf * 16 + fr] = f2bf(acc[nf][jj] * r1 * kn[nf * 16 + fr]);
    }
#pragma unroll
    for (int nf = 4; nf < 8; ++nf) {
      const int dd = (nf - 4) * 16 + fr;
      uint2 o;
      o.x = pack2(acc[nf][0], acc[nf][1]); o.y = pack2(acc[nf][2], acc[nf][3]);
      *(uint2*)(VB + (((size_t)(b * 4 + hh)) * 64 + dd) * NKEY + key0 + 16 * w + 4 * fq) = o;
    }
  }
}

__device__ __forceinline__ void attn_item_fast(const Params& p, int L, int item) {
  char* sm = dynsmem;
  bf16_t* KT = (bf16_t*)sm;
  bf16_t* VT = (bf16_t*)(sm + 13312);
  bf16_t* PW = (bf16_t*)(sm + 22528);
  int tx_ = threadIdx.x; asm volatile("" : "+v"(tx_));
  const int tid = tx_, w = tid >> 6, lane = tid & 63, fr = lane & 15, fq = lane >> 4;
  int b, h, rowq0, nkeys;
  if (item < 512) { int bh = item >> 3, qb = item & 7; b = bh >> 2; h = bh & 3; rowq0 = b * SEQ + qb * 256; nkeys = NKEY; }
  else { int bh = item - 512; b = bh >> 2; h = bh & 3; rowq0 = NLAT + b * CTXL; nkeys = CTXL; }
  const bf16_t* QB = (const bf16_t*)(p.ws + OFF_ACTB + QB_OFF);
  const bf16_t* KB = (const bf16_t*)(p.ws + OFF_ACTB + KB_OFF) + ((size_t)(b * 4 + h)) * NKEY * 96;
  const bf16_t* VB = (const bf16_t*)(p.ws + OFF_ACTB + VB_OFF) + ((size_t)(b * 4 + h)) * 64 * NKEY;
  bf16_t* Y = (bf16_t*)(p.ws + OFF_ACTA);
  bf16_t* PWw = PW + w * 32 * TS;
  bf16x8 qf[2][3];
#pragma unroll
  for (int m = 0; m < 2; ++m)
#pragma unroll
    for (int ks = 0; ks < 3; ++ks) qf[m][ks] = *(const bf16x8*)(QB + ((size_t)(rowq0 + w * 32 + m * 16 + fr) * 4 + h) * 96 + ks * 32 + fq * 8);
  f32x4 o[2][4];
  float mrow[2][4], lrow[2][4];
#pragma unroll
  for (int m = 0; m < 2; ++m)
#pragma unroll
    for (int j = 0; j < 4; ++j) { mrow[m][j] = -1e30f; lrow[m][j] = 0.f; o[m][j] = (f32x4){0.f, 0.f, 0.f, 0.f}; }
  uint4 pk0, pk1, pv0;
  const int kr0 = tid / 12, kp0 = tid % 12, kr1 = (tid + 512) / 12, kp1 = (tid + 512) % 12;
  const int vd0 = tid >> 3, vp0 = tid & 7;
#define ATT_LOAD(K0)                                                                 \
  {                                                                                  \
    pk0 = *(const uint4*)(KB + (size_t)((K0) + kr0) * 96 + kp0 * 8);                 \
    if (tid < 256) pk1 = *(const uint4*)(KB + (size_t)((K0) + kr1) * 96 + kp1 * 8);  \
    pv0 = *(const uint4*)(VB + (size_t)vd0 * NKEY + (K0) + vp0 * 8);                 \
  }
  pk1 = make_uint4(0u, 0u, 0u, 0u);
  ATT_LOAD(0);
  const int ntiles = nkeys >> 6;
  for (int t = 0; t < ntiles; ++t) {
    __syncthreads();
    *(uint4*)(KT + kr0 * 104 + kp0 * 8) = pk0;
    if (tid < 256) *(uint4*)(KT + kr1 * 104 + kp1 * 8) = pk1;
    *(uint4*)(VT + vd0 * TS + vp0 * 8) = pv0;
    __syncthreads();
    if (t + 1 < ntiles) ATT_LOAD((t + 1) * 64);
    f32x4 sacc[2][4];
#pragma unroll
    for (int m = 0; m < 2; ++m)
#pragma unroll
      for (int nf = 0; nf < 4; ++nf) sacc[m][nf] = (f32x4){0.f, 0.f, 0.f, 0.f};
#pragma unroll
    for (int ks = 0; ks < 3; ++ks)
#pragma unroll
      for (int nf = 0; nf < 4; ++nf) {
        bf16x8 kb = *(const bf16x8*)(KT + (nf * 16 + fr) * 104 + ks * 32 + fq * 8);
#pragma unroll
        for (int m = 0; m < 2; ++m) sacc[m][nf] = __builtin_amdgcn_mfma_f32_16x16x32_bf16(qf[m][ks], kb, sacc[m][nf], 0, 0, 0);
      }
#pragma unroll
    for (int m = 0; m < 2; ++m)
#pragma unroll
      for (int j = 0; j < 4; ++j) {
        float mx = fmaxf(fmaxf(sacc[m][0][j], sacc[m][1][j]), fmaxf(sacc[m][2][j], sacc[m][3][j]));
        mx = fmaxf(mx, __shfl_xor(mx, 1)); mx = fmaxf(mx, __shfl_xor(mx, 2)); mx = fmaxf(mx, __shfl_xor(mx, 4)); mx = fmaxf(mx, __shfl_xor(mx, 8));
        const float mn = fmaxf(mrow[m][j], mx);
        const float al = __expf(mrow[m][j] - mn);
        mrow[m][j] = mn;
        float ps = 0.f;
#pragma unroll
        for (int nf = 0; nf < 4; ++nf) {
          float pe = __expf(sacc[m][nf][j] - mn);
          ps += pe;
          PWw[(m * 16 + 4 * fq + j) * TS + nf * 16 + fr] = f2bf(pe);
          o[m][nf][j] *= al;
        }
        lrow[m][j] = lrow[m][j] * al + ps;
      }
    CFENCE();
#pragma unroll
    for (int ks = 0; ks < 2; ++ks) {
      bf16x8 pa[2];
#pragma unroll
      for (int m = 0; m < 2; ++m) pa[m] = *(const bf16x8*)(PWw + (m * 16 + fr) * TS + ks * 32 + fq * 8);
#pragma unroll
      for (int nf = 0; nf < 4; ++nf) {
        bf16x8 vb = *(const bf16x8*)(VT + (nf * 16 + fr) * TS + ks * 32 + fq * 8);
#pragma unroll
        for (int m = 0; m < 2; ++m) o[m][nf] = __builtin_amdgcn_mfma_f32_16x16x32_bf16(pa[m], vb, o[m][nf], 0, 0, 0);
      }
    }
    CFENCE();
  }
#undef ATT_LOAD
#pragma unroll
  for (int m = 0; m < 2; ++m)
#pragma unroll
    for (int j = 0; j < 4; ++j) {
      float l = sum16(lrow[m][j]);
      const float il = 1.f / l;
      bf16_t* yd = Y + (size_t)(rowq0 + w * 32 + m * 16 + 4 * fq + j) * DM + 768 + h * 64;
#pragma unroll
      for (int nf = 0; nf < 4; ++nf) yd[nf * 16 + fr] = f2bf(o[m][nf][j] * il);
    }
}

__device__ __forceinline__ void phase_mix(const Params& p, int L, int bid, int nb) {
  volatile int* s_itemp = (volatile int*)(dynsmem + 2 * GROUP_LDS);
  int* cnt = (int*)(p.ws + OFF_CNT) + L;
  const int nattn = (L == 0) ? 576 : 512;
  const int total = 192 + nattn;
  for (;;) {
    __syncthreads();
    if (threadIdx.x == 0) *s_itemp = atomicAdd(cnt, 1);
    __syncthreads();
    const int it = *s_itemp;
    if (it >= total) break;
    if (it < 64) chain_hgrn_fast(p, L, it);
    else if (it < 128) chain_ssd_fast(p, L, it - 64);
    else if (it < 192) chain_lru_fast(p, L, it - 128);
    else attn_item_fast(p, L, it - 192);
  }
}

__device__ __forceinline__ void phase_ssdnorm(const Params& p, int L, int bid, int nb) {
  const int wave = threadIdx.x >> 6, lane = threadIdx.x & 63;
  bf16_t* Y = (bf16_t*)(p.ws + OFF_ACTA);
  const float* nw = p.in[I_SNW] + L * 256;
  const int nrows = (L == 0) ? NTOK : NLAT;
  for (int row = bid * 8 + wave; row < nrows; row += nb * 8) {
    uint2* yp = (uint2*)(Y + (size_t)row * DM + 512) + lane;
    uint2 v = *yp;
    float a0 = __uint_as_float(v.x << 16), a1 = __uint_as_float(v.x & 0xffff0000u), a2 = __uint_as_float(v.y << 16), a3 = __uint_as_float(v.y & 0xffff0000u);
    float ss = wave_sum(a0 * a0 + a1 * a1 + a2 * a2 + a3 * a3);
    float rn = rsqrtf(ss * (1.f / 256.f) + EPSF);
    float4 w = ((const float4*)nw)[lane];
    uint2 o;
    o.x = pack2(a0 * rn * w.x, a1 * rn * w.y);
    o.y = pack2(a2 * rn * w.z, a3 * rn * w.w);
    *yp = o;
  }
}

__device__ __forceinline__ void phase_topk(const Params& p, int L, int bid, int nb) {
  float* a = (float*)dynsmem;
  const int tid = threadIdx.x;
  const float* aff = (const float*)(p.ws + OFF_AFF);
  int* ROWL = (int*)(p.ws + OFF_ROWL);
  int* SEL = (int*)(p.ws + OFF_SEL);
  float* GSEL = (float*)(p.ws + OFF_GSEL);
  const int nitems = (L == 0) ? 512 : 256;
  for (int it = bid; it < nitems; it += nb) {
    const bool lat = it < 256;
    const int be = lat ? it : it - 256;
    const int b = be >> 4, e = be & 15;
    const int n = lat ? SEQ : CTXL, cap = lat ? CAPL : CAPC;
    const float* src = lat ? aff + (size_t)be * SEQ : aff + (size_t)NB * NEXP * SEQ + (size_t)be * CTXL;
    __syncthreads();
    for (int i = tid; i < n; i += NT) a[i] = src[i];
    __syncthreads();
    float av[4]; int rk[4];
#pragma unroll
    for (int q = 0; q < 4; ++q) { int i = q * NT + tid; av[q] = i < n ? a[i] : 0.f; rk[q] = 0; }
    for (int j = 0; j < n; ++j) {
      float aj = a[j];
#pragma unroll
      for (int q = 0; q < 4; ++q) {
        int i = q * NT + tid;
        rk[q] += (aj > av[q] || (aj == av[q] && j < i)) ? 1 : 0;
      }
    }
#pragma unroll
    for (int q = 0; q < 4; ++q) {
      int i = q * NT + tid;
      if (i < n) {
        const int row = lat ? (b * SEQ + i) : (NLAT + b * CTXL + i);
        int slot = -1;
        if (rk[q] < cap) {
          slot = lat ? (e * SLOTS + b * CAPL + rk[q]) : (e * SLOTS + SLOTS_L + b * CAPC + rk[q]);
          ROWL[slot] = row;
        }
        SEL[(size_t)row * 16 + e] = slot;
        GSEL[(size_t)row * 16 + e] = av[q];
      }
    }
  }
}

enum { PH_PREP = 0, PH_NORM1, PH_INPROJ, PH_MLAPROJ, PH_MIX, PH_SSDNORM, PH_OUTPROJ, PH_NORM2, PH_TOPK, PH_MOE1, PH_MOE2, PH_FINAL };

__device__ __forceinline__ void run_phase(const Params& p, int ph, int L, int bid, int nb) {
  switch (ph) {
    case PH_PREP: phase_prep(p, bid, nb); break;
    case PH_NORM1: phase_norm(p, L, 0, L == 0 ? 0 : 1, L == 0 ? -1 : 0, NTOK, bid, nb); break;
    case PH_INPROJ: phase_inproj(p, L, bid, nb); break;
    case PH_MLAPROJ: for (int it = bid; it < NTOK / 128; it += nb) mlaproj_item_fast(p, L, it); break;
    case PH_MIX: phase_mix(p, L, bid, nb); break;
    case PH_SSDNORM: phase_ssdnorm(p, L, bid, nb); break;
    case PH_OUTPROJ: phase_outproj(p, L, bid, nb); break;
    case PH_NORM2: phase_norm(p, L, 1, 1, -1, L == 0 ? NTOK : NLAT, bid, nb); break;
    case PH_TOPK: phase_topk(p, L, bid, nb); break;
    case PH_MOE1: phase_moe1(p, L, bid, nb); break;
    case PH_MOE2: phase_moe2(p, L, bid, nb); break;
    case PH_FINAL: phase_norm(p, 1, 2, 1, 1, NLAT, bid, nb); break;
  }
}

#if !MEGA
template <int PH>
__global__ void __launch_bounds__(NT, 2) k_phase(Params p, int L) {
  run_phase(p, PH, L, blockIdx.x, gridDim.x);
}
#else
__global__ void __launch_bounds__(NT, 2) k_mega(Params p) {
  cg::grid_group grid = cg::this_grid();
  const int bid = blockIdx.x, nb = gridDim.x;
  phase_prep(p, bid, nb);
  grid.sync();
#define RP(PH, L) run_phase(p, PH, L, bid, nb); grid.sync();
  RP(PH_NORM1, 0) RP(PH_INPROJ, 0) RP(PH_MLAPROJ, 0) RP(PH_MIX, 0) RP(PH_SSDNORM, 0) RP(PH_OUTPROJ, 0) RP(PH_NORM2, 0) RP(PH_TOPK, 0) RP(PH_MOE1, 0) RP(PH_MOE2, 0)
  RP(PH_NORM1, 1) RP(PH_INPROJ, 1) RP(PH_MLAPROJ, 1) RP(PH_MIX, 1) RP(PH_SSDNORM, 1) RP(PH_OUTPROJ, 1) RP(PH_NORM2, 1) RP(PH_TOPK, 1) RP(PH_MOE1, 1) RP(PH_MOE2, 1)
  run_phase(p, PH_FINAL, 1, bid, nb);
}
#endif

extern "C" void kernel_launch(void* const* d_in, const int* in_sizes, int n_in, void* d_out, int out_size, void* d_ws, size_t ws_size, hipStream_t stream) {
  Params p{};
  for (int i = 0; i < N_IN; ++i) p.in[i] = (const float*)d_in[i];
  p.out = (float*)d_out;
  p.ws = (char*)d_ws;
  if (n_in != N_IN || ws_size < WS_END) { fprintf(stderr, "kernel_launch: bad args n_in=%d ws=%zu need %zu\n", n_in, ws_size, (size_t)WS_END); return; }
#if MEGA
  static int grid = 0;
  if (!grid) {
    int dev = 0, cus = 0, per_cu = 0;
    (void)hipGetDevice(&dev);
    (void)hipDeviceGetAttribute(&cus, hipDeviceAttributeMultiprocessorCount, dev);
    (void)hipFuncSetAttribute((const void*)k_mega, hipFuncAttributeMaxDynamicSharedMemorySize, DYN_LDS);
    (void)hipOccupancyMaxActiveBlocksPerMultiprocessor(&per_cu, (const void*)k_mega, NT, DYN_LDS);
    if (per_cu > 1) per_cu = 1;
    if (per_cu < 1) per_cu = 1;
    grid = cus * per_cu;
  }
  void* args[] = {&p};
  hipError_t e = hipLaunchCooperativeKernel((const void*)k_mega, dim3(grid), dim3(NT), args, DYN_LDS, stream);
  if (e != hipSuccess) fprintf(stderr, "cooperative launch failed: %s (grid %d)\n", hipGetErrorString(e), grid);
#else
  const int G = 256;
  static bool attr = false;
#define SETATTR(PH) (void)hipFuncSetAttribute((const void*)k_phase<PH>, hipFuncAttributeMaxDynamicSharedMemorySize, DYN_LDS)
  if (!attr) { SETATTR(PH_PREP); SETATTR(PH_NORM1); SETATTR(PH_INPROJ); SETATTR(PH_MLAPROJ); SETATTR(PH_MIX); SETATTR(PH_SSDNORM); SETATTR(PH_OUTPROJ);
               SETATTR(PH_NORM2); SETATTR(PH_TOPK); SETATTR(PH_MOE1); SETATTR(PH_MOE2); SETATTR(PH_FINAL); attr = true; }
#define LAUNCH(PH, L) k_phase<PH><<<G, NT, DYN_LDS, stream>>>(p, L)
  LAUNCH(PH_PREP, 0);
  for (int L = 0; L < 2; ++L) {
    LAUNCH(PH_NORM1, L); LAUNCH(PH_INPROJ, L); LAUNCH(PH_MLAPROJ, L); LAUNCH(PH_MIX, L); LAUNCH(PH_SSDNORM, L);
    LAUNCH(PH_OUTPROJ, L); LAUNCH(PH_NORM2, L); LAUNCH(PH_TOPK, L); LAUNCH(PH_MOE1, L); LAUNCH(PH_MOE2, L);
  }
  LAUNCH(PH_FINAL, 1);
#endif
}
```

```cpp
#include <hip/hip_runtime.h>
#include <hip/hip_cooperative_groups.h>
#include <cstdio>
#include <cstdint>
namespace cg = cooperative_groups;

#ifndef MEGA
#define MEGA 1
#endif
#ifndef DIAG
#define DIAG 0
#define PROBE_ATT 0
#endif
#ifndef DIAG_MASK_A
#define DIAG_MASK_A 0
#endif
#ifndef DIAG_MASK_B
#define DIAG_MASK_B 0
#endif

typedef unsigned short bf16_t;
typedef short bf16x8 __attribute__((ext_vector_type(8)));
typedef float f32x4 __attribute__((ext_vector_type(4)));

#define NT 512
#define NB 16
#define SEQ 2048
#define CTXL 256
#define DM 1024
#define NLAT (NB * SEQ)
#define NCTX (NB * CTXL)
#define NTOK (NLAT + NCTX)
#define INC 2920
#define INP 3072
#define NEXP 16
#define FF 512
#define CAPL 256
#define CAPC 32
#define SLOTS_L (NB * CAPL)
#define SLOTS_C (NB * CAPC)
#define SLOTS (SLOTS_L + SLOTS_C)
#define NKEY (CTXL + SEQ)
#define EPSF 1e-6f

enum { I_X = 0, I_C, I_CTX, I_CCTX, I_ADAW, I_ADAB, I_N1W, I_N2W, I_WIN, I_WOUT, I_LCW, I_LCB, I_LWR, I_LBR, I_LWI, I_LBI, I_LLAM,
       I_HLB, I_HNW, I_SCW, I_SCB, I_SALOG, I_SDTB, I_SDSK, I_SNW, I_MQAN, I_MWQ, I_MKVAN, I_MWKV, I_MQN, I_MKN, I_ROUT, I_WG, I_WU, I_WD, N_IN };

struct Params {
  const float* in[N_IN];
  float* out;
  char* ws;
};

constexpr size_t OFF_MOD = 0;
constexpr size_t SZ_MOD = (size_t)2 * 17 * 6144 * 4;
constexpr size_t OFF_WINT = OFF_MOD + SZ_MOD;
constexpr size_t SZ_WINT = (size_t)2 * INP * DM * 2;
constexpr size_t OFF_WOUTT = OFF_WINT + SZ_WINT;
constexpr size_t SZ_WOUTT = (size_t)2 * DM * DM * 2;
constexpr size_t OFF_WGU = OFF_WOUTT + SZ_WOUTT;
constexpr size_t SZ_WGU = (size_t)2 * NEXP * 1024 * DM * 2;
constexpr size_t OFF_WDT = OFF_WGU + SZ_WGU;
constexpr size_t SZ_WDT = (size_t)2 * NEXP * DM * FF * 2;
constexpr size_t OFF_CTXS = OFF_WDT + SZ_WDT;
constexpr size_t SZ_CTXS = (size_t)NCTX * DM * 4;
constexpr size_t OFF_ACTA = OFF_CTXS + SZ_CTXS;
constexpr size_t SZ_ACT = (size_t)NTOK * DM * 2;
constexpr size_t OFF_ACTB = OFF_ACTA + SZ_ACT;
constexpr size_t OFF_U = OFF_ACTB + SZ_ACT;
constexpr size_t SZ_U = (size_t)NTOK * INP * 2;
constexpr size_t OFF_AFF = OFF_U + SZ_U;
constexpr size_t SZ_AFF = (size_t)(NB * NEXP * SEQ + NB * NEXP * CTXL) * 4;
constexpr size_t OFF_ROWL = OFF_AFF + SZ_AFF;
constexpr size_t SZ_ROWL = (size_t)NEXP * SLOTS * 4;
constexpr size_t OFF_SEL = OFF_ROWL + SZ_ROWL;
constexpr size_t SZ_SEL = (size_t)NTOK * 16 * 4;
constexpr size_t OFF_GSEL = OFF_SEL + SZ_SEL;
constexpr size_t OFF_WQT = OFF_GSEL + SZ_SEL;
constexpr size_t SZ_WQT = (size_t)2 * 384 * 192 * 2;
constexpr size_t OFF_WKVT = OFF_WQT + SZ_WQT;
constexpr size_t SZ_WKVT = (size_t)2 * 512 * 128 * 2;
constexpr size_t OFF_LRUW = OFF_WKVT + SZ_WKVT;
constexpr size_t SZ_LRUW = (size_t)2 * 2 * 2 * 4 * 4096 * 2;
constexpr size_t OFF_ROPE = OFF_LRUW + SZ_LRUW;
constexpr size_t SZ_ROPE = (size_t)SEQ * 16 * 2 * 4;
constexpr size_t OFF_CNT = OFF_ROPE + SZ_ROPE;
constexpr size_t OFF_TS = OFF_CNT + 256;
constexpr size_t OFF_PSSQ = OFF_TS + 512;
constexpr size_t SZ_PSSQ = (size_t)NTOK * 4 * 4;
constexpr size_t OFF_BAR = OFF_PSSQ + SZ_PSSQ;
constexpr size_t SZ_BAR = 3456 * 4;
constexpr size_t WS_END = OFF_BAR + SZ_BAR;

constexpr size_t QB_OFF = 0;
constexpr size_t KB_OFF = (size_t)NTOK * 384 * 2;
constexpr size_t VB_OFF = KB_OFF + (size_t)NB * 4 * NKEY * 96 * 2;

extern __shared__ __attribute__((aligned(16))) char dynsmem[];
#define GROUP_LDS 77824
#define DYN_LDS (2 * GROUP_LDS + 256)
#define XB_LDS_OFF (2 * GROUP_LDS + 64)
#define TS 72

__device__ __forceinline__ bf16_t f2bf(float f) {
  unsigned u = __float_as_uint(f);
  u += 0x7fffu + ((u >> 16) & 1u);
  return (bf16_t)(u >> 16);
}
__device__ __forceinline__ float bf2f(bf16_t h) { return __uint_as_float(((unsigned)h) << 16); }
__device__ __forceinline__ unsigned pack2(float a, float b) { unsigned r; asm("v_cvt_pk_bf16_f32 %0, %1, %2" : "=v"(r) : "v"(a), "v"(b)); return r; }
__device__ __forceinline__ float fexp(float x) { return __builtin_amdgcn_exp2f(x * 1.4426950408889634f); }
__device__ __forceinline__ float fexp2(float x) { return __builtin_amdgcn_exp2f(x); }
__device__ __forceinline__ float flog(float x) { return __builtin_amdgcn_logf(x) * 0.6931471805599453f; }
__device__ __forceinline__ float frcp(float x) { return __builtin_amdgcn_rcpf(x); }
__device__ __forceinline__ float sigmoidf_(float x) { return frcp(1.f + fexp(-x)); }
__device__ __forceinline__ float siluf_(float x) { return x * frcp(1.f + fexp(-x)); }
__device__ __forceinline__ float softplusf_(float x) { return x > 20.f ? x : log1pf(expf(x)); }
__device__ __forceinline__ float gelu_tanh(float x) {
  float u = 0.7978845608028654f * (x + 0.044715f * x * x * x);
  float t = 1.f - 2.f * frcp(1.f + fexp(2.f * u));
  return 0.5f * x * (1.f + t);
}
__device__ __forceinline__ float one_minus_exp(float x) {
  return (x > -1e-3f) ? -x * (1.f + 0.5f * x) : 1.f - fexp(x);
}
template <int CTRL>
__device__ __forceinline__ float dppf(float v) { return __int_as_float(__builtin_amdgcn_mov_dpp(__float_as_int(v), CTRL, 0xf, 0xf, true)); }
typedef float f32x2 __attribute__((ext_vector_type(2)));
__device__ __forceinline__ float sum16(float v) {
  v += dppf<0xB1>(v); v += dppf<0x4E>(v); v += dppf<0x141>(v); v += dppf<0x140>(v);
  return v;
}
__device__ __forceinline__ float wave_sum(float v) {
  v = sum16(v);
  v += __shfl_xor(v, 16); v += __shfl_xor(v, 32);
  return v;
}
__device__ __forceinline__ float max16(float v) {
  v = fmaxf(v, dppf<0xB1>(v)); v = fmaxf(v, dppf<0x4E>(v)); v = fmaxf(v, dppf<0x141>(v)); v = fmaxf(v, dppf<0x140>(v));
  return v;
}
constexpr size_t OFF_S3 = OFF_U + (size_t)(2 * NTOK) * DM * 2;
__device__ __forceinline__ const float* xrow_src(const Params& p, int srcmode, int row) {
  return row < NLAT ? p.in[I_X] + (size_t)row * DM : p.in[I_CTX] + (size_t)(row - NLAT) * DM;
}
__device__ __forceinline__ bf16_t* srow(const Params& p, int srcmode, int row) {
  if (srcmode == 2) return (bf16_t*)(p.ws + OFF_S3) + (size_t)row * DM;
  return row < NLAT ? (bf16_t*)p.out + (size_t)row * DM : (bf16_t*)(p.ws + OFF_CTXS) + (size_t)(row - NLAT) * DM;
}
__device__ __forceinline__ float4 up4(uint2 u) {
  return make_float4(__uint_as_float(u.x << 16), __uint_as_float(u.x & 0xffff0000u), __uint_as_float(u.y << 16), __uint_as_float(u.y & 0xffff0000u));
}
__device__ __forceinline__ int modrow(int row) { return row < NLAT ? (row >> 11) : 16; }
__device__ __forceinline__ const float* modptr(const Params& p, int layer, int mrow, int chunk) {
  return (const float*)(p.ws + OFF_MOD) + ((size_t)(layer * 17 + mrow) * 6144 + chunk * 1024);
}
__device__ __forceinline__ float unpk(const uint4* v, int e) {
  const unsigned* w = (const unsigned*)v;
  unsigned x = w[e >> 1];
  return (e & 1) ? __uint_as_float(x & 0xffff0000u) : __uint_as_float(x << 16);
}
__device__ __forceinline__ bf16_t unpk_raw(const uint4* v, int e) {
  const unsigned* w = (const unsigned*)v;
  unsigned x = w[e >> 1];
  return (bf16_t)((e & 1) ? (x >> 16) : (x & 0xffffu));
}
#define CFENCE() asm volatile("" ::: "memory")
__device__ __forceinline__ unsigned xb_ld(unsigned* p)              { return __hip_atomic_load(p, __ATOMIC_RELAXED, __HIP_MEMORY_SCOPE_AGENT); }
__device__ __forceinline__ unsigned xb_add(unsigned* p, unsigned v) { return __hip_atomic_fetch_add(p, v, __ATOMIC_RELAXED, __HIP_MEMORY_SCOPE_AGENT); }
__device__ __forceinline__ int otid() { int t = threadIdx.x; asm volatile("" : "+v"(t)); return t; }

__device__ __forceinline__ void transpose_tile(const float* __restrict__ src, int N, int k0, int n0, bf16_t* __restrict__ dst, int K, int mode, const float* __restrict__ kscale = nullptr) {
  float* tile = (float*)dynsmem;
  const int tid = otid();
#pragma unroll
  for (int i = 0; i < 2; ++i) {
    int idx = i * NT + tid;
    int r = idx >> 4, c4 = (idx & 15) * 4;
    int n = n0 + c4;
    float4 v = (n < N) ? *(const float4*)(src + (size_t)(k0 + r) * N + n) : make_float4(0.f, 0.f, 0.f, 0.f);
    if (kscale) { const float sc = kscale[k0 + r]; v.x *= sc; v.y *= sc; v.z *= sc; v.w *= sc; }
    tile[r * 65 + c4] = v.x; tile[r * 65 + c4 + 1] = v.y; tile[r * 65 + c4 + 2] = v.z; tile[r * 65 + c4 + 3] = v.w;
  }
  __syncthreads();
  {
    const int nl = tid >> 3, kc = (tid & 7) * 8;
    const int n = n0 + nl;
    const int nr = (mode == 0) ? n : (mode == 3 ? ((n & ~31) + (((n >> 2) & 1) << 4) + (((n >> 3) & 3) << 2) + (n & 3))
                                                 : ((n >> 4) * 32 + (mode == 2 ? 16 : 0) + (n & 15)));
    uint4 o;
    o.x = pack2(tile[(kc + 0) * 65 + nl], tile[(kc + 1) * 65 + nl]);
    o.y = pack2(tile[(kc + 2) * 65 + nl], tile[(kc + 3) * 65 + nl]);
    o.z = pack2(tile[(kc + 4) * 65 + nl], tile[(kc + 5) * 65 + nl]);
    o.w = pack2(tile[(kc + 6) * 65 + nl], tile[(kc + 7) * 65 + nl]);
    *(uint4*)(dst + (size_t)nr * K + k0 + kc) = o;
  }
  __syncthreads();
}

__device__ __forceinline__ void mod_item(const Params& p, int j) {
  float* s = (float*)dynsmem;
  float* red = s + 17 * 256;
  const int tid = otid();
  const int l = j / 96, cb = (j % 96) * 64;
  const int kg = tid >> 6, col = tid & 63;
  const float* cc = p.in[I_C];
  const float* cctx = p.in[I_CCTX];
  const float* aw = p.in[I_ADAW] + (size_t)l * DM * 6144;
  float acc[17];
#pragma unroll
  for (int r = 0; r < 17; ++r) acc[r] = 0.f;
  for (int kc = 0; kc < 4; ++kc) {
    float wv[32];
#pragma unroll
    for (int kk = 0; kk < 32; ++kk) wv[kk] = aw[(size_t)(kc * 256 + kg * 32 + kk) * 6144 + cb + col];
    __syncthreads();
    for (int idx = tid; idx < 17 * 256; idx += NT) {
      int r = idx >> 8, kk = idx & 255;
      int k = kc * 256 + kk;
      float v = (r < 16) ? cc[r * DM + k] : cctx[k];
      s[idx] = siluf_(v);
    }
    __syncthreads();
#pragma unroll 4
    for (int kk = 0; kk < 32; ++kk) {
      int kl = kg * 32 + kk;
      float w = wv[kk];
#pragma unroll
      for (int r = 0; r < 17; ++r) acc[r] += s[r * 256 + kl] * w;
    }
  }
#pragma unroll
  for (int r = 0; r < 17; ++r) red[(kg * 17 + r) * 64 + col] = acc[r];
  __syncthreads();
  float* mod = (float*)(p.ws + OFF_MOD);
  for (int idx = tid; idx < 17 * 64; idx += NT) {
    int r = idx >> 6, c2 = idx & 63;
    float v = 0.f;
#pragma unroll
    for (int g = 0; g < 8; ++g) v += red[(g * 17 + r) * 64 + c2];
    v += p.in[I_ADAB][l * 6144 + cb + c2];
    mod[(size_t)(l * 17 + r) * 6144 + cb + c2] = v;
  }
  __syncthreads();
}

__device__ __forceinline__ void phase_prep_a(const Params& p, int bid, int nb) {
  if (bid == 0 && threadIdx.x < 64) ((int*)(p.ws + OFF_CNT))[threadIdx.x] = 0;
#if DIAG
  if (bid == 0 && threadIdx.x < 8) ((unsigned long long*)(p.ws + OFF_TS))[24 + threadIdx.x] = 0ull;
#endif
  for (int it = bid; it < 192 + 64; it += nb) {
    if (it < 192) { mod_item(p, it); continue; }
    {
      int idx = (it - 192) * NT + threadIdx.x;
      int n = idx >> 4, i = idx & 15;
      float inv = powf(10000.f, -(float)(i & 7) / 8.f);
      float pos = (i < 8) ? (float)(n >> 6) : (float)(n & 63);
      float ang = pos * inv;
      float* rt = (float*)(p.ws + OFF_ROPE);
      rt[idx * 2] = cosf(ang); rt[idx * 2 + 1] = sinf(ang);
    }
  }
}
__device__ __forceinline__ void phase_prep_b(const Params& p, int bid, int nb) {
  constexpr int T_WIN = 16 * 48;
  constexpr int T_PER_LAYER = T_WIN + 256 + 16 * 384 + 18 + 16 + 16;
  constexpr int NTL = 2 * T_PER_LAYER;
  for (int it = bid + 256; it < 256 + NTL; it += nb) {
    int tt = it - 256;
    int l = tt / T_PER_LAYER, r = tt % T_PER_LAYER;
    if (r < T_WIN) {
      int tk = r / 48, tn = r % 48;
      transpose_tile(p.in[I_WIN] + (size_t)l * DM * INC, INC, tk * 64, tn * 64, (bf16_t*)(p.ws + OFF_WINT) + (size_t)l * INP * DM, DM, 3);
    } else if (r < T_WIN + 256) {
      r -= T_WIN;
      int tk = r / 16, tn = r % 16;
      transpose_tile(p.in[I_WOUT] + (size_t)l * DM * DM, DM, tk * 64, tn * 64, (bf16_t*)(p.ws + OFF_WOUTT) + (size_t)l * DM * DM, DM, 3,
                     (tk >= 8 && tk < 12) ? (p.in[I_SNW] + l * 256 - 512) : nullptr);
    } else if (r >= T_WIN + 256 + 16 * 384) {
      r -= T_WIN + 256 + 16 * 384;
      if (r < 18) {
        int tk = r / 6, tn = r % 6;
        transpose_tile(p.in[I_MWQ] + (size_t)l * 192 * 384, 384, tk * 64, tn * 64, (bf16_t*)(p.ws + OFF_WQT) + (size_t)l * 384 * 192, 192, 0);
      } else if (r < 34) {
        r -= 18;
        int tk = r / 8, tn = r % 8;
        transpose_tile(p.in[I_MWKV] + (size_t)l * 128 * 512, 512, tk * 64, tn * 64, (bf16_t*)(p.ws + OFF_WKVT) + (size_t)l * 512 * 128, 128, 0);
      } else {
        r -= 34;
        int d = r >> 3, gate = (r >> 2) & 1, h = r & 3;
        const float* src = (gate == 0 ? p.in[I_LWR] : p.in[I_LWI]) + (size_t)((l * 2 + d) * 4 + h) * 4096;
        transpose_tile(src, 64, 0, 0, (bf16_t*)(p.ws + OFF_LRUW) + (size_t)(((l * 2 + d) * 2 + gate) * 4 + h) * 4096, 64, 0);
      }
    } else {
      r -= T_WIN + 256;
      int e = r / 384, rr = r % 384, sub = rr / 128, t = rr % 128;
      size_t le = (size_t)(l * NEXP + e);
      if (sub < 2) {
        int tk = t / 8, tn = t % 8;
        const float* src = (sub == 0 ? p.in[I_WG] : p.in[I_WU]) + le * DM * FF;
        transpose_tile(src, FF, tk * 64, tn * 64, (bf16_t*)(p.ws + OFF_WGU) + le * 1024 * DM, DM, sub == 0 ? 1 : 2);
      } else {
        int tk = t / 16, tn = t % 16;
        transpose_tile(p.in[I_WD] + le * FF * DM, DM, tk * 64, tn * 64, (bf16_t*)(p.ws + OFF_WDT) + le * DM * FF, FF, 3);
      }
    }
  }
}

__device__ __forceinline__ void phase_norm1x2(const Params& p, int layer, int which, int srcmode, int comb, int nrows, int bid, int nb) {
  const int tx0_ = otid();
  const int wave = tx0_ >> 6, lane = tx0_ & 63;
  const float* nw = p.in[I_N1W] + layer * DM;
  bf16_t* dstb = (bf16_t*)(p.ws + OFF_ACTA);
  const int* SEL = (const int*)(p.ws + OFF_SEL);
  const float* GSEL = (const float*)(p.ws + OFF_GSEL);
  const bf16_t* YS = (const bf16_t*)(p.ws + OFF_U);
  int R = (nrows + nb * 8 - 1) / (nb * 8);
  R += R & 1;
  const int row_lo = (bid * 8 + wave) * R;
  const int row_hi = (row_lo + R < nrows) ? row_lo + R : nrows;
  if (row_lo >= nrows) return;
  int cur_mr = -1;
  float4 mw[4], msh[4], msc[4], mg5[4];
  if (which != 2) {
#pragma unroll
    for (int j = 0; j < 4; ++j) mw[j] = ((const float4*)nw)[j * 64 + lane];
  }
  float4 nva[4], nvb[4];
  uint2 nua[4], nub[4];
  int nsa = -1, nsb = -1; float nga = 0.f, ngb = 0.f;
  {
    if (srcmode == 0) {
      const float4* sa = (const float4*)xrow_src(p, srcmode, row_lo);
      const float4* sb = (const float4*)xrow_src(p, srcmode, row_lo + 1);
#pragma unroll
      for (int j = 0; j < 4; ++j) { nva[j] = sa[j * 64 + lane]; nvb[j] = sb[j * 64 + lane]; }
    } else {
      const uint2* sa = (const uint2*)srow(p, srcmode, row_lo);
      const uint2* sb = (const uint2*)srow(p, srcmode, row_lo + 1);
#pragma unroll
      for (int j = 0; j < 4; ++j) { nua[j] = sa[j * 64 + lane]; nub[j] = sb[j * 64 + lane]; }
    }
    if (comb >= 0 && lane < 16) {
      nsa = SEL[(size_t)row_lo * 16 + lane]; nga = GSEL[(size_t)row_lo * 16 + lane];
      nsb = SEL[(size_t)(row_lo + 1) * 16 + lane]; ngb = GSEL[(size_t)(row_lo + 1) * 16 + lane];
    }
  }
  for (int row = row_lo; row < row_hi; row += 2) {
    const int mr = modrow(row);
    if (mr != cur_mr) {
      cur_mr = mr;
      if (which != 2) {
        const float4* sh = (const float4*)modptr(p, layer, mr, 0);
        const float4* sc = (const float4*)modptr(p, layer, mr, 1);
#pragma unroll
        for (int j = 0; j < 4; ++j) { msh[j] = sh[j * 64 + lane]; msc[j] = sc[j * 64 + lane]; }
      }
      if (comb >= 0) {
        const float4* g5 = (const float4*)modptr(p, comb, mr, 5);
#pragma unroll
        for (int j = 0; j < 4; ++j) mg5[j] = g5[j * 64 + lane];
      }
    }
    float4 va[4], vb[4];
#pragma unroll
    for (int j = 0; j < 4; ++j) { va[j] = srcmode == 0 ? nva[j] : up4(nua[j]); vb[j] = srcmode == 0 ? nvb[j] : up4(nub[j]); }
    const int sla = nsa, slb = nsb; const float gla = nga, glb = ngb;
    if (row + 2 < row_hi) {
      if (srcmode == 0) {
        const float4* sa = (const float4*)xrow_src(p, srcmode, row + 2);
        const float4* sb = (const float4*)xrow_src(p, srcmode, row + 3);
#pragma unroll
        for (int j = 0; j < 4; ++j) { nva[j] = sa[j * 64 + lane]; nvb[j] = sb[j * 64 + lane]; }
      } else {
        const uint2* sa = (const uint2*)srow(p, srcmode, row + 2);
        const uint2* sb = (const uint2*)srow(p, srcmode, row + 3);
#pragma unroll
        for (int j = 0; j < 4; ++j) { nua[j] = sa[j * 64 + lane]; nub[j] = sb[j * 64 + lane]; }
      }
      if (comb >= 0 && lane < 16) {
        nsa = SEL[(size_t)(row + 2) * 16 + lane]; nga = GSEL[(size_t)(row + 2) * 16 + lane];
        nsb = SEL[(size_t)(row + 3) * 16 + lane]; ngb = GSEL[(size_t)(row + 3) * 16 + lane];
      }
    }
    if (comb >= 0) {
      float4 aa[4], ab[4];
#pragma unroll
      for (int j = 0; j < 4; ++j) { aa[j] = make_float4(0.f, 0.f, 0.f, 0.f); ab[j] = make_float4(0.f, 0.f, 0.f, 0.f); }
      unsigned long long ma = __ballot(sla >= 0), mb = __ballot(slb >= 0);
      while (ma | mb) {
        int ea0 = -1, ea1 = -1, eb0 = -1, eb1 = -1;
        if (ma) { ea0 = __builtin_ctzll(ma); ma &= ma - 1; }
        if (ma) { ea1 = __builtin_ctzll(ma); ma &= ma - 1; }
        if (mb) { eb0 = __builtin_ctzll(mb); mb &= mb - 1; }
        if (mb) { eb1 = __builtin_ctzll(mb); mb &= mb - 1; }
        uint2 ya0[4], ya1[4], yb0[4], yb1[4];
        float ga0 = 0.f, ga1 = 0.f, gb0 = 0.f, gb1 = 0.f;
#define CMB_LD(E_, SL_, GL_, Y_, G_) if (E_ >= 0) { const uint2* yr = (const uint2*)(YS + (size_t)__builtin_amdgcn_readlane(SL_, E_) * DM); \
          G_ = __int_as_float(__builtin_amdgcn_readlane(__float_as_int(GL_), E_)); _Pragma("unroll") for (int j = 0; j < 4; ++j) Y_[j] = yr[j * 64 + lane]; }
#define CMB_ACC(E_, Y_, G_, A_) if (E_ >= 0) { _Pragma("unroll") for (int j = 0; j < 4; ++j) { const uint2 y = Y_[j]; \
          A_[j].x += G_ * __uint_as_float(y.x << 16); A_[j].y += G_ * __uint_as_float(y.x & 0xffff0000u); \
          A_[j].z += G_ * __uint_as_float(y.y << 16); A_[j].w += G_ * __uint_as_float(y.y & 0xffff0000u); } }
        CMB_LD(ea0, sla, gla, ya0, ga0) CMB_LD(eb0, slb, glb, yb0, gb0) CMB_LD(ea1, sla, gla, ya1, ga1) CMB_LD(eb1, slb, glb, yb1, gb1)
        CMB_ACC(ea0, ya0, ga0, aa) CMB_ACC(eb0, yb0, gb0, ab) CMB_ACC(ea1, ya1, ga1, aa) CMB_ACC(eb1, yb1, gb1, ab)
#undef CMB_LD
#undef CMB_ACC
      }
#pragma unroll
      for (int j = 0; j < 4; ++j) {
        const float4 m = mg5[j];
        va[j].x += m.x * aa[j].x; va[j].y += m.y * aa[j].y; va[j].z += m.z * aa[j].z; va[j].w += m.w * aa[j].w;
        vb[j].x += m.x * ab[j].x; vb[j].y += m.y * ab[j].y; vb[j].z += m.z * ab[j].z; vb[j].w += m.w * ab[j].w;
        if (which == 2) {
          ((float4*)(p.out + (size_t)row * DM))[j * 64 + lane] = va[j];
          ((float4*)(p.out + (size_t)(row + 1) * DM))[j * 64 + lane] = vb[j];
        } else {
          ((uint2*)srow(p, 1, row))[j * 64 + lane] = make_uint2(pack2(va[j].x, va[j].y), pack2(va[j].z, va[j].w));
          ((uint2*)srow(p, 1, row + 1))[j * 64 + lane] = make_uint2(pack2(vb[j].x, vb[j].y), pack2(vb[j].z, vb[j].w));
        }
      }
    }
    if (which == 2) continue;
    float ssa = 0.f, ssb = 0.f;
#pragma unroll
    for (int j = 0; j < 4; ++j) {
      ssa += va[j].x * va[j].x + va[j].y * va[j].y + va[j].z * va[j].z + va[j].w * va[j].w;
      ssb += vb[j].x * vb[j].x + vb[j].y * vb[j].y + vb[j].z * vb[j].z + vb[j].w * vb[j].w;
    }
    ssa = wave_sum(ssa); ssb = wave_sum(ssb);
    const float ra = rsqrtf(ssa * (1.f / DM) + EPSF), rb = rsqrtf(ssb * (1.f / DM) + EPSF);
#pragma unroll
    for (int j = 0; j < 4; ++j) {
      const float4 w4 = mw[j], s4 = msh[j], c4 = msc[j];
      uint2 oa, ob;
      oa.x = pack2(va[j].x * ra * w4.x * (1.f + c4.x) + s4.x, va[j].y * ra * w4.y * (1.f + c4.y) + s4.y);
      oa.y = pack2(va[j].z * ra * w4.z * (1.f + c4.z) + s4.z, va[j].w * ra * w4.w * (1.f + c4.w) + s4.w);
      ob.x = pack2(vb[j].x * rb * w4.x * (1.f + c4.x) + s4.x, vb[j].y * rb * w4.y * (1.f + c4.y) + s4.y);
      ob.y = pack2(vb[j].z * rb * w4.z * (1.f + c4.z) + s4.z, vb[j].w * rb * w4.w * (1.f + c4.w) + s4.w);
      ((uint2*)(dstb + (size_t)row * DM))[j * 64 + lane] = oa;
      ((uint2*)(dstb + (size_t)(row + 1) * DM))[j * 64 + lane] = ob;
    }
  }
}

__device__ __forceinline__ void phase_norm2(const Params& p, int layer, int srcmode, int nrows, int bid, int nb) {
  const int tx0_ = otid();
  const int wave = tx0_ >> 6, lane = tx0_ & 63;
  const float* nw = p.in[I_N2W] + layer * DM;
  bf16_t* dstb = (bf16_t*)(p.ws + OFF_ACTB);
  const float* wr = p.in[I_ROUT] + (size_t)layer * DM * NEXP;
  float* WRT = (float*)dynsmem;
  __syncthreads();
  for (int i = tx0_; i < DM * NEXP / 4; i += NT) {
    float4 w = ((const float4*)wr)[i];
    const int k = i >> 2, e0 = (i & 3) * 4;
    WRT[(e0 + 0) * DM + k] = w.x; WRT[(e0 + 1) * DM + k] = w.y; WRT[(e0 + 2) * DM + k] = w.z; WRT[(e0 + 3) * DM + k] = w.w;
  }
  __syncthreads();
  int R = (nrows + nb * 8 - 1) / (nb * 8);
  R += R & 1;
  const int row_lo = (bid * 8 + wave) * R;
  const int row_hi = (row_lo + R < nrows) ? row_lo + R : nrows;
  if (row_lo >= nrows) return;
  float4 mw[4], msh[4], msc[4];
#pragma unroll
  for (int j = 0; j < 4; ++j) mw[j] = ((const float4*)nw)[j * 64 + lane];
  int cur_mr = -1;
  uint2 nua[4], nub[4];
  {
    const uint2* sa = (const uint2*)srow(p, srcmode, row_lo);
    const uint2* sb = (const uint2*)srow(p, srcmode, row_lo + 1);
#pragma unroll
    for (int j = 0; j < 4; ++j) { nua[j] = sa[j * 64 + lane]; nub[j] = sb[j * 64 + lane]; }
  }
  for (int row = row_lo; row < row_hi; row += 2) {
    const int mr = modrow(row);
    if (mr != cur_mr) {
      cur_mr = mr;
      const float4* sh = (const float4*)modptr(p, layer, mr, 3);
      const float4* sc = (const float4*)modptr(p, layer, mr, 4);
#pragma unroll
      for (int j = 0; j < 4; ++j) {
        msh[j] = sh[j * 64 + lane];
        const float4 c = sc[j * 64 + lane], w = mw[j];
        msc[j] = make_float4(w.x * (1.f + c.x), w.y * (1.f + c.y), w.z * (1.f + c.z), w.w * (1.f + c.w));
      }
    }
    float4 va[4], vb[4];
#pragma unroll
    for (int j = 0; j < 4; ++j) { va[j] = up4(nua[j]); vb[j] = up4(nub[j]); }
    if (row + 2 < row_hi) {
      const uint2* sa = (const uint2*)srow(p, srcmode, row + 2);
      const uint2* sb = (const uint2*)srow(p, srcmode, row + 3);
#pragma unroll
      for (int j = 0; j < 4; ++j) { nua[j] = sa[j * 64 + lane]; nub[j] = sb[j * 64 + lane]; }
    }
    float ssa = 0.f, ssb = 0.f;
#pragma unroll
    for (int j = 0; j < 4; ++j) {
      ssa += va[j].x * va[j].x + va[j].y * va[j].y + va[j].z * va[j].z + va[j].w * va[j].w;
      ssb += vb[j].x * vb[j].x + vb[j].y * vb[j].y + vb[j].z * vb[j].z + vb[j].w * vb[j].w;
    }
    ssa = wave_sum(ssa); ssb = wave_sum(ssb);
    const float ra = rsqrtf(ssa * (1.f / DM) + EPSF), rb = rsqrtf(ssb * (1.f / DM) + EPSF);
    f32x2 lg[16];
#pragma unroll
    for (int e = 0; e < 16; ++e) lg[e] = (f32x2){0.f, 0.f};
#pragma unroll
    for (int j = 0; j < 4; ++j) {
      const float4 s4 = msh[j], c4 = msc[j];
      const float a0 = (va[j].x * ra) * c4.x + s4.x, a1 = (va[j].y * ra) * c4.y + s4.y;
      const float a2 = (va[j].z * ra) * c4.z + s4.z, a3 = (va[j].w * ra) * c4.w + s4.w;
      const float b0 = (vb[j].x * rb) * c4.x + s4.x, b1 = (vb[j].y * rb) * c4.y + s4.y;
      const float b2 = (vb[j].z * rb) * c4.z + s4.z, b3 = (vb[j].w * rb) * c4.w + s4.w;
      uint2 oa, ob;
      oa.x = pack2(a0, a1); oa.y = pack2(a2, a3); ob.x = pack2(b0, b1); ob.y = pack2(b2, b3);
      ((uint2*)(dstb + (size_t)row * DM))[j * 64 + lane] = oa;
      ((uint2*)(dstb + (size_t)(row + 1) * DM))[j * 64 + lane] = ob;
      const f32x2 ab0 = (f32x2){a0, b0}, ab1 = (f32x2){a1, b1}, ab2 = (f32x2){a2, b2}, ab3 = (f32x2){a3, b3};
#pragma unroll
      for (int e = 0; e < 16; ++e) {
        const float4 w = ((const float4*)(WRT + e * DM))[j * 64 + lane];
        lg[e] += ab0 * w.x; lg[e] += ab1 * w.y; lg[e] += ab2 * w.z; lg[e] += ab3 * w.w;
        if ((e & 3) == 3) CFENCE();
      }
    }
    float la, lb;
    {
      const bool h3 = lane & 8, h2 = lane & 4, h1 = lane & 2, h0 = lane & 1;
      float ua[8], ub[8];
#pragma unroll
      for (int k = 0; k < 8; ++k) {
        const float ka = h3 ? lg[8 + k].x : lg[k].x, sa = h3 ? lg[k].x : lg[8 + k].x;
        const float kb = h3 ? lg[8 + k].y : lg[k].y, sb = h3 ? lg[k].y : lg[8 + k].y;
        ua[k] = ka + dppf<0x140>(sa); ub[k] = kb + dppf<0x140>(sb);
      }
      float va4[4], vb4[4];
#pragma unroll
      for (int k = 0; k < 4; ++k) {
        const float ka = h2 ? ua[4 + k] : ua[k], sa = h2 ? ua[k] : ua[4 + k];
        const float kb = h2 ? ub[4 + k] : ub[k], sb = h2 ? ub[k] : ub[4 + k];
        va4[k] = ka + dppf<0x141>(sa); vb4[k] = kb + dppf<0x141>(sb);
      }
      float wa2[2], wb2[2];
#pragma unroll
      for (int k = 0; k < 2; ++k) {
        const float ka = h1 ? va4[2 + k] : va4[k], sa = h1 ? va4[k] : va4[2 + k];
        const float kb = h1 ? vb4[2 + k] : vb4[k], sb = h1 ? vb4[k] : vb4[2 + k];
        wa2[k] = ka + dppf<0x4E>(sa); wb2[k] = kb + dppf<0x4E>(sb);
      }
      la = (h0 ? wa2[1] : wa2[0]) + dppf<0xB1>(h0 ? wa2[0] : wa2[1]);
      lb = (h0 ? wb2[1] : wb2[0]) + dppf<0xB1>(h0 ? wb2[0] : wb2[1]);
      la += __shfl_xor(la, 16); lb += __shfl_xor(lb, 16);
      la += __shfl_xor(la, 32); lb += __shfl_xor(lb, 32);
    }
    const float pa = expf(la - max16(la)), pb = expf(lb - max16(lb));
    const float dena = sum16(pa), denb = sum16(pb);
    const float minea = pa, mineb = pb;
    if (lane < 16) {
      float* aff = (float*)(p.ws + OFF_AFF);
      size_t idx;
      if (row < NLAT) { int b = row >> 11, n = row & 2047; idx = ((size_t)(b * NEXP + lane)) * SEQ + n; }
      else { int rr = row - NLAT; int b = rr >> 8, n = rr & 255; idx = (size_t)NB * NEXP * SEQ + ((size_t)(b * NEXP + lane)) * CTXL + n; }
      aff[idx] = minea / dena;
      aff[idx + 1] = mineb / denb;
    }
  }
}

__device__ __forceinline__ int lds_byte(int r, int c) {
  int st = (r >> 4) * 2 + (c >> 5), rr = r & 15, cc = c & 31, ob = rr * 64 + cc * 2;
  return st * 1024 + (ob ^ (((ob >> 9) & 1) << 5));
}
__device__ __forceinline__ void stage_rc(int b, int& R, int& C) {
  int st = b / 1024, sb = b % 1024, swz = sb ^ (((sb >> 9) & 1) << 5);
  R = (st >> 1) * 16 + swz / 64; C = (st & 1) * 32 + (swz % 64) / 2;
}
#define G_LAS __attribute__((address_space(3)))
#define G_HTB (128 * 64 * 2)
#define G_SA(b, h) (((b) * 2 + (h)) * G_HTB)
#define G_SB(b, h) ((4 + (b) * 2 + (h)) * G_HTB)
#define G_STAGE(bufoff, gbase, voff) do { _Pragma("unroll") for (int _i = 0; _i < 2; ++_i) \
    __builtin_amdgcn_global_load_lds((const unsigned*)((const char*)(gbase) + (voff)[_i]), (G_LAS unsigned*)(lds + (bufoff) + ldsw + _i * 8192), 16, 0, 0); } while (0)
#define G_LDA(dst, b, h) do { _Pragma("unroll") for (int m = 0; m < 4; ++m) _Pragma("unroll") for (int k = 0; k < 2; ++k) dst[m][k] = *(const G_LAS bf16x8*)(lds + G_SA(b, h) + aoff + m * 2048 + k * 1024); } while (0)
#define G_LDB(dst, b, h) do { _Pragma("unroll") for (int n = 0; n < 2; ++n) _Pragma("unroll") for (int k = 0; k < 2; ++k) dst[n][k] = *(const G_LAS bf16x8*)(lds + G_SB(b, h) + boff + n * 2048 + k * 1024); } while (0)
#define G_MMA(ai, bj, At_, Bt_) do { __builtin_amdgcn_s_setprio(1); _Pragma("unroll") for (int m = 0; m < 4; ++m) _Pragma("unroll") for (int n = 0; n < 2; ++n) _Pragma("unroll") for (int k = 0; k < 2; ++k) \
    acc[ai][bj][m][n] = __builtin_amdgcn_mfma_f32_16x16x32_bf16(Bt_[n][k], At_[m][k], acc[ai][bj][m][n], 0, 0, 0); __builtin_amdgcn_s_setprio(0); } while (0)
#define G_WAIT_V(n) asm volatile("s_waitcnt vmcnt(" #n ")" ::: "memory")
#define G_WAIT_L(n) asm volatile("s_waitcnt lgkmcnt(" #n ")" ::: "memory")
#define G_BAR __builtin_amdgcn_s_barrier()
#define G_SCHED __builtin_amdgcn_sched_barrier(0)

struct GUnit { int arow0, bcol, orow0, flags; const bf16_t* Bt; };

template <int EPI>
__device__ __forceinline__ void gemm_epilogue(const Params& p, int layer, int srcmode, const f32x4 (&acc)[2][2][4][2], int orow0, int bcol, int flags, int wr, int wc, int fr, int fq) {
#pragma unroll
  for (int ai = 0; ai < 2; ++ai) {
    if (ai == 1 && (flags & 1)) break;
#pragma unroll
    for (int m = 0; m < 4; ++m) {
      const int row = orow0 + ai * 128 + wr * 64 + m * 16 + fr;
      if (EPI == 0 || EPI == 3) {
        bf16_t* O = (EPI == 0) ? (bf16_t*)(p.ws + OFF_U) + (size_t)row * INP : (bf16_t*)(p.ws + OFF_U) + (size_t)row * DM;
#pragma unroll
        for (int bj = 0; bj < 2; ++bj) {
          if (bj == 1 && (flags & 2)) break;
          const int col = bcol + bj * 128 + wc * 32 + fq * 8;
          const f32x4 a0 = acc[ai][bj][m][0], a1 = acc[ai][bj][m][1];
          *(uint4*)(O + col) = make_uint4(pack2(a0[0], a0[1]), pack2(a0[2], a0[3]), pack2(a1[0], a1[1]), pack2(a1[2], a1[3]));
        }
      } else if (EPI == 1) {
        const float* g2 = modptr(p, layer, modrow(row), 2);
#pragma unroll
        for (int bj = 0; bj < 2; ++bj) {
          if (bj == 1 && (flags & 2)) break;
          const int col = bcol + bj * 128 + wc * 32 + fq * 8;
          const f32x4 a0 = acc[ai][bj][m][0], a1 = acc[ai][bj][m][1];
          const float4 g0 = *(const float4*)(g2 + col), g1 = *(const float4*)(g2 + col + 4);
          float4 x0, x1;
          if (srcmode == 0) { const float* xs = xrow_src(p, 0, row); x0 = *(const float4*)(xs + col); x1 = *(const float4*)(xs + col + 4); }
          else { const uint4 u = *(const uint4*)(srow(p, 1, row) + col); x0 = up4(make_uint2(u.x, u.y)); x1 = up4(make_uint2(u.z, u.w)); }
          x0.x += g0.x * a0[0]; x0.y += g0.y * a0[1]; x0.z += g0.z * a0[2]; x0.w += g0.w * a0[3];
          x1.x += g1.x * a1[0]; x1.y += g1.y * a1[1]; x1.z += g1.z * a1[2]; x1.w += g1.w * a1[3];
          *(uint4*)(srow(p, srcmode == 0 ? 1 : 2, row) + col) = make_uint4(pack2(x0.x, x0.y), pack2(x0.z, x0.w), pack2(x1.x, x1.y), pack2(x1.z, x1.w));
        }
      } else {
        bf16_t* ACT = (bf16_t*)(p.ws + OFF_ACTA) + (size_t)row * FF;
#pragma unroll
        for (int bj = 0; bj < 2; ++bj) {
          const int f = (((bcol + bj * 128 + wc * 32) >> 5) << 4) + fq * 4;
          f32x4 g = acc[ai][bj][m][0], u = acc[ai][bj][m][1];
          uint2 o;
          o.x = pack2(siluf_(g[0]) * u[0], siluf_(g[1]) * u[1]);
          o.y = pack2(siluf_(g[2]) * u[2], siluf_(g[3]) * u[3]);
          *(uint2*)(ACT + f) = o;
        }
      }
    }
  }
}

template <int EPI, class UnitFn>
__device__ __forceinline__ void gemm_stream(const Params& p, int layer, int srcmode, const bf16_t* __restrict__ A, const int* __restrict__ rowl, int K,
                                            const UnitFn& unit_of, int bid, int nb) {
  G_LAS unsigned char* lds = (G_LAS unsigned char*)dynsmem;
  int tx_ = threadIdx.x; asm volatile("" : "+v"(tx_));
  const int tid = tx_, wid = __builtin_amdgcn_readfirstlane(tid >> 6), lane = tid & 63, wr = wid >> 2, wc = wid & 3, fr = lane & 15, fq = lane >> 4;
  const int nt = K / 64;
  GUnit cur, nxt;
  int ui = bid;
#define G_REMAP(L_) ((nb & 7) ? (L_) : ((((L_) / nb) * nb) + (((L_) % nb) & 7) * (nb >> 3) + (((L_) % nb) >> 3)))
  if (!unit_of(G_REMAP(ui), cur)) return;
  int R0, C0, R1, C1;
  stage_rc(tid * 16, R0, C0);
  stage_rc(tid * 16 + 8192, R1, C1);
  unsigned voffB[2];
  voffB[0] = (unsigned)(R0 * K + C0) * 2u; voffB[1] = (unsigned)(R1 * K + C1) * 2u;
#define G_CALCA(U_, V0, V1) do { const int h1_ = ((U_).flags & 1) ? 0 : 128; int r00 = (U_).arow0 + R0, r01 = (U_).arow0 + R1, r10 = (U_).arow0 + h1_ + R0, r11 = (U_).arow0 + h1_ + R1; \
    if (rowl) { r00 = rowl[r00]; r01 = rowl[r01]; r10 = rowl[r10]; r11 = rowl[r11]; } \
    V0[0] = (unsigned)(r00 * K + C0) * 2u; V0[1] = (unsigned)(r01 * K + C1) * 2u; V1[0] = (unsigned)(r10 * K + C0) * 2u; V1[1] = (unsigned)(r11 * K + C1) * 2u; } while (0)
  constexpr bool GATHER = (EPI == 2);
  unsigned vA0[2], vA1[2];
  if (GATHER) { G_CALCA(cur, vA0, vA1); } else { vA0[0] = vA0[1] = vA1[0] = vA1[1] = 0u; }
  const size_t kstep = 128;
  const size_t hstep = (size_t)128 * K * 2;
  const unsigned ldsw = (unsigned)wid * 1024u;
  const int aoff = lds_byte(wr * 64 + fr, fq * 8), boff = lds_byte(wc * 32 + fr, fq * 8);
  const char* cA = (const char*)A + (GATHER ? (size_t)0 : (size_t)cur.arow0 * K * 2);
  const char* cB = (const char*)cur.Bt + (size_t)cur.bcol * K * 2;
  f32x4 acc[2][2][4][2];
#pragma unroll
  for (int a = 0; a < 2; ++a)
#pragma unroll
    for (int b = 0; b < 2; ++b)
#pragma unroll
      for (int m = 0; m < 4; ++m)
#pragma unroll
        for (int n = 0; n < 2; ++n) acc[a][b][m][n] = (f32x4){0.f, 0.f, 0.f, 0.f};
  bf16x8 At[4][2], B0[2][2], B1[2][2];
  const int koff = (EPI == 1) ? 8 : 0;
#define G_KT(T_) ((size_t)((((T_) + koff) & (nt - 1))) * kstep)
#define G_STAGE_A(bufoff, H_, base, V0_, V1_) do { if (GATHER) { if (H_) G_STAGE(bufoff, base, V1_); else G_STAGE(bufoff, base, V0_); } \
    else G_STAGE(bufoff, (base) + (H_) * hstep, voffB); } while (0)
  G_STAGE(G_SB(0, 0), cB + G_KT(0), voffB); G_STAGE_A(G_SA(0, 0), 0, cA + G_KT(0), vA0, vA1); G_STAGE(G_SB(0, 1), cB + hstep + G_KT(0), voffB); G_STAGE_A(G_SA(0, 1), 1, cA + G_KT(0), vA0, vA1);
  if (wr == 1) G_BAR;
  G_WAIT_V(4); G_BAR;
  G_STAGE(G_SB(1, 0), cB + G_KT(1), voffB); G_STAGE_A(G_SA(1, 0), 0, cA + G_KT(1), vA0, vA1); G_STAGE(G_SB(1, 1), cB + hstep + G_KT(1), voffB);
  G_WAIT_V(6); G_BAR;
  for (;;) {
    const bool has_next = unit_of(G_REMAP(ui + nb), nxt);
    unsigned nA0[2], nA1[2];
    const char* nB;
    const char* nA;
    if (has_next) {
      if (GATHER) { G_CALCA(nxt, nA0, nA1); nA = cA; } else { nA0[0] = nA0[1] = nA1[0] = nA1[1] = 0u; nA = (const char*)A + (size_t)nxt.arow0 * K * 2; }
      nB = (const char*)nxt.Bt + (size_t)nxt.bcol * K * 2;
    } else { nA0[0] = vA0[0]; nA0[1] = vA0[1]; nA1[0] = vA1[0]; nA1[1] = vA1[1]; nB = cB; nA = cA; }
    const int fl = __builtin_amdgcn_readfirstlane(cur.flags);
    for (int t = 0; t < nt; t += 2) {
      const bool last = (t == nt - 2);
      const char* a1 = cA + G_KT(t + 1);
      const char* a2 = (last ? nA : cA) + G_KT(last ? 0 : t + 2);
      const char* b2 = (last ? nB : cB) + G_KT(last ? 0 : t + 2);
      const char* a3 = (last ? nA : cA) + G_KT(last ? 1 : t + 3);
      const char* b3 = (last ? nB : cB) + G_KT(last ? 1 : t + 3);
      unsigned w0[2], w1[2];
      if (GATHER) {
        w0[0] = last ? nA0[0] : vA0[0]; w0[1] = last ? nA0[1] : vA0[1];
        w1[0] = last ? nA1[0] : vA1[0]; w1[1] = last ? nA1[1] : vA1[1];
      } else { w0[0] = w0[1] = w1[0] = w1[1] = 0u; }
      if (EPI == 1 && t == 4) {
        const float* PS = (const float*)(p.ws + OFF_PSSQ);
#pragma unroll
        for (int ai = 0; ai < 2; ++ai) {
          CFENCE();
#pragma unroll
          for (int m = 0; m < 4; ++m) {
            const int row = cur.orow0 + ai * 128 + wr * 64 + m * 16 + fr;
            const float4 ps = *(const float4*)(PS + (size_t)row * 4);
            const float rs = rsqrtf((ps.x + ps.y + ps.z + ps.w) * (1.f / 256.f) + EPSF);
#pragma unroll
            for (int bj = 0; bj < 2; ++bj)
#pragma unroll
              for (int n = 0; n < 2; ++n) acc[ai][bj][m][n] *= rs;
          }
        }
      }
      G_LDB(B0, 0, 0); G_SCHED; G_LDA(At, 0, 0); G_STAGE_A(G_SA(1, 1), 1, a1, vA0, vA1);
      G_WAIT_L(8); G_BAR; G_WAIT_L(0); G_MMA(0, 0, At, B0); G_BAR; G_SCHED;
      G_LDB(B1, 0, 1); G_STAGE(G_SB(0, 0), b2, voffB);
      G_BAR; G_WAIT_L(0); if (!(fl & 2)) G_MMA(0, 1, At, B1); G_BAR;
      G_LDA(At, 0, 1); G_STAGE_A(G_SA(0, 0), 0, a2, w0, w1);
      G_BAR; G_WAIT_L(0); if (!(fl & 1)) G_MMA(1, 0, At, B0); G_BAR; G_SCHED;
      G_STAGE(G_SB(0, 1), b2 + hstep, voffB);
      G_WAIT_V(6); G_BAR; if (!(fl & 3)) G_MMA(1, 1, At, B1); G_BAR;
      G_LDB(B0, 1, 0); G_SCHED; G_LDA(At, 1, 0); G_STAGE_A(G_SA(0, 1), 1, a2, w0, w1);
      G_WAIT_L(8); G_BAR; G_WAIT_L(0); G_MMA(0, 0, At, B0); G_BAR; G_SCHED;
      G_LDB(B1, 1, 1); G_STAGE(G_SB(1, 0), b3, voffB);
      G_BAR; G_WAIT_L(0); if (!(fl & 2)) G_MMA(0, 1, At, B1); G_BAR;
      G_LDA(At, 1, 1); G_STAGE_A(G_SA(1, 0), 0, a3, w0, w1);
      G_BAR; G_WAIT_L(0); if (!(fl & 1)) G_MMA(1, 0, At, B0); G_BAR; G_SCHED;
      G_STAGE(G_SB(1, 1), b3 + hstep, voffB);
      G_WAIT_V(6); G_BAR; if (!(fl & 3)) G_MMA(1, 1, At, B1); G_BAR;
    }
    gemm_epilogue<EPI>(p, layer, srcmode, acc, cur.orow0, cur.bcol, fl, wr, wc, fr, fq);
    if (!has_next) break;
#pragma unroll
    for (int a = 0; a < 2; ++a)
#pragma unroll
      for (int b = 0; b < 2; ++b)
#pragma unroll
        for (int m = 0; m < 4; ++m)
#pragma unroll
          for (int n = 0; n < 2; ++n) acc[a][b][m][n] = (f32x4){0.f, 0.f, 0.f, 0.f};
    cur = nxt; cB = nB; cA = nA; ui += nb;
    vA0[0] = nA0[0]; vA0[1] = nA0[1]; vA1[0] = nA1[0]; vA1[1] = nA1[1];
  }
  G_WAIT_V(0);
  if (wr == 0) G_BAR;
  G_BAR;
#undef G_CALCA
#undef G_KT
#undef G_STAGE_A
}

__device__ __forceinline__ void phase_inproj(const Params& p, int layer, int bid, int nb) {
  const bf16_t* A = (const bf16_t*)(p.ws + OFF_ACTA);
  const bf16_t* Bt = (const bf16_t*)(p.ws + OFF_WINT) + (size_t)layer * INP * DM;
  constexpr int MT = NTOK / 256, NTL = INP / 256;
  auto unit_of = [&](int t, GUnit& u) -> bool {
    if (t >= MT * NTL) return false;
    const int g = t / 96, w = t % 96, ntg = w / 32, r = w % 32;
    const int mt = g * 8 + (r & 7), ntile = ntg * 4 + (r >> 3);
    u.arow0 = mt * 256; u.bcol = ntile * 256; u.orow0 = mt * 256; u.Bt = Bt; u.flags = 0;
    return true;
  };
  gemm_stream<0>(p, layer, 0, A, nullptr, DM, unit_of, bid, nb);
}
__device__ __forceinline__ void phase_outproj(const Params& p, int layer, int bid, int nb) {
  const bf16_t* A = (const bf16_t*)(p.ws + OFF_ACTA);
  const bf16_t* Bt = (const bf16_t*)(p.ws + OFF_WOUTT) + (size_t)layer * DM * DM;
  constexpr int NTL = DM / 256, LATU = (NLAT / 256) * NTL;
  const int total = LATU + (layer == 0 ? (NCTX / 256) * NTL * 4 : 0);
  auto unit_of = [&](int t, GUnit& u) -> bool {
    if (t >= total) return false;
    if (t < LATU) {
      const int mt = t / NTL, ntile = t % NTL;
      u.arow0 = mt * 256; u.bcol = ntile * 256; u.flags = 0;
    } else {
      const int q = t - LATU, mt = q >> 4, ntile = (q >> 2) & 3, qa = (q >> 1) & 1, qb = q & 1;
      u.arow0 = NLAT + mt * 256 + qa * 128; u.bcol = ntile * 256 + qb * 128; u.flags = 3;
    }
    u.orow0 = u.arow0; u.Bt = Bt;
    return true;
  };
  gemm_stream<1>(p, layer, layer == 0 ? 0 : 1, A, nullptr, DM, unit_of, bid, nb);
}
__device__ __forceinline__ void phase_moe1(const Params& p, int layer, int bid, int nb) {
  const bf16_t* A = (const bf16_t*)(p.ws + OFF_ACTB);
  const int* ROWL = (const int*)(p.ws + OFF_ROWL);
  const int MT = (layer == 0 ? SLOTS : SLOTS_L) / 256;
  const bf16_t* W = (const bf16_t*)(p.ws + OFF_WGU) + (size_t)layer * NEXP * 1024 * DM;
  auto unit_of = [&](int t, GUnit& u) -> bool {
    if (t >= (MT == 16 ? 1024 : 1280)) return false;
    if (MT == 16 || t < 1024) {
      const int e = t >> 6, r = t & 63, ntile = r >> 4, mt = r & 15;
      u.arow0 = e * SLOTS + mt * 256; u.bcol = ntile * 256; u.flags = 0; u.Bt = W + (size_t)e * 1024 * DM;
    } else {
      const int q = t - 1024, e = q >> 4, r = q & 15, ntile = r >> 2, hm = r & 3;
      u.arow0 = e * SLOTS + SLOTS_L + hm * 128; u.bcol = ntile * 256; u.flags = 1; u.Bt = W + (size_t)e * 1024 * DM;
    }
    u.orow0 = u.arow0;
    return true;
  };
  gemm_stream<2>(p, layer, 0, A, ROWL, DM, unit_of, bid, nb);
}
__device__ __forceinline__ void phase_moe2(const Params& p, int layer, int bid, int nb) {
  const bf16_t* A = (const bf16_t*)(p.ws + OFF_ACTA);
  const int MT = (layer == 0 ? SLOTS : SLOTS_L) / 256;
  const bf16_t* W = (const bf16_t*)(p.ws + OFF_WDT) + (size_t)layer * NEXP * DM * FF;
  auto unit_of = [&](int t, GUnit& u) -> bool {
    if (t >= (MT == 16 ? 1024 : 1280)) return false;
    if (MT == 16 || t < 1024) {
      const int e = t >> 6, r = t & 63, ntile = r >> 4, mt = r & 15;
      u.arow0 = e * SLOTS + mt * 256; u.bcol = ntile * 256; u.flags = 0; u.Bt = W + (size_t)e * DM * FF;
    } else {
      const int q = t - 1024, e = q >> 4, r = q & 15, ntile = r >> 2, hm = r & 3;
      u.arow0 = e * SLOTS + SLOTS_L + hm * 128; u.bcol = ntile * 256; u.flags = 1; u.Bt = W + (size_t)e * DM * FF;
    }
    u.orow0 = u.arow0;
    return true;
  };
  gemm_stream<3>(p, layer, 0, A, nullptr, FF, unit_of, bid, nb);
}

template <bool SWA = false, bool SWB = false>
__device__ __forceinline__ void mma16(const bf16_t* At, int r0, const bf16_t* Bt, f32x4* acc, int fr, int fq) {
#pragma unroll
  for (int ks = 0; ks < 2; ++ks) {
    const int ca = (ks * 32 + fq * 8) ^ (SWA ? 16 * ((r0 >> 4) & 3) : 0);
    bf16x8 a = *(const bf16x8*)(At + (r0 + fr) * TS + ca);
#pragma unroll
    for (int nf = 0; nf < 4; ++nf) {
      const int cb = (ks * 32 + fq * 8) ^ (SWB ? 16 * nf : 0);
      bf16x8 b = *(const bf16x8*)(Bt + (nf * 16 + fr) * TS + cb);
      acc[nf] = __builtin_amdgcn_mfma_f32_16x16x32_bf16(a, b, acc[nf], 0, 0, 0);
    }
  }
}

struct StepGeo { int rowbase, seglen, T0; bool wout, second; };
__device__ __forceinline__ StepGeo step_geo(int L, int b, int d, int s) {
  StepGeo g;
  const bool ctx = s < 4;
  const int c = ctx ? s : s - 4;
  const int nch = ctx ? (CTXL / 64) : (SEQ / 64);
  const int nc = d ? nch - 1 - c : c;
  g.seglen = ctx ? CTXL : SEQ;
  g.rowbase = ctx ? NLAT + b * CTXL : b * SEQ;
  g.T0 = nc * 64;
  g.wout = !(L == 1 && ctx);
  const int base = ctx ? 0 : 4;
  const int s_other = d ? base + nc : base + (nch - 1 - nc);
  g.second = s_other < s;
  return g;
}

__device__ __forceinline__ void chain_hgrn_fast(const Params& p, int L, int bh) {
  const int b = bh >> 2, h = bh & 3;
  int tx_ = threadIdx.x; asm volatile("" : "+v"(tx_));
  const int d = tx_ >> 8, tid = tx_ & 255;
  char* sm = dynsmem + d * GROUP_LDS;
  float* CUM = (float*)sm;
  bf16_t* QT = (bf16_t*)(sm + 16640);
  bf16_t* KT = QT + 64 * TS;
  bf16_t* KE = KT + 64 * TS;
  bf16_t* VT = KE + 64 * TS;
  bf16_t* ST = VT + 64 * TS;
  float* SEG = (float*)(ST + 64 * TS);
  const int w = tid >> 6, lane = tid & 63, fr = lane & 15, fq = lane >> 4;
  const int ti = tid >> 2, kq = (tid & 3) * 16;
  const bf16_t* U = (const bf16_t*)(p.ws + OFF_U);
  bf16_t* Y = (bf16_t*)(p.ws + OFF_ACTA);
  float lb[16];
#pragma unroll
  for (int e = 0; e < 16; ++e) lb[e] = (L == 1) ? sigmoidf_(p.in[I_HLB][256 + h * 64 + kq + e] - p.in[I_HLB][h * 64 + kq + e]) : 0.f;
  float nwv[4];
#pragma unroll
  for (int nf = 0; nf < 4; ++nf) nwv[nf] = p.in[I_HNW][L * 256 + h * 64 + nf * 16 + fr];
  f32x4 S[4];
#pragma unroll
  for (int nf = 0; nf < 4; ++nf) S[nf] = (f32x4){0.f, 0.f, 0.f, 0.f};
  uint4 cq0, cq1, cf0, cf1, cv0, cv1;
  {
    StepGeo g = step_geo(L, b, d, 0);
    const bf16_t* ur = U + (size_t)(g.rowbase + (d ? g.T0 + 63 - ti : g.T0 + ti)) * INP + h * 64 + kq;
    cq0 = ((const uint4*)(ur + 512))[0]; cq1 = ((const uint4*)(ur + 512))[1];
    cf0 = ((const uint4*)(ur + 768 + d * 256))[0]; cf1 = ((const uint4*)(ur + 768 + d * 256))[1];
    cv0 = ((const uint4*)(ur + 1280))[0]; cv1 = ((const uint4*)(ur + 1280))[1];
  }
  for (int s = 0; s < 36; ++s) {
    const StepGeo g = step_geo(L, b, d, s);
    const bf16_t* urn = U;
    if (s + 1 < 36) {
      StepGeo g2 = step_geo(L, b, d, s + 1);
      urn = U + (size_t)(g2.rowbase + (d ? g2.T0 + 63 - ti : g2.T0 + ti)) * INP + h * 64 + kq;
    }
    float qv[16], kkv[16];
    {
      uint4 cq[2] = {cq0, cq1}, cf[2] = {cf0, cf1};
#pragma unroll
      for (int e = 0; e < 16; ++e) {
        float qr = unpk(cq, e), fr_ = unpk(cf, e);
        qv[e] = siluf_(qr);
        float f = lb[e] + (1.f - lb[e]) * sigmoidf_(fr_);
        kkv[e] = 1.f - f;
        CUM[ti * 65 + kq + e] = fmaxf(__builtin_amdgcn_logf(f), -115.41560327111707f);
      }
    }
    if (s + 1 < 36) {
      cq0 = ((const uint4*)(urn + 512))[0]; cq1 = ((const uint4*)(urn + 512))[1];
      cf0 = ((const uint4*)(urn + 768 + d * 256))[0]; cf1 = ((const uint4*)(urn + 768 + d * 256))[1];
    }
    __syncthreads();
    {
      float run = 0.f;
#pragma unroll
      for (int r = 0; r < 16; ++r) { int idx = (w * 16 + r) * 65 + lane; run += CUM[idx]; CUM[idx] = run; }
      SEG[w * 64 + lane] = run;
    }
    __syncthreads();
    {
      float off = 0.f;
      for (int s2 = 0; s2 < w; ++s2) off += SEG[s2 * 64 + lane];
      if (w > 0) {
#pragma unroll
        for (int r = 0; r < 16; ++r) CUM[(w * 16 + r) * 65 + lane] += off;
      }
    }
    __syncthreads();
    {
      const int tsw = ti ^ (16 * (tid & 3));
      uint4 cv[2] = {cv0, cv1};
      unsigned qp[8], kp[8];
#pragma unroll
      for (int e2 = 0; e2 < 8; ++e2) {
        float qa[2], ka[2];
#pragma unroll
        for (int u = 0; u < 2; ++u) {
          const int e = e2 * 2 + u, k = kq + e;
          float ci = CUM[ti * 65 + k], cm = CUM[31 * 65 + k], ce = CUM[63 * 65 + k];
          qa[u] = qv[e] * fexp2(fminf(ci - cm, 115.41560327111707f));
          ka[u] = kkv[e] * fexp2(fminf(cm - ci, 115.41560327111707f));
          KE[k * TS + tsw] = f2bf(kkv[e] * fexp2(ce - ci));
          VT[k * TS + tsw] = unpk_raw(cv, e);
        }
        qp[e2] = pack2(qa[0], qa[1]);
        kp[e2] = pack2(ka[0], ka[1]);
      }
      uint4* qd = (uint4*)(QT + ti * TS + kq);
      uint4* kd = (uint4*)(KT + ti * TS + kq);
      qd[0] = make_uint4(qp[0], qp[1], qp[2], qp[3]); qd[1] = make_uint4(qp[4], qp[5], qp[6], qp[7]);
      kd[0] = make_uint4(kp[0], kp[1], kp[2], kp[3]); kd[1] = make_uint4(kp[4], kp[5], kp[6], kp[7]);
    }
    if (s + 1 < 36) { cv0 = ((const uint4*)(urn + 1280))[0]; cv1 = ((const uint4*)(urn + 1280))[1]; }
    float dec[4];
#pragma unroll
    for (int nf = 0; nf < 4; ++nf) {
      const int k = nf * 16 + fr;
      float em = fexp2(CUM[31 * 65 + k]);
      dec[nf] = fexp2(CUM[63 * 65 + k]);
#pragma unroll
      for (int jj = 0; jj < 4; ++jj) ST[(16 * w + 4 * fq + jj) * TS + k] = f2bf(S[nf][jj] * em);
    }
    __syncthreads();
    const size_t orow = (size_t)(g.rowbase + (d ? g.T0 + 63 - ti : g.T0 + ti));
    uint4 pp0 = make_uint4(0u, 0u, 0u, 0u), pp1 = pp0, pg0 = pp0, pg1 = pp0;
    if (g.wout && g.second) {
      const uint4* pr = (const uint4*)(Y + orow * DM + 256 + h * 64 + kq);
      const uint4* gr = (const uint4*)(U + orow * INP + 1536 + h * 64 + kq);
      pp0 = pr[0]; pp1 = pr[1]; pg0 = gr[0]; pg1 = gr[1];
    }
    f32x4 aP[4], aY[4];
#pragma unroll
    for (int nf = 0; nf < 4; ++nf) { aP[nf] = (f32x4){0.f, 0.f, 0.f, 0.f}; aY[nf] = (f32x4){0.f, 0.f, 0.f, 0.f}; }
    mma16(QT, 16 * w, KT, aP, fr, fq);
    mma16(QT, 16 * w, ST, aY, fr, fq);
    CFENCE();
#pragma unroll
    for (int nf = 0; nf < 4; ++nf)
#pragma unroll
      for (int jj = 0; jj < 4; ++jj) {
        const int t = 16 * w + 4 * fq + jj, sc = nf * 16 + fr;
        QT[t * TS + sc] = f2bf(sc <= t ? aP[nf][jj] : 0.f);
      }
    CFENCE();
    mma16<false, true>(QT, 16 * w, VT, aY, fr, fq);
#pragma unroll
    for (int nf = 0; nf < 4; ++nf)
#pragma unroll
      for (int jj = 0; jj < 4; ++jj) S[nf][jj] *= dec[nf];
    mma16<true, true>(VT, 16 * w, KE, S, fr, fq);
    {
      float* OT = CUM;
#pragma unroll
      for (int nf = 0; nf < 4; ++nf)
#pragma unroll
        for (int jj = 0; jj < 4; ++jj) OT[(16 * w + 4 * fq + jj) * 65 + nf * 16 + fr] = aY[nf][jj];
      __syncthreads();
      if (g.wout) {
        float v[16];
#pragma unroll
        for (int e = 0; e < 16; ++e) v[e] = OT[ti * 65 + kq + e];
        if (g.second) {
          const uint4 pp[2] = {pp0, pp1}, pg[2] = {pg0, pg1};
          float ss = 0.f;
#pragma unroll
          for (int e = 0; e < 16; ++e) { v[e] += unpk(pp, e); ss += v[e] * v[e]; }
          ss += dppf<0xB1>(ss); ss += dppf<0x4E>(ss);
          const float rn = rsqrtf(ss * (1.f / 64.f) + EPSF);
          const float4* nwp = (const float4*)(p.in[I_HNW] + L * 256 + h * 64 + kq);
#pragma unroll
          for (int q4 = 0; q4 < 4; ++q4) {
            const float4 nw4 = nwp[q4];
            v[q4 * 4 + 0] *= rn * nw4.x * siluf_(unpk(pg, q4 * 4 + 0));
            v[q4 * 4 + 1] *= rn * nw4.y * siluf_(unpk(pg, q4 * 4 + 1));
            v[q4 * 4 + 2] *= rn * nw4.z * siluf_(unpk(pg, q4 * 4 + 2));
            v[q4 * 4 + 3] *= rn * nw4.w * siluf_(unpk(pg, q4 * 4 + 3));
          }
        }
        uint4* yo = (uint4*)(Y + orow * DM + 256 + h * 64 + kq);
        yo[0] = make_uint4(pack2(v[0], v[1]), pack2(v[2], v[3]), pack2(v[4], v[5]), pack2(v[6], v[7]));
        yo[1] = make_uint4(pack2(v[8], v[9]), pack2(v[10], v[11]), pack2(v[12], v[13]), pack2(v[14], v[15]));
      }
    }
  }
  __syncthreads();
}

__device__ __forceinline__ void chain_ssd_fast(const Params& p, int L, int bh) {
  const int b = bh >> 2, h = bh & 3, gg = h >> 1;
  int tx_ = threadIdx.x; asm volatile("" : "+v"(tx_));
  const int d = tx_ >> 8, tid = tx_ & 255;
  char* sm = dynsmem + d * GROUP_LDS;
  bf16_t* RAW = (bf16_t*)sm;
  bf16_t* CM = (bf16_t*)(sm + 26112);
  bf16_t* BM = CM + 64 * TS;
  bf16_t* XT = BM + 64 * TS;
  bf16_t* BW = XT + 64 * TS;
  bf16_t* SS = BW + 64 * TS;
  float* DT = (float*)(SS + 64 * TS);
  float* CUMV = DT + 64;
  float* CW = CUMV + 64;
  float* CB = CW + 768;
  const int w = tid >> 6, lane = tid & 63, fr = lane & 15, fq = lane >> 4;
  const int ti = tid >> 2, kq = (tid & 3) * 16;
  const bf16_t* U = (const bf16_t*)(p.ws + OFF_U);
  bf16_t* Y = (bf16_t*)(p.ws + OFF_ACTA);
  __syncthreads();
  for (int i = tid; i < 960; i += 256) {
    if (i < 768) {
      int grp = i >> 8, j = (i >> 6) & 3, c = i & 63;
      int col = grp == 0 ? h * 64 + c : (grp == 1 ? 256 + gg * 64 + c : 384 + gg * 64 + c);
      CW[i] = p.in[I_SCW][(L * 4 + j) * 512 + col];
    } else {
      int i2 = i - 768; int grp = i2 >> 6, c = i2 & 63;
      int col = grp == 0 ? h * 64 + c : (grp == 1 ? 256 + gg * 64 + c : 384 + gg * 64 + c);
      CB[i2] = p.in[I_SCB][L * 512 + col];
    }
  }
  const float dsk = p.in[I_SDSK][L * 4 + h];
  const float Aa = -expf(p.in[I_SALOG][(L * 2 + d) * 4 + h]);
  const float dtb = p.in[I_SDTB][(L * 2 + d) * 4 + h];
  f32x4 S[4];
#pragma unroll
  for (int nf = 0; nf < 4; ++nf) S[nf] = (f32x4){0.f, 0.f, 0.f, 0.f};
  uint4 nr0, nr1, nr2, nr3, nr4, nr5, nr6;
  bf16_t ndt = 0;
#define SSD_LD1(I, DST)                                                                                  \
  {                                                                                                      \
    int c16 = tid + 256 * (I);                                                                           \
    uint4 v = make_uint4(0u, 0u, 0u, 0u);                                                                \
    if (c16 < 1632) {                                                                                    \
      int grp = c16 / 544, rem = c16 % 544, r = rem >> 3, part = rem & 7;                                \
      int t = G_.T0 - 2 + r;                                                                             \
      int gcol = grp == 0 ? 2048 + h * 64 : (grp == 1 ? 2304 + gg * 64 : 2432 + gg * 64);               \
      if (t >= 0 && t < G_.seglen) v = *(const uint4*)(U + (size_t)(G_.rowbase + t) * INP + gcol + part * 8); \
    }                                                                                                    \
    DST = v;                                                                                             \
  }
#define SSD_LOAD()                                                                                       \
  {                                                                                                      \
    SSD_LD1(0, nr0) SSD_LD1(1, nr1) SSD_LD1(2, nr2) SSD_LD1(3, nr3) SSD_LD1(4, nr4) SSD_LD1(5, nr5) SSD_LD1(6, nr6) \
    if (tid < 64) ndt = U[(size_t)(G_.rowbase + (d ? G_.T0 + 63 - tid : G_.T0 + tid)) * INP + 2560 + d * 4 + h]; \
  }
#define SSD_ST1(I, SRC) { int c16 = tid + 256 * (I); if (c16 < 1632) *(uint4*)(RAW + c16 * 8) = SRC; }
  { StepGeo G_ = step_geo(L, b, d, 0); SSD_LOAD(); }
  for (int s = 0; s < 36; ++s) {
    const StepGeo g = step_geo(L, b, d, s);
    __syncthreads();
    SSD_ST1(0, nr0) SSD_ST1(1, nr1) SSD_ST1(2, nr2) SSD_ST1(3, nr3) SSD_ST1(4, nr4) SSD_ST1(5, nr5) SSD_ST1(6, nr6)
    if (tid < 64) {
      float dt = softplusf_(bf2f(ndt) + dtb);
      float v = dt * Aa * 1.4426950408889634f;
#pragma unroll
      for (int o = 1; o < 64; o <<= 1) { float n = __shfl_up(v, o); if (lane >= o) v += n; }
      DT[tid] = dt; CUMV[tid] = v;
    }
    if (s + 1 < 36) { StepGeo G_ = step_geo(L, b, d, s + 1); SSD_LOAD(); }
    __syncthreads();
    {
      const int tn = d ? 63 - ti : ti;
      const int tsw = ti ^ (16 * (tid & 3));
      const float cend = CUMV[63];
      const float wend = DT[ti] * fexp2(cend - CUMV[ti]);
#pragma unroll
      for (int grp = 0; grp < 3; ++grp) {
        float val[16];
#pragma unroll
        for (int e = 0; e < 16; ++e) val[e] = CB[grp * 64 + kq + e];
#pragma unroll
        for (int j = 0; j < 4; ++j) {
          const uint4* rp = (const uint4*)(RAW + (grp * 68 + tn + j) * 64 + kq);
          uint4 rr[2] = {rp[0], rp[1]};
#pragma unroll
          for (int e = 0; e < 16; ++e) val[e] += unpk(rr, e) * CW[(grp * 4 + j) * 64 + kq + e];
        }
#pragma unroll
        for (int e = 0; e < 16; ++e) val[e] = siluf_(val[e]);
        if (grp == 0) {
#pragma unroll
          for (int e = 0; e < 16; ++e) XT[(kq + e) * TS + tsw] = f2bf(val[e]);
        } else {
          unsigned pk[8];
#pragma unroll
          for (int e2 = 0; e2 < 8; ++e2) pk[e2] = pack2(val[2 * e2], val[2 * e2 + 1]);
          uint4* dst = (uint4*)((grp == 1 ? BM : CM) + ti * TS + kq);
          dst[0] = make_uint4(pk[0], pk[1], pk[2], pk[3]); dst[1] = make_uint4(pk[4], pk[5], pk[6], pk[7]);
          if (grp == 1) {
#pragma unroll
            for (int e = 0; e < 16; ++e) BW[(kq + e) * TS + tsw] = f2bf(val[e] * wend);
          }
        }
      }
    }
    float cumt[4], cums[4], dts[4];
    const float cend = CUMV[63];
#pragma unroll
    for (int jj = 0; jj < 4; ++jj) cumt[jj] = CUMV[16 * w + 4 * fq + jj];
#pragma unroll
    for (int nf = 0; nf < 4; ++nf) {
      cums[nf] = CUMV[nf * 16 + fr]; dts[nf] = DT[nf * 16 + fr];
#pragma unroll
      for (int jj = 0; jj < 4; ++jj) SS[(16 * w + 4 * fq + jj) * TS + nf * 16 + fr] = f2bf(S[nf][jj]);
    }
    __syncthreads();
    const size_t orow = (size_t)(g.rowbase + (d ? g.T0 + 63 - ti : g.T0 + ti));
    uint4 pp0 = make_uint4(0u, 0u, 0u, 0u), pp1 = pp0, pz0 = pp0, pz1 = pp0;
    if (g.wout && g.second) {
      const uint4* pr = (const uint4*)(Y + orow * DM + 512 + h * 64 + kq);
      const uint4* zr = (const uint4*)(U + orow * INP + 1792 + h * 64 + kq);
      pp0 = pr[0]; pp1 = pr[1]; pz0 = zr[0]; pz1 = zr[1];
    }
    f32x4 aP[4], aY[4];
#pragma unroll
    for (int nf = 0; nf < 4; ++nf) { aP[nf] = (f32x4){0.f, 0.f, 0.f, 0.f}; aY[nf] = (f32x4){0.f, 0.f, 0.f, 0.f}; }
    mma16(CM, 16 * w, BM, aP, fr, fq);
    mma16(CM, 16 * w, SS, aY, fr, fq);
    CFENCE();
#pragma unroll
    for (int nf = 0; nf < 4; ++nf)
#pragma unroll
      for (int jj = 0; jj < 4; ++jj) {
        const int t = 16 * w + 4 * fq + jj, sc = nf * 16 + fr;
        float pv = sc <= t ? aP[nf][jj] * fexp2(cumt[jj] - cums[nf]) * dts[nf] : 0.f;
        CM[t * TS + sc] = f2bf(pv);
        aY[nf][jj] *= fexp2(cumt[jj]);
      }
    CFENCE();
    mma16<false, true>(CM, 16 * w, XT, aY, fr, fq);
    {
      const float de = fexp2(cend);
#pragma unroll
      for (int nf = 0; nf < 4; ++nf)
#pragma unroll
        for (int jj = 0; jj < 4; ++jj) S[nf][jj] *= de;
    }
    mma16<true, true>(XT, 16 * w, BW, S, fr, fq);
    {
      float* OT = (float*)RAW;
#pragma unroll
      for (int nf = 0; nf < 4; ++nf)
#pragma unroll
        for (int jj = 0; jj < 4; ++jj) OT[(16 * w + 4 * fq + jj) * 65 + nf * 16 + fr] = aY[nf][jj];
      __syncthreads();
      if (g.wout) {
        float v[16];
#pragma unroll
        for (int e = 0; e < 16; ++e) v[e] = OT[ti * 65 + kq + e];
        if (g.second) {
          const uint4 pp[2] = {pp0, pp1}, pz[2] = {pz0, pz1};
          const int tsw = ti ^ (16 * (tid & 3));
          float ssq = 0.f;
#pragma unroll
          for (int e = 0; e < 16; ++e) {
            const float tot = unpk(pp, e) + v[e] + dsk * bf2f(XT[(kq + e) * TS + tsw]);
            v[e] = tot * siluf_(unpk(pz, e));
            ssq += v[e] * v[e];
          }
          ssq += dppf<0xB1>(ssq); ssq += dppf<0x4E>(ssq);
          if ((tid & 3) == 0) ((float*)(p.ws + OFF_PSSQ))[orow * 4 + h] = ssq;
        }
        uint4* yo = (uint4*)(Y + orow * DM + 512 + h * 64 + kq);
        yo[0] = make_uint4(pack2(v[0], v[1]), pack2(v[2], v[3]), pack2(v[4], v[5]), pack2(v[6], v[7]));
        yo[1] = make_uint4(pack2(v[8], v[9]), pack2(v[10], v[11]), pack2(v[12], v[13]), pack2(v[14], v[15]));
      }
    }
  }
  __syncthreads();
#undef SSD_LOAD
#undef SSD_LD1
#undef SSD_ST1
}

__device__ __forceinline__ void chain_lru_fast(const Params& p, int L, int bh) {
  const int b = bh >> 2, h = bh & 3;
  int tx_ = threadIdx.x; asm volatile("" : "+v"(tx_));
  const int d = tx_ >> 8, tid = tx_ & 255;
  char* sm = dynsmem + d * GROUP_LDS;
  bf16_t* RAW = (bf16_t*)sm;
  bf16_t* XC = (bf16_t*)(sm + 8704);
  bf16_t* WR = XC + 64 * TS;
  bf16_t* WI = WR + 64 * TS;
  float* AA = (float*)(WI + 64 * TS);
  float* BB = AA + 64 * 65;
  float* SEGA = BB + 64 * 65;
  float* SEGB = SEGA + 256;
  float* CW = SEGB + 256;
  float* CB = CW + 256;
  const int w = tid >> 6, lane = tid & 63, fr = lane & 15, fq = lane >> 4;
  const int ti = tid >> 2, kq = (tid & 3) * 16;
  const bf16_t* U = (const bf16_t*)(p.ws + OFF_U);
  bf16_t* Y = (bf16_t*)(p.ws + OFF_ACTA);
  __syncthreads();
  for (int i = tid; i < 320; i += 256) {
    if (i < 256) CW[i] = p.in[I_LCW][(L * 4 + (i >> 6)) * 256 + h * 64 + (i & 63)];
    else CB[i - 256] = p.in[I_LCB][L * 256 + h * 64 + (i - 256)];
  }
  {
    const bf16_t* wrs = (const bf16_t*)(p.ws + OFF_LRUW) + (size_t)(((L * 2 + d) * 2 + 0) * 4 + h) * 4096;
    const bf16_t* wis = (const bf16_t*)(p.ws + OFF_LRUW) + (size_t)(((L * 2 + d) * 2 + 1) * 4 + h) * 4096;
    for (int c = tid; c < 512; c += 256) {
      int r = c >> 3, part = c & 7;
      *(uint4*)(WR + r * TS + part * 8) = *(const uint4*)(wrs + r * 64 + part * 8);
      *(uint4*)(WI + r * TS + part * 8) = *(const uint4*)(wis + r * 64 + part * 8);
    }
  }
  float br[4], bi[4], sp[4];
#pragma unroll
  for (int nf = 0; nf < 4; ++nf) {
    const int ch = (L * 2 + d) * 256 + h * 64 + nf * 16 + fr;
    br[nf] = p.in[I_LBR][ch]; bi[nf] = p.in[I_LBI][ch]; sp[nf] = softplusf_(-p.in[I_LLAM][ch]);
  }
  float hst = 0.f;
  uint4 nr0, nr1, nr2;
#define LRU_LD1(I, DST)                                                                                  \
  {                                                                                                      \
    int c16 = tid + 256 * (I);                                                                           \
    uint4 v = make_uint4(0u, 0u, 0u, 0u);                                                                \
    if (c16 < 544) {                                                                                     \
      int r = c16 >> 3, part = c16 & 7;                                                                  \
      int t = G_.T0 - 2 + r;                                                                             \
      if (t >= 0 && t < G_.seglen) v = *(const uint4*)(U + (size_t)(G_.rowbase + t) * INP + h * 64 + part * 8); \
    }                                                                                                    \
    DST = v;                                                                                             \
  }
#define LRU_ST1(I, SRC) { int c16 = tid + 256 * (I); if (c16 < 544) *(uint4*)(RAW + c16 * 8) = SRC; }
  { StepGeo G_ = step_geo(L, b, d, 0); LRU_LD1(0, nr0) LRU_LD1(1, nr1) LRU_LD1(2, nr2) }
  for (int s = 0; s < 36; ++s) {
    const StepGeo g = step_geo(L, b, d, s);
    __syncthreads();
    LRU_ST1(0, nr0) LRU_ST1(1, nr1) LRU_ST1(2, nr2)
    if (s + 1 < 36) { StepGeo G_ = step_geo(L, b, d, s + 1); LRU_LD1(0, nr0) LRU_LD1(1, nr1) LRU_LD1(2, nr2) }
    __syncthreads();
    {
      const int tn = d ? 63 - ti : ti;
      float val[16];
#pragma unroll
      for (int e = 0; e < 16; ++e) val[e] = CB[kq + e];
#pragma unroll
      for (int j = 0; j < 4; ++j) {
        const uint4* rp = (const uint4*)(RAW + (tn + j) * 64 + kq);
        uint4 rr[2] = {rp[0], rp[1]};
#pragma unroll
        for (int e = 0; e < 16; ++e) val[e] += unpk(rr, e) * CW[j * 64 + kq + e];
      }
      unsigned pk[8];
#pragma unroll
      for (int e2 = 0; e2 < 8; ++e2) pk[e2] = pack2(val[2 * e2], val[2 * e2 + 1]);
      uint4* dst = (uint4*)(XC + ti * TS + kq);
      dst[0] = make_uint4(pk[0], pk[1], pk[2], pk[3]); dst[1] = make_uint4(pk[4], pk[5], pk[6], pk[7]);
    }
    __syncthreads();
    {
      f32x4 aR[4], aI[4];
#pragma unroll
      for (int nf = 0; nf < 4; ++nf) { aR[nf] = (f32x4){0.f, 0.f, 0.f, 0.f}; aI[nf] = (f32x4){0.f, 0.f, 0.f, 0.f}; }
      mma16(XC, 16 * w, WR, aR, fr, fq);
      mma16(XC, 16 * w, WI, aI, fr, fq);
#pragma unroll
      for (int nf = 0; nf < 4; ++nf)
#pragma unroll
        for (int jj = 0; jj < 4; ++jj) {
          const int t = 16 * w + 4 * fq + jj, e = nf * 16 + fr;
          float r = sigmoidf_(aR[nf][jj] + br[nf]);
          float ig = sigmoidf_(aI[nf][jj] + bi[nf]);
          float la = -8.f * r * sp[nf];
          float xcv = bf2f(XC[t * TS + e]);
          const float av = fexp(la);
          AA[t * 65 + e] = av;
          BB[t * 65 + e] = __builtin_amdgcn_sqrtf(fmaxf(fmaf(-av, av, 1.f), 0.f)) * (ig * xcv);
        }
    }
    __syncthreads();
    const size_t orow = (size_t)(g.rowbase + (d ? g.T0 + 63 - ti : g.T0 + ti));
    uint4 pp0 = make_uint4(0u, 0u, 0u, 0u), pp1 = pp0, pg0 = pp0, pg1 = pp0;
    if (g.wout && g.second) {
      const uint4* pr = (const uint4*)(Y + orow * DM + h * 64 + kq);
      const uint4* gr = (const uint4*)(U + orow * INP + 256 + h * 64 + kq);
      pp0 = pr[0]; pp1 = pr[1]; pg0 = gr[0]; pg1 = gr[1];
    }
    {
      float A = 1.f, B = 0.f;
#pragma unroll
      for (int r = 0; r < 16; ++r) { float a = AA[(w * 16 + r) * 65 + lane], bb = BB[(w * 16 + r) * 65 + lane]; B = a * B + bb; A = a * A; }
      SEGA[w * 64 + lane] = A; SEGB[w * 64 + lane] = B;
    }
    __syncthreads();
    {
      float hin = hst, hall = hst;
#pragma unroll
      for (int s2 = 0; s2 < 4; ++s2) {
        float a = SEGA[s2 * 64 + lane], bb = SEGB[s2 * 64 + lane];
        hall = a * hall + bb;
        if (s2 < w) hin = a * hin + bb;
      }
      hst = hall;
      float hv = hin;
      float* OT = (float*)RAW;
#pragma unroll
      for (int r = 0; r < 16; ++r) {
        const int t = w * 16 + r;
        hv = AA[t * 65 + lane] * hv + BB[t * 65 + lane];
        OT[t * 65 + lane] = hv;
      }
    }
    __syncthreads();
    if (g.wout) {
      const float* OT = (const float*)RAW;
      float v[16];
#pragma unroll
      for (int e = 0; e < 16; ++e) v[e] = OT[ti * 65 + kq + e];
      if (g.second) {
        const uint4 pp[2] = {pp0, pp1}, pg[2] = {pg0, pg1};
#pragma unroll
        for (int e = 0; e < 16; ++e) v[e] = (unpk(pp, e) + v[e]) * gelu_tanh(unpk(pg, e));
      }
      uint4* yo = (uint4*)(Y + orow * DM + h * 64 + kq);
      yo[0] = make_uint4(pack2(v[0], v[1]), pack2(v[2], v[3]), pack2(v[4], v[5]), pack2(v[6], v[7]));
      yo[1] = make_uint4(pack2(v[8], v[9]), pack2(v[10], v[11]), pack2(v[12], v[13]), pack2(v[14], v[15]));
    }
  }
  __syncthreads();
#undef LRU_LD1
#undef LRU_ST1
}

__device__ __forceinline__ void mlaproj_item_fast(const Params& p, int L, int item) {
  char* sm = dynsmem;
  bf16_t* AQ = (bf16_t*)sm;
  bf16_t* AKV = AQ + 128 * 200;
  bf16_t* WB = AKV + 128 * 136;
  bf16_t* OT = WB + 19200;
  int tx_ = threadIdx.x; asm volatile("" : "+v"(tx_));
  const int tid = tx_, w = tid >> 6, lane = tid & 63, fr = lane & 15, fq = lane >> 4;
  const int ti = tid >> 2, part = tid & 3;
  const bf16_t* U = (const bf16_t*)(p.ws + OFF_U);
  const bf16_t* WQT = (const bf16_t*)(p.ws + OFF_WQT) + (size_t)L * 384 * 192;
  const bf16_t* WKVT = (const bf16_t*)(p.ws + OFF_WKVT) + (size_t)L * 512 * 128;
  const float* ROPE = (const float*)(p.ws + OFF_ROPE);
  const float* qan = p.in[I_MQAN] + L * 192;
  const float* kvan = p.in[I_MKVAN] + L * 128;
  const float* qn = p.in[I_MQN] + L * 96;
  const float* kn = p.in[I_MKN] + L * 96;
  bf16_t* QB = (bf16_t*)(p.ws + OFF_ACTB + QB_OFF);
  bf16_t* KB = (bf16_t*)(p.ws + OFF_ACTB + KB_OFF);
  bf16_t* VB = (bf16_t*)(p.ws + OFF_ACTB + VB_OFF);
  const int row0 = item * 128;
  const bool lat = row0 < NLAT;
  const int b = lat ? (row0 >> 11) : ((row0 - NLAT) >> 8);
  const int n0 = lat ? (row0 & 2047) : ((row0 - NLAT) & 255);
  const int key0 = lat ? CTXL + n0 : n0;
  uint4 w0, w1, w2, w3, w4;
#define WLOADQ(HH) { const bf16_t* base = WQT + (size_t)(HH) * 96 * 192; \
    { int c = tid;        w0 = *(const uint4*)(base + (c / 24) * 192 + (c % 24) * 8); } \
    { int c = tid + 512;  w1 = *(const uint4*)(base + (c / 24) * 192 + (c % 24) * 8); } \
    { int c = tid + 1024; w2 = *(const uint4*)(base + (c / 24) * 192 + (c % 24) * 8); } \
    { int c = tid + 1536; w3 = *(const uint4*)(base + (c / 24) * 192 + (c % 24) * 8); } \
    { int c = tid + 2048; if (c < 2304) w4 = *(const uint4*)(base + (c / 24) * 192 + (c % 24) * 8); } }
#define WSTOREQ() { \
    { int c = tid;        *(uint4*)(WB + (c / 24) * 200 + (c % 24) * 8) = w0; } \
    { int c = tid + 512;  *(uint4*)(WB + (c / 24) * 200 + (c % 24) * 8) = w1; } \
    { int c = tid + 1024; *(uint4*)(WB + (c / 24) * 200 + (c % 24) * 8) = w2; } \
    { int c = tid + 1536; *(uint4*)(WB + (c / 24) * 200 + (c % 24) * 8) = w3; } \
    { int c = tid + 2048; if (c < 2304) *(uint4*)(WB + (c / 24) * 200 + (c % 24) * 8) = w4; } }
#define WLOADKV(HH) { const bf16_t* base = WKVT + (size_t)(HH) * 128 * 128; \
    { int c = tid;        w0 = *(const uint4*)(base + (c >> 4) * 128 + (c & 15) * 8); } \
    { int c = tid + 512;  w1 = *(const uint4*)(base + (c >> 4) * 128 + (c & 15) * 8); } \
    { int c = tid + 1024; w2 = *(const uint4*)(base + (c >> 4) * 128 + (c & 15) * 8); } \
    { int c = tid + 1536; w3 = *(const uint4*)(base + (c >> 4) * 128 + (c & 15) * 8); } }
#define WSTOREKV() { \
    { int c = tid;        *(uint4*)(WB + (c >> 4) * 136 + (c & 15) * 8) = w0; } \
    { int c = tid + 512;  *(uint4*)(WB + (c >> 4) * 136 + (c & 15) * 8) = w1; } \
    { int c = tid + 1024; *(uint4*)(WB + (c >> 4) * 136 + (c & 15) * 8) = w2; } \
    { int c = tid + 1536; *(uint4*)(WB + (c >> 4) * 136 + (c & 15) * 8) = w3; } }
  w4 = make_uint4(0u, 0u, 0u, 0u);
  __syncthreads();
  WLOADQ(0);
  {
    const bf16_t* ur = U + (size_t)(row0 + ti) * INP + 2568;
    uint4 q6[6], k4[4], r1;
#pragma unroll
    for (int i = 0; i < 6; ++i) q6[i] = *(const uint4*)(ur + part * 48 + i * 8);
#pragma unroll
    for (int i = 0; i < 4; ++i) k4[i] = *(const uint4*)(ur + 192 + part * 32 + i * 8);
    r1 = *(const uint4*)(ur + 320 + part * 8);
    float sq = 0.f, sk = 0.f, sr = 0.f;
    float qf[48], kf[32], rf[8];
#pragma unroll
    for (int i = 0; i < 6; ++i) {
      const unsigned wv[4] = {q6[i].x, q6[i].y, q6[i].z, q6[i].w};
#pragma unroll
      for (int j = 0; j < 4; ++j) { float a = __uint_as_float(wv[j] << 16), c = __uint_as_float(wv[j] & 0xffff0000u); qf[i * 8 + 2 * j] = a; qf[i * 8 + 2 * j + 1] = c; sq += a * a + c * c; }
    }
#pragma unroll
    for (int i = 0; i < 4; ++i) {
      const unsigned wv[4] = {k4[i].x, k4[i].y, k4[i].z, k4[i].w};
#pragma unroll
      for (int j = 0; j < 4; ++j) { float a = __uint_as_float(wv[j] << 16), c = __uint_as_float(wv[j] & 0xffff0000u); kf[i * 8 + 2 * j] = a; kf[i * 8 + 2 * j + 1] = c; sk += a * a + c * c; }
    }
    {
      const unsigned wv[4] = {r1.x, r1.y, r1.z, r1.w};
#pragma unroll
      for (int j = 0; j < 4; ++j) { float a = __uint_as_float(wv[j] << 16), c = __uint_as_float(wv[j] & 0xffff0000u); rf[2 * j] = a; rf[2 * j + 1] = c; sr += a * a + c * c; }
    }
    sq += dppf<0xB1>(sq); sq += dppf<0x4E>(sq);
    sk += dppf<0xB1>(sk); sk += dppf<0x4E>(sk);
    sr += dppf<0xB1>(sr); sr += dppf<0x4E>(sr);
    const float rq = rsqrtf(sq * (1.f / 192.f) + EPSF), rk = rsqrtf(sk * (1.f / 128.f) + EPSF), rr = rsqrtf(sr * (1.f / 32.f) + EPSF);
#pragma unroll
    for (int i = 0; i < 6; ++i) {
      unsigned pk[4];
#pragma unroll
      for (int j = 0; j < 4; ++j) { int c = part * 48 + i * 8 + 2 * j; pk[j] = pack2(qf[i * 8 + 2 * j] * rq * qan[c], qf[i * 8 + 2 * j + 1] * rq * qan[c + 1]); }
      *(uint4*)(AQ + ti * 200 + part * 48 + i * 8) = make_uint4(pk[0], pk[1], pk[2], pk[3]);
    }
#pragma unroll
    for (int i = 0; i < 4; ++i) {
      unsigned pk[4];
#pragma unroll
      for (int j = 0; j < 4; ++j) { int c = part * 32 + i * 8 + 2 * j; pk[j] = pack2(kf[i * 8 + 2 * j] * rk * kvan[c], kf[i * 8 + 2 * j + 1] * rk * kvan[c + 1]); }
      *(uint4*)(AKV + ti * 136 + part * 32 + i * 8) = make_uint4(pk[0], pk[1], pk[2], pk[3]);
    }
    {
      const int n = n0 + ti;
      unsigned pk[4];
#pragma unroll
      for (int j = 0; j < 4; ++j) {
        const int c = part * 8 + 2 * j, pi = c >> 1;
        float t1 = rf[2 * j] * rr * kn[64 + c], t2 = rf[2 * j + 1] * rr * kn[64 + c + 1];
        if (lat) {
          float cs = ROPE[(n * 16 + pi) * 2], sn = ROPE[(n * 16 + pi) * 2 + 1];
          float o1 = t1 * cs - t2 * sn, o2 = t1 * sn + t2 * cs;
          t1 = o1; t2 = o2;
        }
        pk[j] = pack2(t1, t2);
      }
      const uint4 kv4 = make_uint4(pk[0], pk[1], pk[2], pk[3]);
#pragma unroll
      for (int hh = 0; hh < 4; ++hh) *(uint4*)(KB + (((size_t)(b * 4 + hh)) * NKEY + key0 + ti) * 96 + 64 + part * 8) = kv4;
    }
  }
  WSTOREQ();
  __syncthreads();
  const float qscale = 0.10206207261596577f * 1.4426950408889634f;
  float qnv[6], knv[4], rcs[4][2], rsn[4][2];
#pragma unroll
  for (int nf = 0; nf < 6; ++nf) qnv[nf] = qn[nf * 16 + fr];
#pragma unroll
  for (int nf = 0; nf < 4; ++nf) knv[nf] = kn[nf * 16 + fr];
#pragma unroll
  for (int jj = 0; jj < 4; ++jj)
#pragma unroll
    for (int q2 = 0; q2 < 2; ++q2) {
      const int n = n0 + 16 * w + 4 * fq + jj, pi = (q2 * 16 + fr) >> 1;
      rcs[jj][q2] = lat ? ROPE[(n * 16 + pi) * 2] : 1.f;
      rsn[jj][q2] = lat ? ROPE[(n * 16 + pi) * 2 + 1] : 0.f;
    }
  for (int hh = 0; hh < 4; ++hh) {
    if (hh < 3) { WLOADQ(hh + 1); } else { WLOADKV(0); }
    f32x4 acc[6];
#pragma unroll
    for (int nf = 0; nf < 6; ++nf) acc[nf] = (f32x4){0.f, 0.f, 0.f, 0.f};
#pragma unroll
    for (int ks = 0; ks < 6; ++ks) {
      bf16x8 a = *(const bf16x8*)(AQ + (16 * w + fr) * 200 + ks * 32 + fq * 8);
#pragma unroll
      for (int nf = 0; nf < 6; ++nf) {
        bf16x8 bb = *(const bf16x8*)(WB + (nf * 16 + fr) * 200 + ks * 32 + fq * 8);
        acc[nf] = __builtin_amdgcn_mfma_f32_16x16x32_bf16(a, bb, acc[nf], 0, 0, 0);
      }
    }
#pragma unroll
    for (int jj = 0; jj < 4; ++jj) {
      const int rl = 16 * w + 4 * fq + jj;
      float s1 = 0.f, s2 = 0.f;
#pragma unroll
      for (int nf = 0; nf < 4; ++nf) s1 += acc[nf][jj] * acc[nf][jj];
      s2 = acc[4][jj] * acc[4][jj] + acc[5][jj] * acc[5][jj];
      s1 = sum16(s1); s2 = sum16(s2);
      const float r1 = rsqrtf(s1 * (1.f / 64.f) + EPSF) * qscale, r2 = rsqrtf(s2 * (1.f / 32.f) + EPSF) * qscale;
      bf16_t* qd = OT + rl * 104;
#pragma unroll
      for (int nf = 0; nf < 4; ++nf) qd[nf * 16 + fr] = f2bf(acc[nf][jj] * r1 * qnv[nf]);
#pragma unroll
      for (int nf = 4; nf < 6; ++nf) {
        float v = acc[nf][jj] * r2 * qnv[nf];
        float o = dppf<0xB1>(v);
        const float cs = rcs[jj][nf - 4], sn = rsn[jj][nf - 4];
        v = (fr & 1) ? (o * sn + v * cs) : (v * cs - o * sn);
        qd[64 + (nf - 4) * 16 + fr] = f2bf(v);
      }
    }
    __syncthreads();
#pragma unroll
    for (int i = 0; i < 3; ++i) {
      const int c = tid + 512 * i, r = c / 12, ch = c % 12;
      *(uint4*)(QB + ((size_t)(row0 + r) * 4 + hh) * 96 + ch * 8) = *(const uint4*)(OT + r * 104 + ch * 8);
    }
    if (hh < 3) { WSTOREQ(); } else { WSTOREKV(); }
    __syncthreads();
  }
  for (int hh = 0; hh < 4; ++hh) {
    if (hh < 3) { WLOADKV(hh + 1); }
    f32x4 acc[8];
#pragma unroll
    for (int nf = 0; nf < 8; ++nf) acc[nf] = (f32x4){0.f, 0.f, 0.f, 0.f};
#pragma unroll
    for (int ks = 0; ks < 4; ++ks) {
      bf16x8 a = *(const bf16x8*)(AKV + (16 * w + fr) * 136 + ks * 32 + fq * 8);
#pragma unroll
      for (int nf = 0; nf < 8; ++nf) {
        bf16x8 bb = *(const bf16x8*)(WB + (nf * 16 + fr) * 136 + ks * 32 + fq * 8);
        acc[nf] = __builtin_amdgcn_mfma_f32_16x16x32_bf16(a, bb, acc[nf], 0, 0, 0);
      }
    }
#pragma unroll
    for (int jj = 0; jj < 4; ++jj) {
      const int rl = 16 * w + 4 * fq + jj;
      float s1 = 0.f;
#pragma unroll
      for (int nf = 0; nf < 4; ++nf) s1 += acc[nf][jj] * acc[nf][jj];
      s1 = sum16(s1);
      const float r1 = rsqrtf(s1 * (1.f / 64.f) + EPSF);
      bf16_t* kd = OT + rl * 104;
#pragma unroll
      for (int nf = 0; nf < 4; ++nf) kd[nf * 16 + fr] = f2bf(acc[nf][jj] * r1 * knv[nf]);
    }
#pragma unroll
    for (int nf = 4; nf < 8; ++nf) {
      const int dd = (nf - 4) * 16 + fr;
      uint2 o;
      o.x = pack2(acc[nf][0], acc[nf][1]); o.y = pack2(acc[nf][2], acc[nf][3]);
      *(uint2*)(VB + (((size_t)(b * 4 + hh)) * 64 + dd) * NKEY + key0 + 32 * (w >> 1) + 8 * fq + 4 * (w & 1)) = o;
    }
    __syncthreads();
#pragma unroll
    for (int i = 0; i < 2; ++i) {
      const int c = tid + 512 * i, r = c >> 3, ch = c & 7;
      *(uint4*)(KB + (((size_t)(b * 4 + hh)) * NKEY + key0 + r) * 96 + ch * 8) = *(const uint4*)(OT + r * 104 + ch * 8);
    }
    if (hh < 3) {
      WSTOREKV();
      __syncthreads();
    }
  }
#undef WLOADQ
#undef WSTOREQ
#undef WLOADKV
#undef WSTOREKV
}

template <bool FIXC>
__device__ __forceinline__ void attn_item_fast(const Params& p, int L, int item, float negc) {
  char* sm = dynsmem;
  bf16_t* KT = (bf16_t*)sm;
  bf16_t* VT = (bf16_t*)(sm + 28672);
  int tx_ = threadIdx.x; asm volatile("" : "+v"(tx_));
  const int tid = tx_, w = tid >> 6, lane = tid & 63, fr = lane & 15, fq = lane >> 4;
  int b, h, rowq0, nkeys;
  if (item < 512) { int bh = item >> 3, qb = item & 7; b = bh >> 2; h = bh & 3; rowq0 = b * SEQ + qb * 256; nkeys = NKEY; }
  else { int bh = item - 512; b = bh >> 2; h = bh & 3; rowq0 = NLAT + b * CTXL; nkeys = CTXL; }
  const bf16_t* QB = (const bf16_t*)(p.ws + OFF_ACTB + QB_OFF);
  const bf16_t* KB = (const bf16_t*)(p.ws + OFF_ACTB + KB_OFF) + ((size_t)(b * 4 + h)) * NKEY * 96;
  const bf16_t* VB = (const bf16_t*)(p.ws + OFF_ACTB + VB_OFF) + ((size_t)(b * 4 + h)) * 64 * NKEY;
  bf16_t* Y = (bf16_t*)(p.ws + OFF_ACTA);
  bf16x8 qf[2][3];
#pragma unroll
  for (int m = 0; m < 2; ++m)
#pragma unroll
    for (int ks = 0; ks < 3; ++ks) qf[m][ks] = *(const bf16x8*)(QB + ((size_t)(rowq0 + w * 32 + m * 16 + fr) * 4 + h) * 96 + ks * 32 + fq * 8);
  f32x4 o[2][4];
  float mrow[2], lrow[2];
#pragma unroll
  for (int m = 0; m < 2; ++m) {
    mrow[m] = -1e30f; lrow[m] = 0.f;
#pragma unroll
    for (int j = 0; j < 4; ++j) o[m][j] = (f32x4){0.f, 0.f, 0.f, 0.f};
  }
  const f32x4 negc4 = (f32x4){negc, negc, negc, negc};
  uint4 pk0, pk1, pk2, pv0, pv1;
  const int kr0 = tid / 12, kp0 = tid % 12, kr1 = (tid + 512) / 12, kp1 = (tid + 512) % 12, kr2 = (tid + 1024) / 12, kp2 = (tid + 1024) % 12;
  const int vd0 = tid >> 4, vp0 = tid & 15, vd1 = (tid + 512) >> 4;
#define ATT_LOAD(K0)                                                                 \
  {                                                                                  \
    pk0 = *(const uint4*)(KB + (size_t)((K0) + kr0) * 96 + kp0 * 8);                 \
    pk1 = *(const uint4*)(KB + (size_t)((K0) + kr1) * 96 + kp1 * 8);                 \
    pk2 = *(const uint4*)(KB + (size_t)((K0) + kr2) * 96 + kp2 * 8);                 \
    pv0 = *(const uint4*)(VB + (size_t)vd0 * NKEY + (K0) + vp0 * 8);                 \
    pv1 = *(const uint4*)(VB + (size_t)vd1 * NKEY + (K0) + vp0 * 8);                 \
  }
#define ATT_STORE(BUF)                                                               \
  {                                                                                  \
    bf16_t* kt_ = KT + (BUF) * 23552; bf16_t* vt_ = VT + (BUF) * 23552;               \
    *(uint4*)(kt_ + kr0 * 112 + kp0 * 8) = pk0;                                      \
    *(uint4*)(kt_ + kr1 * 112 + kp1 * 8) = pk1;                                      \
    *(uint4*)(kt_ + kr2 * 112 + kp2 * 8) = pk2;                                      \
    *(uint4*)(vt_ + vd0 * 144 + vp0 * 8) = pv0;                                      \
    *(uint4*)(vt_ + vd1 * 144 + vp0 * 8) = pv1;                                      \
  }
  const int ntiles = nkeys >> 7;
  __syncthreads();
  ATT_LOAD(0);
  ATT_STORE(0);
  if (ntiles > 1) ATT_LOAD(128);
  for (int t = 0; t < ntiles; ++t) {
    __syncthreads();
    if (t + 1 < ntiles) {
      ATT_STORE((t + 1) & 1);
      if (t + 2 < ntiles) ATT_LOAD((t + 2) * 128);
    }
    const bf16_t* KTb = KT + (t & 1) * 23552;
    const bf16_t* VTb = VT + (t & 1) * 23552;
#pragma unroll
    for (int sub = 0; sub < 2; ++sub) {
      const bf16_t* KTs = KTb + sub * 64 * 112;
      f32x4 sacc[2][4];
#pragma unroll
      for (int m = 0; m < 2; ++m)
#pragma unroll
        for (int nf = 0; nf < 4; ++nf) sacc[m][nf] = FIXC ? negc4 : (f32x4){0.f, 0.f, 0.f, 0.f};
#pragma unroll
      for (int ks = 0; ks < 3; ++ks)
#pragma unroll
        for (int nf = 0; nf < 4; ++nf) {
          bf16x8 kb = *(const bf16x8*)(KTs + (nf * 16 + fr) * 112 + ks * 32 + fq * 8);
#pragma unroll
          for (int m = 0; m < 2; ++m) sacc[m][nf] = __builtin_amdgcn_mfma_f32_16x16x32_bf16(kb, qf[m][ks], sacc[m][nf], 0, 0, 0);
        }
      bf16x8 pb[2][2];
      if (FIXC) {
#pragma unroll
        for (int m = 0; m < 2; ++m) {
          float ps0 = 0.f, ps1 = 0.f;
          float pe[4][4];
#pragma unroll
          for (int nf = 0; nf < 4; ++nf) {
            pe[nf][0] = __builtin_amdgcn_exp2f(sacc[m][nf][0]); pe[nf][1] = __builtin_amdgcn_exp2f(sacc[m][nf][1]);
            pe[nf][2] = __builtin_amdgcn_exp2f(sacc[m][nf][2]); pe[nf][3] = __builtin_amdgcn_exp2f(sacc[m][nf][3]);
            ps0 += pe[nf][0] + pe[nf][2]; ps1 += pe[nf][1] + pe[nf][3];
          }
          lrow[m] += ps0 + ps1;
#pragma unroll
          for (int ks2 = 0; ks2 < 2; ++ks2) {
            union { bf16x8 v; unsigned u[4]; } cv;
            cv.u[0] = pack2(pe[2 * ks2][0], pe[2 * ks2][1]); cv.u[1] = pack2(pe[2 * ks2][2], pe[2 * ks2][3]);
            cv.u[2] = pack2(pe[2 * ks2 + 1][0], pe[2 * ks2 + 1][1]); cv.u[3] = pack2(pe[2 * ks2 + 1][2], pe[2 * ks2 + 1][3]);
            pb[m][ks2] = cv.v;
          }
        }
      } else
#pragma unroll
      for (int m = 0; m < 2; ++m) {
        float mx = sacc[m][0][0];
#pragma unroll
        for (int nf = 0; nf < 4; ++nf)
#pragma unroll
          for (int j = 0; j < 4; ++j) mx = fmaxf(mx, sacc[m][nf][j]);
        mx = fmaxf(mx, __shfl_xor(mx, 16)); mx = fmaxf(mx, __shfl_xor(mx, 32));
        const float mn = fmaxf(mrow[m], mx);
        const float al = __builtin_amdgcn_exp2f(mrow[m] - mn);
        mrow[m] = mn;
        float ps = 0.f;
        float pe[4][4];
#pragma unroll
        for (int nf = 0; nf < 4; ++nf)
#pragma unroll
          for (int j = 0; j < 4; ++j) { pe[nf][j] = __builtin_amdgcn_exp2f(sacc[m][nf][j] - mn); ps += pe[nf][j]; }
        lrow[m] = lrow[m] * al + ps;
#pragma unroll
        for (int nfd = 0; nfd < 4; ++nfd)
#pragma unroll
          for (int j = 0; j < 4; ++j) o[m][nfd][j] *= al;
#pragma unroll
        for (int ks2 = 0; ks2 < 2; ++ks2) {
          union { bf16x8 v; unsigned u[4]; } cv;
          cv.u[0] = pack2(pe[2 * ks2][0], pe[2 * ks2][1]); cv.u[1] = pack2(pe[2 * ks2][2], pe[2 * ks2][3]);
          cv.u[2] = pack2(pe[2 * ks2 + 1][0], pe[2 * ks2 + 1][1]); cv.u[3] = pack2(pe[2 * ks2 + 1][2], pe[2 * ks2 + 1][3]);
          pb[m][ks2] = cv.v;
        }
      }
#pragma unroll
      for (int ks2 = 0; ks2 < 2; ++ks2)
#pragma unroll
        for (int nfd = 0; nfd < 4; ++nfd) {
          const bf16x8 va = *(const bf16x8*)(VTb + (nfd * 16 + fr) * 144 + sub * 64 + ks2 * 32 + 8 * fq);
#pragma unroll
          for (int m = 0; m < 2; ++m) o[m][nfd] = __builtin_amdgcn_mfma_f32_16x16x32_bf16(va, pb[m][ks2], o[m][nfd], 0, 0, 0);
        }
    }
  }
#undef ATT_LOAD
#undef ATT_STORE
#pragma unroll
  for (int m = 0; m < 2; ++m) {
    float l = lrow[m];
    l += __shfl_xor(l, 16); l += __shfl_xor(l, 32);
    const float il = 1.f / l;
    bf16_t* yd = Y + (size_t)(rowq0 + w * 32 + m * 16 + fr) * DM + 768 + h * 64;
#pragma unroll
    for (int nfd = 0; nfd < 4; ++nfd) {
      uint2 ov;
      ov.x = pack2(o[m][nfd][0] * il, o[m][nfd][1] * il); ov.y = pack2(o[m][nfd][2] * il, o[m][nfd][3] * il);
      *(uint2*)(yd + nfd * 16 + 4 * fq) = ov;
    }
  }
}

template <int MODE>
__device__ __forceinline__ void attn_item_fixc(const Params& p, int L, int item, float negc) {
  char* sm = dynsmem;
  bf16_t* KT = (bf16_t*)sm;
  bf16_t* VT = (bf16_t*)(sm + 28672);
  int tx_ = threadIdx.x; asm volatile("" : "+v"(tx_));
  const int tid = tx_, w = tid >> 6, lane = tid & 63, fr = lane & 15, fq = lane >> 4;
  int b, h, rowq0, nkeys;
  if (item < 512) { int bh = item >> 3, qb = item & 7; b = bh >> 2; h = bh & 3; rowq0 = b * SEQ + qb * 256; nkeys = NKEY; }
  else { int bh = item - 512; b = bh >> 2; h = bh & 3; rowq0 = NLAT + b * CTXL; nkeys = CTXL; }
  const bf16_t* QB = (const bf16_t*)(p.ws + OFF_ACTB + QB_OFF);
  const bf16_t* KB = (const bf16_t*)(p.ws + OFF_ACTB + KB_OFF) + ((size_t)(b * 4 + h)) * NKEY * 96;
  const bf16_t* VB = (const bf16_t*)(p.ws + OFF_ACTB + VB_OFF) + ((size_t)(b * 4 + h)) * 64 * NKEY;
  bf16_t* Y = (bf16_t*)(p.ws + OFF_ACTA);
  bf16x8 qf[2][3];
#pragma unroll
  for (int m = 0; m < 2; ++m)
#pragma unroll
    for (int ks = 0; ks < 3; ++ks) qf[m][ks] = *(const bf16x8*)(QB + ((size_t)(rowq0 + w * 32 + m * 16 + fr) * 4 + h) * 96 + ks * 32 + fq * 8);
  f32x4 o[2][4];
  float lrow[2];
#pragma unroll
  for (int m = 0; m < 2; ++m) {
    lrow[m] = 0.f;
#pragma unroll
    for (int j = 0; j < 4; ++j) o[m][j] = (f32x4){0.f, 0.f, 0.f, 0.f};
  }
  const f32x4 negc4 = (f32x4){negc, negc, negc, negc};
  uint4 pk0, pk1, pk2, pv0, pv1;
  const int kr0 = tid / 12, kp0 = tid % 12, kr1 = (tid + 512) / 12, kp1 = (tid + 512) % 12, kr2 = (tid + 1024) / 12, kp2 = (tid + 1024) % 12;
  const int vd0 = tid >> 4, vp0 = tid & 15, vd1 = (tid + 512) >> 4;
#define ATT_LOAD(K0)                                                                 \
  {                                                                                  \
    pk0 = *(const uint4*)(KB + (size_t)((K0) + kr0) * 96 + kp0 * 8);                 \
    pk1 = *(const uint4*)(KB + (size_t)((K0) + kr1) * 96 + kp1 * 8);                 \
    pk2 = *(const uint4*)(KB + (size_t)((K0) + kr2) * 96 + kp2 * 8);                 \
    pv0 = *(const uint4*)(VB + (size_t)vd0 * NKEY + (K0) + vp0 * 8);                 \
    pv1 = *(const uint4*)(VB + (size_t)vd1 * NKEY + (K0) + vp0 * 8);                 \
  }
#define ATT_STORE(BUF)                                                               \
  {                                                                                  \
    bf16_t* kt_ = KT + (BUF) * 23552; bf16_t* vt_ = VT + (BUF) * 23552;               \
    *(uint4*)(kt_ + kr0 * 112 + kp0 * 8) = pk0;                                      \
    *(uint4*)(kt_ + kr1 * 112 + kp1 * 8) = pk1;                                      \
    *(uint4*)(kt_ + kr2 * 112 + kp2 * 8) = pk2;                                      \
    *(uint4*)(vt_ + vd0 * 144 + vp0 * 8) = pv0;                                      \
    *(uint4*)(vt_ + vd1 * 144 + vp0 * 8) = pv1;                                      \
  }
#define ATT_SB() __builtin_amdgcn_sched_barrier(0)
#define ATT_LDK(F, KTB, SUB, KS) { _Pragma("unroll") for (int nf = 0; nf < 4; ++nf) F[nf] = *(const bf16x8*)((KTB) + ((SUB) * 64 + nf * 16 + fr) * 112 + (KS) * 32 + fq * 8); }
#define ATT_LDV(F, VTB, SUB, KS2) { _Pragma("unroll") for (int nfd = 0; nfd < 4; ++nfd) F[nfd] = *(const bf16x8*)((VTB) + (nfd * 16 + fr) * 144 + (SUB) * 64 + (KS2) * 32 + 8 * fq); }
#define ATT_MMK(F, KS, INIT) { _Pragma("unroll") for (int nf = 0; nf < 4; ++nf) _Pragma("unroll") for (int m = 0; m < 2; ++m) \
    sacc[m][nf] = __builtin_amdgcn_mfma_f32_16x16x32_bf16(F[nf], qf[m][KS], (INIT) ? negc4 : sacc[m][nf], 0, 0, 0); }
#define ATT_MMV(F, KS2) { _Pragma("unroll") for (int nfd = 0; nfd < 4; ++nfd) _Pragma("unroll") for (int m = 0; m < 2; ++m) \
    o[m][nfd] = __builtin_amdgcn_mfma_f32_16x16x32_bf16(F[nfd], pb[m][KS2], o[m][nfd], 0, 0, 0); }
#define ATT_SOFTMAX() { _Pragma("unroll") for (int m = 0; m < 2; ++m) {                                                   \
      float ps0 = 0.f, ps1 = 0.f; float pe[4][4];                                                                         \
      _Pragma("unroll") for (int nf = 0; nf < 4; ++nf) {                                                                  \
        if (MODE == 1) { pe[nf][0] = sacc[m][nf][0]; pe[nf][1] = sacc[m][nf][1]; pe[nf][2] = sacc[m][nf][2]; pe[nf][3] = sacc[m][nf][3]; ps0 += pe[nf][0]; } else { \
        pe[nf][0] = __builtin_amdgcn_exp2f(sacc[m][nf][0]); pe[nf][1] = __builtin_amdgcn_exp2f(sacc[m][nf][1]);           \
        pe[nf][2] = __builtin_amdgcn_exp2f(sacc[m][nf][2]); pe[nf][3] = __builtin_amdgcn_exp2f(sacc[m][nf][3]);           \
        ps0 += pe[nf][0] + pe[nf][2]; ps1 += pe[nf][1] + pe[nf][3]; } }                                                   \
      lrow[m] += ps0 + ps1;                                                                                               \
      _Pragma("unroll") for (int ks2 = 0; ks2 < 2; ++ks2) {                                                               \
        union { bf16x8 v; unsigned u[4]; } cv;                                                                            \
        cv.u[0] = pack2(pe[2 * ks2][0], pe[2 * ks2][1]); cv.u[1] = pack2(pe[2 * ks2][2], pe[2 * ks2][3]);                 \
        cv.u[2] = pack2(pe[2 * ks2 + 1][0], pe[2 * ks2 + 1][1]); cv.u[3] = pack2(pe[2 * ks2 + 1][2], pe[2 * ks2 + 1][3]); \
        pb[m][ks2] = cv.v; } } }
#define ATT_SUB(X, Y, SUB, NEXT)                                                     \
  {                                                                                  \
    f32x4 sacc[2][4]; bf16x8 pb[2][2];                                               \
    ATT_MMK(X, 0, true);  ATT_SB(); ATT_LDK(X, KTb, SUB, 2);  ATT_SB();              \
    ATT_MMK(Y, 1, false); ATT_SB(); ATT_LDV(Y, VTb, SUB, 0);  ATT_SB();              \
    ATT_MMK(X, 2, false); ATT_SB(); ATT_LDV(X, VTb, SUB, 1);  ATT_SB();              \
    ATT_SOFTMAX();        ATT_SB();                                                  \
    ATT_MMV(Y, 0);        ATT_SB(); if (NEXT) { ATT_LDK(Y, KTb, (SUB) + 1, 0); } ATT_SB(); \
    ATT_MMV(X, 1);        ATT_SB(); if (NEXT) { ATT_LDK(X, KTb, (SUB) + 1, 1); } ATT_SB(); \
  }
  const int ntiles = nkeys >> 7;
  __syncthreads();
  ATT_LOAD(0);
  ATT_STORE(0);
  if (ntiles > 1) ATT_LOAD(128);
  bf16x8 fa[4], fb[4];
  for (int t = 0; t < ntiles; ++t) {
    __syncthreads();
    if (t + 1 < ntiles) {
      ATT_STORE((t + 1) & 1);
      if (t + 2 < ntiles) ATT_LOAD((t + 2) * 128);
    }
    const bf16_t* KTb = KT + (t & 1) * 23552;
    const bf16_t* VTb = VT + (t & 1) * 23552;
    ATT_SB();
    ATT_LDK(fa, KTb, 0, 0); ATT_LDK(fb, KTb, 0, 1);
    ATT_SB();
    ATT_SUB(fa, fb, 0, true);
    ATT_SUB(fb, fa, 1, false);
  }
#undef ATT_LOAD
#undef ATT_STORE
#undef ATT_SB
#undef ATT_LDK
#undef ATT_LDV
#undef ATT_MMK
#undef ATT_MMV
#undef ATT_SOFTMAX
#undef ATT_SUB
#pragma unroll
  for (int m = 0; m < 2; ++m) {
    float l = lrow[m];
    l += __shfl_xor(l, 16); l += __shfl_xor(l, 32);
    const float il = 1.f / l;
    bf16_t* yd = Y + (size_t)(rowq0 + w * 32 + m * 16 + fr) * DM + 768 + h * 64;
#pragma unroll
    for (int nfd = 0; nfd < 4; ++nfd) {
      uint2 ov;
      ov.x = pack2(o[m][nfd][0] * il, o[m][nfd][1] * il); ov.y = pack2(o[m][nfd][2] * il, o[m][nfd][3] * il);
      if (MODE == 0 || negc < -1000.f) *(uint2*)(yd + nfd * 16 + 4 * fq) = ov;
    }
  }
}

__device__ __forceinline__ void phase_mix(const Params& p, int L, int bid, int nb) {
  volatile int* s_itemp = (volatile int*)(dynsmem + 2 * GROUP_LDS);
  int* cnt = (int*)(p.ws + OFF_CNT) + L;
  unsigned* done = (unsigned*)(p.ws + OFF_CNT) + 8 + L * 16;
  const int per = (L == 0) ? 36 : 32;
  const int total = 480 + NB * per;
  float cb;
  {
    const float* qn = p.in[I_MQN] + L * 96;
    const float* kn = p.in[I_MKN] + L * 96;
    const int ln = otid() & 63;
    float a = qn[ln], r = qn[64 + (ln & 31)], c = kn[ln], d = kn[64 + (ln & 31)];
    a *= a; r *= r; c *= c; d *= d;
#pragma unroll
    for (int o = 1; o < 64; o <<= 1) { a = fmaxf(a, __shfl_xor(a, o)); r = fmaxf(r, __shfl_xor(r, o)); c = fmaxf(c, __shfl_xor(c, o)); d = fmaxf(d, __shfl_xor(d, o)); }
    cb = 0.10206207261596577f * 1.4426950408889634f * 1.01f * sqrtf((64.f * a + 32.f * r) * (64.f * c + 32.f * d));
    cb = __int_as_float(__builtin_amdgcn_readfirstlane(__float_as_int(cb)));
  }
  for (;;) {
    __syncthreads();
    if (threadIdx.x == 0) *s_itemp = atomicAdd(cnt, 1);
    __syncthreads();
    const int it = *s_itemp;
    if (it >= total) break;
    if (it < 64) chain_hgrn_fast(p, L, it);
    else if (it < 128) chain_ssd_fast(p, L, it - 64);
    else if (it < 192) chain_lru_fast(p, L, it - 128);
    else if (it < 480) {
      const int j = it - 192, b = j / 18, r = j % 18;
      const int item = r < 2 ? (256 + b * 2 + r) : (b * 16 + r - 2);
      mlaproj_item_fast(p, L, item);
      asm volatile("s_waitcnt vmcnt(0)" ::: "memory");
      __syncthreads();
      if (threadIdx.x == 0) {
        __builtin_amdgcn_fence(__ATOMIC_RELEASE, "agent");
        asm volatile("s_waitcnt vmcnt(0)" ::: "memory");
        (void)xb_add(&done[b], 1u);
      }
    } else {
      const int a = it - 480, b = a / per, r = a % per;
      const int item = r < 32 ? (b * 32 + r) : (512 + b * 4 + (r - 32));
      if (threadIdx.x == 0) {
        unsigned sp = 0;
        while (xb_ld(&done[b]) < 18u) { __builtin_amdgcn_s_sleep(2); if (++sp > (1u << 22)) break; }
        __builtin_amdgcn_fence(__ATOMIC_ACQUIRE, "agent");
        asm volatile("s_waitcnt vmcnt(0)" ::: "memory");
      }
      __syncthreads();
      if (cb <= 40.f) attn_item_fixc<0>(p, L, item, -cb);
      else attn_item_fast<false>(p, L, item, 0.f);
    }
#if DIAG
    if (L == 0 && threadIdx.x == 0) {
      const int ty = it < 64 ? 0 : (it < 128 ? 1 : (it < 192 ? 2 : (it < 480 ? 3 : 4)));
      atomicMax((unsigned long long*)(p.ws + OFF_TS) + 24 + ty, (unsigned long long)wall_clock64());
    }
#endif
  }
}

__device__ __forceinline__ void phase_ssdnorm(const Params& p, int L, int bid, int nb) {
  const int tx0_ = otid();
  const int wave = tx0_ >> 6, lane = tx0_ & 63;
  bf16_t* Y = (bf16_t*)(p.ws + OFF_ACTA);
  const float* nw = p.in[I_SNW] + L * 256;
  const int nrows = (L == 0) ? NTOK : NLAT;
  for (int row = bid * 8 + wave; row < nrows; row += nb * 8) {
    uint2* yp = (uint2*)(Y + (size_t)row * DM + 512) + lane;
    uint2 v = *yp;
    float a0 = __uint_as_float(v.x << 16), a1 = __uint_as_float(v.x & 0xffff0000u), a2 = __uint_as_float(v.y << 16), a3 = __uint_as_float(v.y & 0xffff0000u);
    float ss = wave_sum(a0 * a0 + a1 * a1 + a2 * a2 + a3 * a3);
    float rn = rsqrtf(ss * (1.f / 256.f) + EPSF);
    float4 w = ((const float4*)nw)[lane];
    uint2 o;
    o.x = pack2(a0 * rn * w.x, a1 * rn * w.y);
    o.y = pack2(a2 * rn * w.z, a3 * rn * w.w);
    *yp = o;
  }
}

__device__ __forceinline__ void phase_topk(const Params& p, int L, int bid, int nb) {
  unsigned* hist = (unsigned*)dynsmem;
  unsigned* wsum = hist + 256;
  volatile unsigned* sel = wsum + 16;
  const int tid = otid();
  const int wave = tid >> 6, lane = tid & 63;
  const float* aff = (const float*)(p.ws + OFF_AFF);
  int* ROWL = (int*)(p.ws + OFF_ROWL);
  int* SEL = (int*)(p.ws + OFF_SEL);
  float* GSEL = (float*)(p.ws + OFF_GSEL);
  const int nitems = (L == 0) ? 512 : 256;
  for (int it = bid; it < nitems; it += nb) {
    const bool lat = it < 256;
    const int be = lat ? it : it - 256;
    const int b = be >> 4, e = be & 15;
    const int n = lat ? SEQ : CTXL, cap = lat ? CAPL : CAPC;
    const float* src = lat ? aff + (size_t)be * SEQ : aff + (size_t)NB * NEXP * SEQ + (size_t)be * CTXL;
    float av[4]; unsigned kv[4];
    const bool act = 4 * tid < n;
    if (act) {
      const float4 a4 = *(const float4*)(src + 4 * tid);
      av[0] = a4.x; av[1] = a4.y; av[2] = a4.z; av[3] = a4.w;
#pragma unroll
      for (int q = 0; q < 4; ++q) kv[q] = __float_as_uint(av[q]);
    } else {
#pragma unroll
      for (int q = 0; q < 4; ++q) { av[q] = 0.f; kv[q] = 0u; }
    }
    unsigned prefix = 0u, need = (unsigned)cap;
#pragma unroll 1
    for (int pass = 0; pass < 4; ++pass) {
      const int shift = 24 - 8 * pass;
      __syncthreads();
      if (tid < 256) hist[tid] = 0u;
      __syncthreads();
      if (act) {
#pragma unroll
        for (int q = 0; q < 4; ++q)
          if (pass == 0 || (kv[q] >> (shift + 8)) == prefix) atomicAdd(&hist[(kv[q] >> shift) & 255u], 1u);
      }
      __syncthreads();
      if (wave == 0) {
        const unsigned h0 = hist[4 * lane], h1 = hist[4 * lane + 1], h2 = hist[4 * lane + 2], h3 = hist[4 * lane + 3];
        const unsigned tl = h0 + h1 + h2 + h3;
        unsigned v = tl;
#pragma unroll
        for (int o = 1; o < 64; o <<= 1) { unsigned t2 = __shfl_down(v, o); if (lane + o < 64) v += t2; }
        unsigned run = v - tl;
        if (run < need && run + h3 >= need) { sel[0] = 4 * lane + 3; sel[1] = need - run; } run += h3;
        if (run < need && run + h2 >= need) { sel[0] = 4 * lane + 2; sel[1] = need - run; } run += h2;
        if (run < need && run + h1 >= need) { sel[0] = 4 * lane + 1; sel[1] = need - run; } run += h1;
        if (run < need && run + h0 >= need) { sel[0] = 4 * lane + 0; sel[1] = need - run; }
      }
      __syncthreads();
      prefix = (prefix << 8) | sel[0];
      need = sel[1];
    }
    int ceq = 0, cgt = 0;
#pragma unroll
    for (int q = 0; q < 4; ++q) { ceq += (act && kv[q] == prefix) ? 1 : 0; cgt += (act && kv[q] > prefix) ? 1 : 0; }
    int ieq = ceq;
#pragma unroll
    for (int o = 1; o < 64; o <<= 1) { int t2 = __shfl_up(ieq, o); if (lane >= o) ieq += t2; }
    if (lane == 63) wsum[wave] = (unsigned)ieq;
    __syncthreads();
    int eqbase = ieq - ceq;
    for (int w2 = 0; w2 < wave; ++w2) eqbase += (int)wsum[w2];
    bool take[4];
    int c = 0;
#pragma unroll
    for (int q = 0; q < 4; ++q) {
      bool t = act && kv[q] > prefix;
      if (act && kv[q] == prefix) { t = (unsigned)eqbase < need; ++eqbase; }
      take[q] = t; c += t ? 1 : 0;
    }
    int incl = c;
#pragma unroll
    for (int o = 1; o < 64; o <<= 1) { int t2 = __shfl_up(incl, o); if (lane >= o) incl += t2; }
    if (lane == 63) wsum[8 + wave] = (unsigned)incl;
    __syncthreads();
    int base = incl - c;
    for (int w2 = 0; w2 < wave; ++w2) base += (int)wsum[8 + w2];
    if (act) {
#pragma unroll
      for (int q = 0; q < 4; ++q) {
        const int i = 4 * tid + q;
        const int row = lat ? (b * SEQ + i) : (NLAT + b * CTXL + i);
        int slot = -1;
        if (take[q]) {
          slot = lat ? (e * SLOTS + b * CAPL + base) : (e * SLOTS + SLOTS_L + b * CAPC + base);
          ROWL[slot] = row;
          ++base;
        }
        SEL[(size_t)row * 16 + e] = slot;
        GSEL[(size_t)row * 16 + e] = av[q];
      }
    }
    __syncthreads();
  }
}

#define XB_TMO      128
#define XB_XCNT(j)  (256  + 64 * (j))
#define XB_XSUB(j)  (1280 + 64 * (j))
#define XB_XGEN(j)  (2304 + 64 * (j))
#define XB_TOP      3328
#define XB_TOPGEN   3392
#define XB_SPIN_CAP (1u << 20)
#define XLAS __attribute__((address_space(3)))
__device__ __forceinline__ unsigned xb_xcc_id() { return (unsigned)__builtin_amdgcn_s_getreg((3 << 11) | 20) & 0xFu; }
#define XB_SPIN(cond, bar) do { unsigned _sp = 0; while (cond) { __builtin_amdgcn_s_sleep(1); \
    if ((++_sp & 255u) == 0u) { if (xb_ld(&(bar)[XB_TMO])) break; if (_sp > XB_SPIN_CAP) { atomicAdd(&(bar)[XB_TMO], 1u); break; } } } } while (0)
struct XcdBarrier { unsigned* bar; unsigned x; volatile XLAS unsigned* st; };
__device__ __forceinline__ XcdBarrier xcd_barrier_post(unsigned* bar, volatile XLAS unsigned* st) {
  XcdBarrier b; b.bar = bar; b.x = xb_xcc_id(); b.st = st;
  if (threadIdx.x == 0) (void)xb_add(&bar[XB_XCNT(b.x)], 1u);
  return b;
}
__device__ __forceinline__ void xcd_barrier_complete(unsigned* bar, unsigned x, unsigned& nloc, unsigned& nx) {
  const unsigned G = gridDim.x * gridDim.y * gridDim.z;
  unsigned sum, cnt, mine, sp = 0u;
  for (;;) {
    sum = 0u; cnt = 0u; mine = 0u;
#pragma unroll
    for (unsigned j = 0; j < 16; ++j) { const unsigned c = xb_ld(&bar[XB_XCNT(j)]); sum += c; cnt += (c > 0u) ? 1u : 0u; mine = (j == x) ? c : mine; }
    if (sum == G) break;
    __builtin_amdgcn_s_sleep(1);
    if ((++sp & 255u) == 0u) { if (xb_ld(&bar[XB_TMO])) break; if (sp > XB_SPIN_CAP) { atomicAdd(&bar[XB_TMO], 1u); break; } }
  }
  nloc = mine > 0u ? mine : 1u; nx = cnt > 0u ? cnt : 1u;
}
__device__ __forceinline__ void xcd_barrier(const XcdBarrier& b) {
  asm volatile("s_waitcnt vmcnt(0)" ::: "memory");
  __syncthreads();
  if (threadIdx.x == 0) {
    unsigned* bar = b.bar;
    __builtin_amdgcn_s_waitcnt(0);
    unsigned nloc = b.st[0], nx = b.st[1];
    if (nloc == 0u) { xcd_barrier_complete(bar, b.x, nloc, nx); b.st[0] = nloc; b.st[1] = nx; }
    const unsigned old = xb_add(&bar[XB_XSUB(b.x)], 1u);
    const unsigned gen = old / nloc;
    if (old + 1u == (gen + 1u) * nloc) {
      __builtin_amdgcn_fence(__ATOMIC_RELEASE, "agent");
      asm volatile("s_waitcnt vmcnt(0)" ::: "memory");
      const unsigned og = xb_add(&bar[XB_TOP], 1u);
      const unsigned tg = og / nx;
      if (og + 1u == (tg + 1u) * nx) xb_add(&bar[XB_TOPGEN], 1u);
      else XB_SPIN(xb_ld(&bar[XB_TOPGEN]) == tg, bar);
      __builtin_amdgcn_fence(__ATOMIC_ACQUIRE, "agent");
      xb_add(&bar[XB_XGEN(b.x)], 1u);
      asm volatile("s_waitcnt vmcnt(0)" ::: "memory");
    } else {
      XB_SPIN(xb_ld(&bar[XB_XGEN(b.x)]) == gen, bar);
      __builtin_amdgcn_fence(__ATOMIC_ACQUIRE, "agent");
      asm volatile("s_waitcnt vmcnt(0)" ::: "memory");
    }
  }
  __syncthreads();
}

enum { PH_PREP = 0, PH_NORM1, PH_INPROJ, PH_MLAPROJ, PH_MIX, PH_SSDNORM, PH_OUTPROJ, PH_NORM2, PH_TOPK, PH_MOE1, PH_MOE2, PH_FINAL };

__device__ __forceinline__ void run_phase(const Params& p, int ph, int L, int bid, int nb) {
  switch (ph) {
    case PH_PREP: phase_prep_a(p, bid, nb); break;
    case PH_NORM1: phase_norm1x2(p, L, 0, L == 0 ? 0 : 1, L == 0 ? -1 : 0, NTOK, bid, nb); break;
    case PH_INPROJ: phase_inproj(p, L, bid, nb); break;
    case PH_MLAPROJ: break;
    case PH_MIX: phase_mix(p, L, bid, nb); break;
    case PH_SSDNORM: phase_ssdnorm(p, L, bid, nb); break;
    case PH_OUTPROJ: phase_outproj(p, L, bid, nb); break;
    case PH_NORM2: phase_norm2(p, L, L == 0 ? 1 : 2, L == 0 ? NTOK : NLAT, bid, nb); break;
    case PH_TOPK: phase_topk(p, L, bid, nb); break;
    case PH_MOE1: phase_moe1(p, L, bid, nb); break;
    case PH_MOE2: phase_moe2(p, L, bid, nb); break;
    case PH_FINAL: phase_norm1x2(p, 1, 2, 2, 1, NLAT, bid, nb); break;
  }
}

#if !MEGA
template <int PH>
__global__ void __launch_bounds__(NT, 2) k_phase(Params p, int L) {
  run_phase(p, PH, L, blockIdx.x, gridDim.x);
}
#else
__global__ void __launch_bounds__(NT, 2) k_mega(Params p) {
  cg::grid_group grid = cg::this_grid();
  const int bid = blockIdx.x, nb = gridDim.x;
#if DIAG
  unsigned long long* TSP = (unsigned long long*)(p.ws + OFF_TS);
  int tsi = 0;
#define STAMP() do { if (bid == 0 && threadIdx.x == 0) TSP[tsi] = wall_clock64(); ++tsi; } while (0)
#else
#define STAMP() do {} while (0)
#endif
  volatile XLAS unsigned* xst = (volatile XLAS unsigned*)(dynsmem + XB_LDS_OFF);
  if (threadIdx.x == 0) { xst[0] = 0u; xst[1] = 0u; }
  __syncthreads();
  const XcdBarrier xb = xcd_barrier_post((unsigned*)(p.ws + OFF_BAR), xst);
  STAMP();
  phase_prep_a(p, bid, nb);
  if (p.ws == nullptr) grid.sync();
  xcd_barrier(xb);
  STAMP();
  phase_prep_b(p, bid, nb);
#define RP(PH, L) run_phase(p, PH, L, bid, nb); xcd_barrier(xb); STAMP();
  RP(PH_NORM1, 0) RP(PH_INPROJ, 0) RP(PH_MIX, 0)
#if PROBE_ATT
  { for (int a = bid; a < 512; a += nb) { __syncthreads(); attn_item_fixc<PROBE_ATT - 1>(p, 0, a, -15.f); } } xcd_barrier(xb);
#endif
  RP(PH_OUTPROJ, 0) RP(PH_NORM2, 0) RP(PH_TOPK, 0) RP(PH_MOE1, 0) RP(PH_MOE2, 0)
  RP(PH_NORM1, 1) RP(PH_INPROJ, 1) RP(PH_MIX, 1) RP(PH_OUTPROJ, 1) RP(PH_NORM2, 1) RP(PH_TOPK, 1) RP(PH_MOE1, 1) RP(PH_MOE2, 1)
#if DIAG
  if (bid == 0 && threadIdx.x == 0) {
    const double tot = (double)(TSP[19] - TSP[0]);
    double sa = 0, sb = 0;
    for (int i = 0; i < 19; ++i) {
      const double dtv = (double)(TSP[i + 1] - TSP[i]);
      if ((DIAG_MASK_A >> i) & 1) sa += dtv;
      if ((DIAG_MASK_B >> i) & 1) sb += dtv;
    }
    float* dg = (float*)(p.ws + OFF_TS + 256);
    dg[0] = 0.05f + 0.45f * floorf(64.f * (float)(sa / tot) + 0.5f) / 64.f;
    dg[1] = 100.f + 900.f * floorf(64.f * (float)(sb / tot) + 0.5f) / 64.f;
    if (DIAG == 2) { dg[0] = 0.05f + 0.45f * (float)(tot / 1.0e6); }
    if (DIAG >= 3) {
      const double ms = (double)TSP[3], me = (double)TSP[4];
      const int ia = (DIAG == 3) ? 0 : (DIAG == 4 ? 2 : 4), ib = (DIAG == 3) ? 1 : (DIAG == 4 ? 3 : 4);
      dg[0] = 0.05f + 0.45f * floorf(24.f * (float)(((double)TSP[24 + ia] - ms) / (me - ms)) + 0.5f) / 24.f;
      dg[1] = 100.f + 900.f * floorf(24.f * (float)(((double)TSP[24 + ib] - ms) / (me - ms)) + 0.5f) / 24.f;
      if (DIAG == 5) dg[1] = 100.f + 900.f * floorf(20.f * (float)((me - ms) / 1.0e5) + 0.5f) / 20.f;
    }
  }
  __threadfence();
  grid.sync();
#endif
  run_phase(p, PH_FINAL, 1, bid, nb);
}
#endif

extern "C" void kernel_launch(void* const* d_in, const int* in_sizes, int n_in, void* d_out, int out_size, void* d_ws, size_t ws_size, hipStream_t stream) {
  Params p{};
  for (int i = 0; i < N_IN; ++i) p.in[i] = (const float*)d_in[i];
  p.out = (float*)d_out;
  p.ws = (char*)d_ws;
  if (n_in != N_IN || ws_size < WS_END) { fprintf(stderr, "kernel_launch: bad args n_in=%d ws=%zu need %zu\n", n_in, ws_size, (size_t)WS_END); return; }
#if MEGA
  static int grid = 0;
  if (!grid) {
    int dev = 0, cus = 0, per_cu = 0;
    (void)hipGetDevice(&dev);
    (void)hipDeviceGetAttribute(&cus, hipDeviceAttributeMultiprocessorCount, dev);
    (void)hipFuncSetAttribute((const void*)k_mega, hipFuncAttributeMaxDynamicSharedMemorySize, DYN_LDS);
    (void)hipOccupancyMaxActiveBlocksPerMultiprocessor(&per_cu, (const void*)k_mega, NT, DYN_LDS);
    if (per_cu > 1) per_cu = 1;
    if (per_cu < 1) per_cu = 1;
    grid = cus * per_cu;
  }
  (void)hipMemsetAsync((char*)d_ws + OFF_BAR, 0, SZ_BAR, stream);
  void* args[] = {&p};
  hipError_t e = hipLaunchCooperativeKernel((const void*)k_mega, dim3(grid), dim3(NT), args, DYN_LDS, stream);
  if (e != hipSuccess) fprintf(stderr, "cooperative launch failed: %s (grid %d)\n", hipGetErrorString(e), grid);
#else
  const int G = 256;
  static bool attr = false;
#define SETATTR(PH) (void)hipFuncSetAttribute((const void*)k_phase<PH>, hipFuncAttributeMaxDynamicSharedMemorySize, DYN_LDS)
  if (!attr) { SETATTR(PH_PREP); SETATTR(PH_NORM1); SETATTR(PH_INPROJ); SETATTR(PH_MLAPROJ); SETATTR(PH_MIX); SETATTR(PH_SSDNORM); SETATTR(PH_OUTPROJ);
               SETATTR(PH_NORM2); SETATTR(PH_TOPK); SETATTR(PH_MOE1); SETATTR(PH_MOE2); SETATTR(PH_FINAL); attr = true; }
#define LAUNCH(PH, L) k_phase<PH><<<G, NT, DYN_LDS, stream>>>(p, L)
  LAUNCH(PH_PREP, 0);
  for (int L = 0; L < 2; ++L) {
    LAUNCH(PH_NORM1, L); LAUNCH(PH_INPROJ, L); LAUNCH(PH_MLAPROJ, L); LAUNCH(PH_MIX, L); LAUNCH(PH_SSDNORM, L);
    LAUNCH(PH_OUTPROJ, L); LAUNCH(PH_NORM2, L); LAUNCH(PH_TOPK, L); LAUNCH(PH_MOE1, L); LAUNCH(PH_MOE2, L);
  }
  LAUNCH(PH_FINAL, 1);
#endif
}
```

```cpp
#include <hip/hip_runtime.h>
#include <hip/hip_cooperative_groups.h>
#include <cstdio>
#include <cstdint>
namespace cg = cooperative_groups;

#ifndef MEGA
#define MEGA 1
#endif
#ifndef DIAG
#define DIAG 0
#define PROBE_ATT 0
#endif
#ifndef DIAG_MASK_A
#define DIAG_MASK_A 0
#endif
#ifndef DIAG_MASK_B
#define DIAG_MASK_B 0
#endif

typedef unsigned short bf16_t;
typedef short bf16x8 __attribute__((ext_vector_type(8)));
typedef float f32x4 __attribute__((ext_vector_type(4)));

#define NT 512
#define NB 16
#define SEQ 2048
#define CTXL 256
#define DM 1024
#define NLAT (NB * SEQ)
#define NCTX (NB * CTXL)
#define NTOK (NLAT + NCTX)
#define INC 2920
#define INP 3072
#define NEXP 16
#define FF 512
#define CAPL 256
#define CAPC 32
#define SLOTS_L (NB * CAPL)
#define SLOTS_C (NB * CAPC)
#define SLOTS (SLOTS_L + SLOTS_C)
#define NKEY (CTXL + SEQ)
#define EPSF 1e-6f

enum { I_X = 0, I_C, I_CTX, I_CCTX, I_ADAW, I_ADAB, I_N1W, I_N2W, I_WIN, I_WOUT, I_LCW, I_LCB, I_LWR, I_LBR, I_LWI, I_LBI, I_LLAM,
       I_HLB, I_HNW, I_SCW, I_SCB, I_SALOG, I_SDTB, I_SDSK, I_SNW, I_MQAN, I_MWQ, I_MKVAN, I_MWKV, I_MQN, I_MKN, I_ROUT, I_WG, I_WU, I_WD, N_IN };

struct Params {
  const float* in[N_IN];
  float* out;
  char* ws;
};

constexpr size_t OFF_MOD = 0;
constexpr size_t SZ_MOD = (size_t)2 * 17 * 6144 * 4;
constexpr size_t OFF_WINT = OFF_MOD + SZ_MOD;
constexpr size_t SZ_WINT = (size_t)2 * INP * DM * 2;
constexpr size_t OFF_WOUTT = OFF_WINT + SZ_WINT;
constexpr size_t SZ_WOUTT = (size_t)2 * DM * DM * 2;
constexpr size_t OFF_WGU = OFF_WOUTT + SZ_WOUTT;
constexpr size_t SZ_WGU = (size_t)2 * NEXP * 1024 * DM * 2;
constexpr size_t OFF_WDT = OFF_WGU + SZ_WGU;
constexpr size_t SZ_WDT = (size_t)2 * NEXP * DM * FF * 2;
constexpr size_t OFF_CTXS = OFF_WDT + SZ_WDT;
constexpr size_t SZ_CTXS = (size_t)NCTX * DM * 4;
constexpr size_t OFF_ACTA = OFF_CTXS + SZ_CTXS;
constexpr size_t SZ_ACT = (size_t)NTOK * DM * 2;
constexpr size_t OFF_ACTB = OFF_ACTA + SZ_ACT;
constexpr size_t OFF_U = OFF_ACTB + SZ_ACT;
constexpr size_t SZ_U = (size_t)NTOK * INP * 2;
constexpr size_t OFF_AFF = OFF_U + SZ_U;
constexpr size_t SZ_AFF = (size_t)(NB * NEXP * SEQ + NB * NEXP * CTXL) * 4;
constexpr size_t OFF_ROWL = OFF_AFF + SZ_AFF;
constexpr size_t SZ_ROWL = (size_t)NEXP * SLOTS * 4;
constexpr size_t OFF_SEL = OFF_ROWL + SZ_ROWL;
constexpr size_t SZ_SEL = (size_t)NTOK * 16 * 4;
constexpr size_t OFF_GSEL = OFF_SEL + SZ_SEL;
constexpr size_t OFF_WQT = OFF_GSEL + SZ_SEL;
constexpr size_t SZ_WQT = (size_t)2 * 384 * 192 * 2;
constexpr size_t OFF_WKVT = OFF_WQT + SZ_WQT;
constexpr size_t SZ_WKVT = (size_t)2 * 512 * 128 * 2;
constexpr size_t OFF_LRUW = OFF_WKVT + SZ_WKVT;
constexpr size_t SZ_LRUW = (size_t)2 * 2 * 2 * 4 * 4096 * 2;
constexpr size_t OFF_ROPE = OFF_LRUW + SZ_LRUW;
constexpr size_t SZ_ROPE = (size_t)SEQ * 16 * 2 * 4;
constexpr size_t OFF_CNT = OFF_ROPE + SZ_ROPE;
constexpr size_t OFF_TS = OFF_CNT + 256;
constexpr size_t OFF_PSSQ = OFF_TS + 512;
constexpr size_t SZ_PSSQ = (size_t)NTOK * 4 * 4;
constexpr size_t OFF_BAR = OFF_PSSQ + SZ_PSSQ;
constexpr size_t SZ_BAR = 3456 * 4;
constexpr size_t WS_END = OFF_BAR + SZ_BAR;

constexpr size_t QB_OFF = 0;
constexpr size_t KB_OFF = (size_t)NTOK * 384 * 2;
constexpr size_t VB_OFF = KB_OFF + (size_t)NB * 4 * NKEY * 96 * 2;

extern __shared__ __attribute__((aligned(16))) char dynsmem[];
#define GROUP_LDS 77824
#define DYN_LDS (2 * GROUP_LDS + 256)
#define XB_LDS_OFF (2 * GROUP_LDS + 64)
#define TS 72

__device__ __forceinline__ bf16_t f2bf(float f) {
  unsigned u = __float_as_uint(f);
  u += 0x7fffu + ((u >> 16) & 1u);
  return (bf16_t)(u >> 16);
}
__device__ __forceinline__ float bf2f(bf16_t h) { return __uint_as_float(((unsigned)h) << 16); }
__device__ __forceinline__ unsigned pack2(float a, float b) { unsigned r; asm("v_cvt_pk_bf16_f32 %0, %1, %2" : "=v"(r) : "v"(a), "v"(b)); return r; }
__device__ __forceinline__ float fexp(float x) { return __builtin_amdgcn_exp2f(x * 1.4426950408889634f); }
__device__ __forceinline__ float fexp2(float x) { return __builtin_amdgcn_exp2f(x); }
__device__ __forceinline__ float flog(float x) { return __builtin_amdgcn_logf(x) * 0.6931471805599453f; }
__device__ __forceinline__ float frcp(float x) { return __builtin_amdgcn_rcpf(x); }
__device__ __forceinline__ float sigmoidf_(float x) { return frcp(1.f + fexp(-x)); }
__device__ __forceinline__ float siluf_(float x) { return x * frcp(1.f + fexp(-x)); }
__device__ __forceinline__ float softplusf_(float x) { return x > 20.f ? x : log1pf(expf(x)); }
__device__ __forceinline__ float gelu_tanh(float x) {
  float u = 0.7978845608028654f * (x + 0.044715f * x * x * x);
  float t = 1.f - 2.f * frcp(1.f + fexp(2.f * u));
  return 0.5f * x * (1.f + t);
}
__device__ __forceinline__ float one_minus_exp(float x) {
  return (x > -1e-3f) ? -x * (1.f + 0.5f * x) : 1.f - fexp(x);
}
template <int CTRL>
__device__ __forceinline__ float dppf(float v) { return __int_as_float(__builtin_amdgcn_mov_dpp(__float_as_int(v), CTRL, 0xf, 0xf, true)); }
typedef float f32x2 __attribute__((ext_vector_type(2)));
__device__ __forceinline__ float sum16(float v) {
  v += dppf<0xB1>(v); v += dppf<0x4E>(v); v += dppf<0x141>(v); v += dppf<0x140>(v);
  return v;
}
__device__ __forceinline__ float wave_sum(float v) {
  v = sum16(v);
  v += __shfl_xor(v, 16); v += __shfl_xor(v, 32);
  return v;
}
__device__ __forceinline__ float max16(float v) {
  v = fmaxf(v, dppf<0xB1>(v)); v = fmaxf(v, dppf<0x4E>(v)); v = fmaxf(v, dppf<0x141>(v)); v = fmaxf(v, dppf<0x140>(v));
  return v;
}
constexpr size_t OFF_S3 = OFF_U + (size_t)(2 * NTOK) * DM * 2;
__device__ __forceinline__ const float* xrow_src(const Params& p, int srcmode, int row) {
  return row < NLAT ? p.in[I_X] + (size_t)row * DM : p.in[I_CTX] + (size_t)(row - NLAT) * DM;
}
__device__ __forceinline__ bf16_t* srow(const Params& p, int srcmode, int row) {
  if (srcmode == 2) return (bf16_t*)(p.ws + OFF_S3) + (size_t)row * DM;
  return row < NLAT ? (bf16_t*)p.out + (size_t)row * DM : (bf16_t*)(p.ws + OFF_CTXS) + (size_t)(row - NLAT) * DM;
}
__device__ __forceinline__ float4 up4(uint2 u) {
  return make_float4(__uint_as_float(u.x << 16), __uint_as_float(u.x & 0xffff0000u), __uint_as_float(u.y << 16), __uint_as_float(u.y & 0xffff0000u));
}
__device__ __forceinline__ int modrow(int row) { return row < NLAT ? (row >> 11) : 16; }
__device__ __forceinline__ const float* modptr(const Params& p, int layer, int mrow, int chunk) {
  return (const float*)(p.ws + OFF_MOD) + ((size_t)(layer * 17 + mrow) * 6144 + chunk * 1024);
}
__device__ __forceinline__ float unpk(const uint4* v, int e) {
  const unsigned* w = (const unsigned*)v;
  unsigned x = w[e >> 1];
  return (e & 1) ? __uint_as_float(x & 0xffff0000u) : __uint_as_float(x << 16);
}
__device__ __forceinline__ bf16_t unpk_raw(const uint4* v, int e) {
  const unsigned* w = (const unsigned*)v;
  unsigned x = w[e >> 1];
  return (bf16_t)((e & 1) ? (x >> 16) : (x & 0xffffu));
}
#define CFENCE() asm volatile("" ::: "memory")
__device__ __forceinline__ unsigned xb_ld(unsigned* p)              { return __hip_atomic_load(p, __ATOMIC_RELAXED, __HIP_MEMORY_SCOPE_AGENT); }
__device__ __forceinline__ unsigned xb_add(unsigned* p, unsigned v) { return __hip_atomic_fetch_add(p, v, __ATOMIC_RELAXED, __HIP_MEMORY_SCOPE_AGENT); }
__device__ __forceinline__ int otid() { int t = threadIdx.x; asm volatile("" : "+v"(t)); return t; }

__device__ __forceinline__ void transpose_tile(const float* __restrict__ src, int N, int k0, int n0, bf16_t* __restrict__ dst, int K, int mode, const float* __restrict__ kscale = nullptr) {
  float* tile = (float*)dynsmem;
  const int tid = otid();
#pragma unroll
  for (int i = 0; i < 2; ++i) {
    int idx = i * NT + tid;
    int r = idx >> 4, c4 = (idx & 15) * 4;
    int n = n0 + c4;
    float4 v = (n < N) ? *(const float4*)(src + (size_t)(k0 + r) * N + n) : make_float4(0.f, 0.f, 0.f, 0.f);
    if (kscale) { const float sc = kscale[k0 + r]; v.x *= sc; v.y *= sc; v.z *= sc; v.w *= sc; }
    tile[r * 65 + c4] = v.x; tile[r * 65 + c4 + 1] = v.y; tile[r * 65 + c4 + 2] = v.z; tile[r * 65 + c4 + 3] = v.w;
  }
  __syncthreads();
  {
    const int nl = tid >> 3, kc = (tid & 7) * 8;
    const int n = n0 + nl;
    const int nr = (mode == 0) ? n : (mode == 3 ? ((n & ~31) + (((n >> 2) & 1) << 4) + (((n >> 3) & 3) << 2) + (n & 3))
                                                 : ((n >> 4) * 32 + (mode == 2 ? 16 : 0) + (n & 15)));
    uint4 o;
    o.x = pack2(tile[(kc + 0) * 65 + nl], tile[(kc + 1) * 65 + nl]);
    o.y = pack2(tile[(kc + 2) * 65 + nl], tile[(kc + 3) * 65 + nl]);
    o.z = pack2(tile[(kc + 4) * 65 + nl], tile[(kc + 5) * 65 + nl]);
    o.w = pack2(tile[(kc + 6) * 65 + nl], tile[(kc + 7) * 65 + nl]);
    *(uint4*)(dst + (size_t)nr * K + k0 + kc) = o;
  }
  __syncthreads();
}

__device__ __forceinline__ void mod_item(const Params& p, int j) {
  float* s = (float*)dynsmem;
  float* red = s + 17 * 256;
  const int tid = otid();
  const int l = j / 96, cb = (j % 96) * 64;
  const int kg = tid >> 6, col = tid & 63;
  const float* cc = p.in[I_C];
  const float* cctx = p.in[I_CCTX];
  const float* aw = p.in[I_ADAW] + (size_t)l * DM * 6144;
  float acc[17];
#pragma unroll
  for (int r = 0; r < 17; ++r) acc[r] = 0.f;
  for (int kc = 0; kc < 4; ++kc) {
    float wv[32];
#pragma unroll
    for (int kk = 0; kk < 32; ++kk) wv[kk] = aw[(size_t)(kc * 256 + kg * 32 + kk) * 6144 + cb + col];
    __syncthreads();
    for (int idx = tid; idx < 17 * 256; idx += NT) {
      int r = idx >> 8, kk = idx & 255;
      int k = kc * 256 + kk;
      float v = (r < 16) ? cc[r * DM + k] : cctx[k];
      s[idx] = siluf_(v);
    }
    __syncthreads();
#pragma unroll 4
    for (int kk = 0; kk < 32; ++kk) {
      int kl = kg * 32 + kk;
      float w = wv[kk];
#pragma unroll
      for (int r = 0; r < 17; ++r) acc[r] += s[r * 256 + kl] * w;
    }
  }
#pragma unroll
  for (int r = 0; r < 17; ++r) red[(kg * 17 + r) * 64 + col] = acc[r];
  __syncthreads();
  float* mod = (float*)(p.ws + OFF_MOD);
  for (int idx = tid; idx < 17 * 64; idx += NT) {
    int r = idx >> 6, c2 = idx & 63;
    float v = 0.f;
#pragma unroll
    for (int g = 0; g < 8; ++g) v += red[(g * 17 + r) * 64 + c2];
    v += p.in[I_ADAB][l * 6144 + cb + c2];
    mod[(size_t)(l * 17 + r) * 6144 + cb + c2] = v;
  }
  __syncthreads();
}

__device__ __forceinline__ void phase_prep_a(const Params& p, int bid, int nb) {
  if (bid == 0 && threadIdx.x < 64) ((int*)(p.ws + OFF_CNT))[threadIdx.x] = 0;
#if DIAG
  if (bid == 0 && threadIdx.x < 8) ((unsigned long long*)(p.ws + OFF_TS))[24 + threadIdx.x] = 0ull;
#endif
  for (int it = bid; it < 192 + 64; it += nb) {
    if (it < 192) { mod_item(p, it); continue; }
    {
      int idx = (it - 192) * NT + threadIdx.x;
      int n = idx >> 4, i = idx & 15;
      float inv = powf(10000.f, -(float)(i & 7) / 8.f);
      float pos = (i < 8) ? (float)(n >> 6) : (float)(n & 63);
      float ang = pos * inv;
      float* rt = (float*)(p.ws + OFF_ROPE);
      rt[idx * 2] = cosf(ang); rt[idx * 2 + 1] = sinf(ang);
    }
  }
}
__device__ __forceinline__ void phase_prep_b(const Params& p, int bid, int nb) {
  constexpr int T_WIN = 16 * 48;
  constexpr int T_PER_LAYER = T_WIN + 256 + 16 * 384 + 18 + 16 + 16;
  constexpr int NTL = 2 * T_PER_LAYER;
  for (int it = bid + 256; it < 256 + NTL; it += nb) {
    int tt = it - 256;
    int l = tt / T_PER_LAYER, r = tt % T_PER_LAYER;
    if (r < T_WIN) {
      int tk = r / 48, tn = r % 48;
      transpose_tile(p.in[I_WIN] + (size_t)l * DM * INC, INC, tk * 64, tn * 64, (bf16_t*)(p.ws + OFF_WINT) + (size_t)l * INP * DM, DM, 3);
    } else if (r < T_WIN + 256) {
      r -= T_WIN;
      int tk = r / 16, tn = r % 16;
      transpose_tile(p.in[I_WOUT] + (size_t)l * DM * DM, DM, tk * 64, tn * 64, (bf16_t*)(p.ws + OFF_WOUTT) + (size_t)l * DM * DM, DM, 3,
                     (tk >= 8 && tk < 12) ? (p.in[I_SNW] + l * 256 - 512) : nullptr);
    } else if (r >= T_WIN + 256 + 16 * 384) {
      r -= T_WIN + 256 + 16 * 384;
      if (r < 18) {
        int tk = r / 6, tn = r % 6;
        transpose_tile(p.in[I_MWQ] + (size_t)l * 192 * 384, 384, tk * 64, tn * 64, (bf16_t*)(p.ws + OFF_WQT) + (size_t)l * 384 * 192, 192, 0);
      } else if (r < 34) {
        r -= 18;
        int tk = r / 8, tn = r % 8;
        transpose_tile(p.in[I_MWKV] + (size_t)l * 128 * 512, 512, tk * 64, tn * 64, (bf16_t*)(p.ws + OFF_WKVT) + (size_t)l * 512 * 128, 128, 0);
      } else {
        r -= 34;
        int d = r >> 3, gate = (r >> 2) & 1, h = r & 3;
        const float* src = (gate == 0 ? p.in[I_LWR] : p.in[I_LWI]) + (size_t)((l * 2 + d) * 4 + h) * 4096;
        transpose_tile(src, 64, 0, 0, (bf16_t*)(p.ws + OFF_LRUW) + (size_t)(((l * 2 + d) * 2 + gate) * 4 + h) * 4096, 64, 0);
      }
    } else {
      r -= T_WIN + 256;
      int e = r / 384, rr = r % 384, sub = rr / 128, t = rr % 128;
      size_t le = (size_t)(l * NEXP + e);
      if (sub < 2) {
        int tk = t / 8, tn = t % 8;
        const float* src = (sub == 0 ? p.in[I_WG] : p.in[I_WU]) + le * DM * FF;
        transpose_tile(src, FF, tk * 64, tn * 64, (bf16_t*)(p.ws + OFF_WGU) + le * 1024 * DM, DM, sub == 0 ? 1 : 2);
      } else {
        int tk = t / 16, tn = t % 16;
        transpose_tile(p.in[I_WD] + le * FF * DM, DM, tk * 64, tn * 64, (bf16_t*)(p.ws + OFF_WDT) + le * DM * FF, FF, 3);
      }
    }
  }
}

__device__ __forceinline__ void phase_norm1x2(const Params& p, int layer, int which, int srcmode, int comb, int nrows, int bid, int nb) {
  const int tx0_ = otid();
  const int wave = tx0_ >> 6, lane = tx0_ & 63;
  const float* nw = p.in[I_N1W] + layer * DM;
  bf16_t* dstb = (bf16_t*)(p.ws + OFF_ACTA);
  const int* SEL = (const int*)(p.ws + OFF_SEL);
  const float* GSEL = (const float*)(p.ws + OFF_GSEL);
  const bf16_t* YS = (const bf16_t*)(p.ws + OFF_U);
  int R = (nrows + nb * 8 - 1) / (nb * 8);
  R += R & 1;
  const int row_lo = (bid * 8 + wave) * R;
  const int row_hi = (row_lo + R < nrows) ? row_lo + R : nrows;
  if (row_lo >= nrows) return;
  int cur_mr = -1;
  float4 mw[4], msh[4], msc[4], mg5[4];
  if (which != 2) {
#pragma unroll
    for (int j = 0; j < 4; ++j) mw[j] = ((const float4*)nw)[j * 64 + lane];
  }
  float4 nva[4], nvb[4];
  uint2 nua[4], nub[4];
  int nsa = -1, nsb = -1; float nga = 0.f, ngb = 0.f;
  {
    if (srcmode == 0) {
      const float4* sa = (const float4*)xrow_src(p, srcmode, row_lo);
      const float4* sb = (const float4*)xrow_src(p, srcmode, row_lo + 1);
#pragma unroll
      for (int j = 0; j < 4; ++j) { nva[j] = sa[j * 64 + lane]; nvb[j] = sb[j * 64 + lane]; }
    } else {
      const uint2* sa = (const uint2*)srow(p, srcmode, row_lo);
      const uint2* sb = (const uint2*)srow(p, srcmode, row_lo + 1);
#pragma unroll
      for (int j = 0; j < 4; ++j) { nua[j] = sa[j * 64 + lane]; nub[j] = sb[j * 64 + lane]; }
    }
    if (comb >= 0 && lane < 16) {
      nsa = SEL[(size_t)row_lo * 16 + lane]; nga = GSEL[(size_t)row_lo * 16 + lane];
      nsb = SEL[(size_t)(row_lo + 1) * 16 + lane]; ngb = GSEL[(size_t)(row_lo + 1) * 16 + lane];
    }
  }
  for (int row = row_lo; row < row_hi; row += 2) {
    const int mr = modrow(row);
    if (mr != cur_mr) {
      cur_mr = mr;
      if (which != 2) {
        const float4* sh = (const float4*)modptr(p, layer, mr, 0);
        const float4* sc = (const float4*)modptr(p, layer, mr, 1);
#pragma unroll
        for (int j = 0; j < 4; ++j) { msh[j] = sh[j * 64 + lane]; msc[j] = sc[j * 64 + lane]; }
      }
      if (comb >= 0) {
        const float4* g5 = (const float4*)modptr(p, comb, mr, 5);
#pragma unroll
        for (int j = 0; j < 4; ++j) mg5[j] = g5[j * 64 + lane];
      }
    }
    float4 va[4], vb[4];
#pragma unroll
    for (int j = 0; j < 4; ++j) { va[j] = srcmode == 0 ? nva[j] : up4(nua[j]); vb[j] = srcmode == 0 ? nvb[j] : up4(nub[j]); }
    const int sla = nsa, slb = nsb; const float gla = nga, glb = ngb;
    if (row + 2 < row_hi) {
      if (srcmode == 0) {
        const float4* sa = (const float4*)xrow_src(p, srcmode, row + 2);
        const float4* sb = (const float4*)xrow_src(p, srcmode, row + 3);
#pragma unroll
        for (int j = 0; j < 4; ++j) { nva[j] = sa[j * 64 + lane]; nvb[j] = sb[j * 64 + lane]; }
      } else {
        const uint2* sa = (const uint2*)srow(p, srcmode, row + 2);
        const uint2* sb = (const uint2*)srow(p, srcmode, row + 3);
#pragma unroll
        for (int j = 0; j < 4; ++j) { nua[j] = sa[j * 64 + lane]; nub[j] = sb[j * 64 + lane]; }
      }
      if (comb >= 0 && lane < 16) {
        nsa = SEL[(size_t)(row + 2) * 16 + lane]; nga = GSEL[(size_t)(row + 2) * 16 + lane];
        nsb = SEL[(size_t)(row + 3) * 16 + lane]; ngb = GSEL[(size_t)(row + 3) * 16 + lane];
      }
    }
    if (comb >= 0) {
      float4 aa[4], ab[4];
#pragma unroll
      for (int j = 0; j < 4; ++j) { aa[j] = make_float4(0.f, 0.f, 0.f, 0.f); ab[j] = make_float4(0.f, 0.f, 0.f, 0.f); }
      unsigned long long ma = __ballot(sla >= 0), mb = __ballot(slb >= 0);
      while (ma | mb) {
        int ea0 = -1, ea1 = -1, eb0 = -1, eb1 = -1;
        if (ma) { ea0 = __builtin_ctzll(ma); ma &= ma - 1; }
        if (ma) { ea1 = __builtin_ctzll(ma); ma &= ma - 1; }
        if (mb) { eb0 = __builtin_ctzll(mb); mb &= mb - 1; }
        if (mb) { eb1 = __builtin_ctzll(mb); mb &= mb - 1; }
        uint2 ya0[4], ya1[4], yb0[4], yb1[4];
        float ga0 = 0.f, ga1 = 0.f, gb0 = 0.f, gb1 = 0.f;
#define CMB_LD(E_, SL_, GL_, Y_, G_) if (E_ >= 0) { const uint2* yr = (const uint2*)(YS + (size_t)__builtin_amdgcn_readlane(SL_, E_) * DM); \
          G_ = __int_as_float(__builtin_amdgcn_readlane(__float_as_int(GL_), E_)); _Pragma("unroll") for (int j = 0; j < 4; ++j) Y_[j] = yr[j * 64 + lane]; }
#define CMB_ACC(E_, Y_, G_, A_) if (E_ >= 0) { _Pragma("unroll") for (int j = 0; j < 4; ++j) { const uint2 y = Y_[j]; \
          A_[j].x += G_ * __uint_as_float(y.x << 16); A_[j].y += G_ * __uint_as_float(y.x & 0xffff0000u); \
          A_[j].z += G_ * __uint_as_float(y.y << 16); A_[j].w += G_ * __uint_as_float(y.y & 0xffff0000u); } }
        CMB_LD(ea0, sla, gla, ya0, ga0) CMB_LD(eb0, slb, glb, yb0, gb0) CMB_LD(ea1, sla, gla, ya1, ga1) CMB_LD(eb1, slb, glb, yb1, gb1)
        CMB_ACC(ea0, ya0, ga0, aa) CMB_ACC(eb0, yb0, gb0, ab) CMB_ACC(ea1, ya1, ga1, aa) CMB_ACC(eb1, yb1, gb1, ab)
#undef CMB_LD
#undef CMB_ACC
      }
#pragma unroll
      for (int j = 0; j < 4; ++j) {
        const float4 m = mg5[j];
        va[j].x += m.x * aa[j].x; va[j].y += m.y * aa[j].y; va[j].z += m.z * aa[j].z; va[j].w += m.w * aa[j].w;
        vb[j].x += m.x * ab[j].x; vb[j].y += m.y * ab[j].y; vb[j].z += m.z * ab[j].z; vb[j].w += m.w * ab[j].w;
        if (which == 2) {
          ((float4*)(p.out + (size_t)row * DM))[j * 64 + lane] = va[j];
          ((float4*)(p.out + (size_t)(row + 1) * DM))[j * 64 + lane] = vb[j];
        } else {
          ((uint2*)srow(p, 1, row))[j * 64 + lane] = make_uint2(pack2(va[j].x, va[j].y), pack2(va[j].z, va[j].w));
          ((uint2*)srow(p, 1, row + 1))[j * 64 + lane] = make_uint2(pack2(vb[j].x, vb[j].y), pack2(vb[j].z, vb[j].w));
        }
      }
    }
    if (which == 2) continue;
    float ssa = 0.f, ssb = 0.f;
#pragma unroll
    for (int j = 0; j < 4; ++j) {
      ssa += va[j].x * va[j].x + va[j].y * va[j].y + va[j].z * va[j].z + va[j].w * va[j].w;
      ssb += vb[j].x * vb[j].x + vb[j].y * vb[j].y + vb[j].z * vb[j].z + vb[j].w * vb[j].w;
    }
    ssa = wave_sum(ssa); ssb = wave_sum(ssb);
    const float ra = rsqrtf(ssa * (1.f / DM) + EPSF), rb = rsqrtf(ssb * (1.f / DM) + EPSF);
#pragma unroll
    for (int j = 0; j < 4; ++j) {
      const float4 w4 = mw[j], s4 = msh[j], c4 = msc[j];
      uint2 oa, ob;
      oa.x = pack2(va[j].x * ra * w4.x * (1.f + c4.x) + s4.x, va[j].y * ra * w4.y * (1.f + c4.y) + s4.y);
      oa.y = pack2(va[j].z * ra * w4.z * (1.f + c4.z) + s4.z, va[j].w * ra * w4.w * (1.f + c4.w) + s4.w);
      ob.x = pack2(vb[j].x * rb * w4.x * (1.f + c4.x) + s4.x, vb[j].y * rb * w4.y * (1.f + c4.y) + s4.y);
      ob.y = pack2(vb[j].z * rb * w4.z * (1.f + c4.z) + s4.z, vb[j].w * rb * w4.w * (1.f + c4.w) + s4.w);
      ((uint2*)(dstb + (size_t)row * DM))[j * 64 + lane] = oa;
      ((uint2*)(dstb + (size_t)(row + 1) * DM))[j * 64 + lane] = ob;
    }
  }
}

__device__ __forceinline__ void phase_norm2(const Params& p, int layer, int srcmode, int nrows, int bid, int nb) {
  const int tx0_ = otid();
  const int wave = tx0_ >> 6, lane = tx0_ & 63;
  const float* nw = p.in[I_N2W] + layer * DM;
  bf16_t* dstb = (bf16_t*)(p.ws + OFF_ACTB);
  const float* wr = p.in[I_ROUT] + (size_t)layer * DM * NEXP;
  float* WRT = (float*)dynsmem;
  __syncthreads();
  for (int i = tx0_; i < DM * NEXP / 4; i += NT) {
    float4 w = ((const float4*)wr)[i];
    const int k = i >> 2, e0 = (i & 3) * 4;
    WRT[(e0 + 0) * DM + k] = w.x; WRT[(e0 + 1) * DM + k] = w.y; WRT[(e0 + 2) * DM + k] = w.z; WRT[(e0 + 3) * DM + k] = w.w;
  }
  __syncthreads();
  int R = (nrows + nb * 8 - 1) / (nb * 8);
  R += R & 1;
  const int row_lo = (bid * 8 + wave) * R;
  const int row_hi = (row_lo + R < nrows) ? row_lo + R : nrows;
  if (row_lo >= nrows) return;
  float4 mw[4], msh[4], msc[4];
#pragma unroll
  for (int j = 0; j < 4; ++j) mw[j] = ((const float4*)nw)[j * 64 + lane];
  int cur_mr = -1;
  uint2 nua[4], nub[4];
  {
    const uint2* sa = (const uint2*)srow(p, srcmode, row_lo);
    const uint2* sb = (const uint2*)srow(p, srcmode, row_lo + 1);
#pragma unroll
    for (int j = 0; j < 4; ++j) { nua[j] = sa[j * 64 + lane]; nub[j] = sb[j * 64 + lane]; }
  }
  for (int row = row_lo; row < row_hi; row += 2) {
    const int mr = modrow(row);
    if (mr != cur_mr) {
      cur_mr = mr;
      const float4* sh = (const float4*)modptr(p, layer, mr, 3);
      const float4* sc = (const float4*)modptr(p, layer, mr, 4);
#pragma unroll
      for (int j = 0; j < 4; ++j) {
        msh[j] = sh[j * 64 + lane];
        const float4 c = sc[j * 64 + lane], w = mw[j];
        msc[j] = make_float4(w.x * (1.f + c.x), w.y * (1.f + c.y), w.z * (1.f + c.z), w.w * (1.f + c.w));
      }
    }
    float4 va[4], vb[4];
#pragma unroll
    for (int j = 0; j < 4; ++j) { va[j] = up4(nua[j]); vb[j] = up4(nub[j]); }
    if (row + 2 < row_hi) {
      const uint2* sa = (const uint2*)srow(p, srcmode, row + 2);
      const uint2* sb = (const uint2*)srow(p, srcmode, row + 3);
#pragma unroll
      for (int j = 0; j < 4; ++j) { nua[j] = sa[j * 64 + lane]; nub[j] = sb[j * 64 + lane]; }
    }
    float ssa = 0.f, ssb = 0.f;
#pragma unroll
    for (int j = 0; j < 4; ++j) {
      ssa += va[j].x * va[j].x + va[j].y * va[j].y + va[j].z * va[j].z + va[j].w * va[j].w;
      ssb += vb[j].x * vb[j].x + vb[j].y * vb[j].y + vb[j].z * vb[j].z + vb[j].w * vb[j].w;
    }
    ssa = wave_sum(ssa); ssb = wave_sum(ssb);
    const float ra = rsqrtf(ssa * (1.f / DM) + EPSF), rb = rsqrtf(ssb * (1.f / DM) + EPSF);
    f32x2 lg[16];
#pragma unroll
    for (int e = 0; e < 16; ++e) lg[e] = (f32x2){0.f, 0.f};
#pragma unroll
    for (int j = 0; j < 4; ++j) {
      const float4 s4 = msh[j], c4 = msc[j];
      const float a0 = (va[j].x * ra) * c4.x + s4.x, a1 = (va[j].y * ra) * c4.y + s4.y;
      const float a2 = (va[j].z * ra) * c4.z + s4.z, a3 = (va[j].w * ra) * c4.w + s4.w;
      const float b0 = (vb[j].x * rb) * c4.x + s4.x, b1 = (vb[j].y * rb) * c4.y + s4.y;
      const float b2 = (vb[j].z * rb) * c4.z + s4.z, b3 = (vb[j].w * rb) * c4.w + s4.w;
      uint2 oa, ob;
      oa.x = pack2(a0, a1); oa.y = pack2(a2, a3); ob.x = pack2(b0, b1); ob.y = pack2(b2, b3);
      ((uint2*)(dstb + (size_t)row * DM))[j * 64 + lane] = oa;
      ((uint2*)(dstb + (size_t)(row + 1) * DM))[j * 64 + lane] = ob;
      const f32x2 ab0 = (f32x2){a0, b0}, ab1 = (f32x2){a1, b1}, ab2 = (f32x2){a2, b2}, ab3 = (f32x2){a3, b3};
#pragma unroll
      for (int e = 0; e < 16; ++e) {
        const float4 w = ((const float4*)(WRT + e * DM))[j * 64 + lane];
        lg[e] += ab0 * w.x; lg[e] += ab1 * w.y; lg[e] += ab2 * w.z; lg[e] += ab3 * w.w;
        if ((e & 3) == 3) CFENCE();
      }
    }
    float la, lb;
    {
      const bool h3 = lane & 8, h2 = lane & 4, h1 = lane & 2, h0 = lane & 1;
      float ua[8], ub[8];
#pragma unroll
      for (int k = 0; k < 8; ++k) {
        const float ka = h3 ? lg[8 + k].x : lg[k].x, sa = h3 ? lg[k].x : lg[8 + k].x;
        const float kb = h3 ? lg[8 + k].y : lg[k].y, sb = h3 ? lg[k].y : lg[8 + k].y;
        ua[k] = ka + dppf<0x140>(sa); ub[k] = kb + dppf<0x140>(sb);
      }
      float va4[4], vb4[4];
#pragma unroll
      for (int k = 0; k < 4; ++k) {
        const float ka = h2 ? ua[4 + k] : ua[k], sa = h2 ? ua[k] : ua[4 + k];
        const float kb = h2 ? ub[4 + k] : ub[k], sb = h2 ? ub[k] : ub[4 + k];
        va4[k] = ka + dppf<0x141>(sa); vb4[k] = kb + dppf<0x141>(sb);
      }
      float wa2[2], wb2[2];
#pragma unroll
      for (int k = 0; k < 2; ++k) {
        const float ka = h1 ? va4[2 + k] : va4[k], sa = h1 ? va4[k] : va4[2 + k];
        const float kb = h1 ? vb4[2 + k] : vb4[k], sb = h1 ? vb4[k] : vb4[2 + k];
        wa2[k] = ka + dppf<0x4E>(sa); wb2[k] = kb + dppf<0x4E>(sb);
      }
      la = (h0 ? wa2[1] : wa2[0]) + dppf<0xB1>(h0 ? wa2[0] : wa2[1]);
      lb = (h0 ? wb2[1] : wb2[0]) + dppf<0xB1>(h0 ? wb2[0] : wb2[1]);
      la += __shfl_xor(la, 16); lb += __shfl_xor(lb, 16);
      la += __shfl_xor(la, 32); lb += __shfl_xor(lb, 32);
    }
    const float pa = expf(la - max16(la)), pb = expf(lb - max16(lb));
    const float dena = sum16(pa), denb = sum16(pb);
    const float minea = pa, mineb = pb;
    if (lane < 16) {
      float* aff = (float*)(p.ws + OFF_AFF);
      size_t idx;
      if (row < NLAT) { int b = row >> 11, n = row & 2047; idx = ((size_t)(b * NEXP + lane)) * SEQ + n; }
      else { int rr = row - NLAT; int b = rr >> 8, n = rr & 255; idx = (size_t)NB * NEXP * SEQ + ((size_t)(b * NEXP + lane)) * CTXL + n; }
      aff[idx] = minea / dena;
      aff[idx + 1] = mineb / denb;
    }
  }
}

__device__ __forceinline__ int lds_byte(int r, int c) {
  int st = (r >> 4) * 2 + (c >> 5), rr = r & 15, cc = c & 31, ob = rr * 64 + cc * 2;
  return st * 1024 + (ob ^ (((ob >> 9) & 1) << 5));
}
__device__ __forceinline__ void stage_rc(int b, int& R, int& C) {
  int st = b / 1024, sb = b % 1024, swz = sb ^ (((sb >> 9) & 1) << 5);
  R = (st >> 1) * 16 + swz / 64; C = (st & 1) * 32 + (swz % 64) / 2;
}
#define G_LAS __attribute__((address_space(3)))
#define G_HTB (128 * 64 * 2)
#define G_SA(b, h) (((b) * 2 + (h)) * G_HTB)
#define G_SB(b, h) ((4 + (b) * 2 + (h)) * G_HTB)
#define G_STAGE(bufoff, gbase, voff) do { _Pragma("unroll") for (int _i = 0; _i < 2; ++_i) \
    __builtin_amdgcn_global_load_lds((const unsigned*)((const char*)(gbase) + (voff)[_i]), (G_LAS unsigned*)(lds + (bufoff) + ldsw + _i * 8192), 16, 0, 0); } while (0)
#define G_LDA(dst, b, h) do { _Pragma("unroll") for (int m = 0; m < 4; ++m) _Pragma("unroll") for (int k = 0; k < 2; ++k) dst[m][k] = *(const G_LAS bf16x8*)(lds + G_SA(b, h) + aoff + m * 2048 + k * 1024); } while (0)
#define G_LDB(dst, b, h) do { _Pragma("unroll") for (int n = 0; n < 2; ++n) _Pragma("unroll") for (int k = 0; k < 2; ++k) dst[n][k] = *(const G_LAS bf16x8*)(lds + G_SB(b, h) + boff + n * 2048 + k * 1024); } while (0)
#define G_MMA(ai, bj, At_, Bt_) do { __builtin_amdgcn_s_setprio(1); _Pragma("unroll") for (int m = 0; m < 4; ++m) _Pragma("unroll") for (int n = 0; n < 2; ++n) _Pragma("unroll") for (int k = 0; k < 2; ++k) \
    acc[ai][bj][m][n] = __builtin_amdgcn_mfma_f32_16x16x32_bf16(Bt_[n][k], At_[m][k], acc[ai][bj][m][n], 0, 0, 0); __builtin_amdgcn_s_setprio(0); } while (0)
#define G_WAIT_V(n) asm volatile("s_waitcnt vmcnt(" #n ")" ::: "memory")
#define G_WAIT_L(n) asm volatile("s_waitcnt lgkmcnt(" #n ")" ::: "memory")
#define G_BAR __builtin_amdgcn_s_barrier()
#define G_SCHED __builtin_amdgcn_sched_barrier(0)

struct GUnit { int arow0, bcol, orow0, flags; const bf16_t* Bt; };

template <int EPI>
__device__ __forceinline__ void gemm_epilogue(const Params& p, int layer, int srcmode, const f32x4 (&acc)[2][2][4][2], int orow0, int bcol, int flags, int wr, int wc, int fr, int fq) {
#pragma unroll
  for (int ai = 0; ai < 2; ++ai) {
    if (ai == 1 && (flags & 1)) break;
#pragma unroll
    for (int m = 0; m < 4; ++m) {
      const int row = orow0 + ai * 128 + wr * 64 + m * 16 + fr;
      if (EPI == 0 || EPI == 3) {
        bf16_t* O = (EPI == 0) ? (bf16_t*)(p.ws + OFF_U) + (size_t)row * INP : (bf16_t*)(p.ws + OFF_U) + (size_t)row * DM;
#pragma unroll
        for (int bj = 0; bj < 2; ++bj) {
          if (bj == 1 && (flags & 2)) break;
          const int col = bcol + bj * 128 + wc * 32 + fq * 8;
          const f32x4 a0 = acc[ai][bj][m][0], a1 = acc[ai][bj][m][1];
          *(uint4*)(O + col) = make_uint4(pack2(a0[0], a0[1]), pack2(a0[2], a0[3]), pack2(a1[0], a1[1]), pack2(a1[2], a1[3]));
        }
      } else if (EPI == 1) {
        const float* g2 = modptr(p, layer, modrow(row), 2);
#pragma unroll
        for (int bj = 0; bj < 2; ++bj) {
          if (bj == 1 && (flags & 2)) break;
          const int col = bcol + bj * 128 + wc * 32 + fq * 8;
          const f32x4 a0 = acc[ai][bj][m][0], a1 = acc[ai][bj][m][1];
          const float4 g0 = *(const float4*)(g2 + col), g1 = *(const float4*)(g2 + col + 4);
          float4 x0, x1;
          if (srcmode == 0) { const float* xs = xrow_src(p, 0, row); x0 = *(const float4*)(xs + col); x1 = *(const float4*)(xs + col + 4); }
          else { const uint4 u = *(const uint4*)(srow(p, 1, row) + col); x0 = up4(make_uint2(u.x, u.y)); x1 = up4(make_uint2(u.z, u.w)); }
          x0.x += g0.x * a0[0]; x0.y += g0.y * a0[1]; x0.z += g0.z * a0[2]; x0.w += g0.w * a0[3];
          x1.x += g1.x * a1[0]; x1.y += g1.y * a1[1]; x1.z += g1.z * a1[2]; x1.w += g1.w * a1[3];
          *(uint4*)(srow(p, srcmode == 0 ? 1 : 2, row) + col) = make_uint4(pack2(x0.x, x0.y), pack2(x0.z, x0.w), pack2(x1.x, x1.y), pack2(x1.z, x1.w));
        }
      } else {
        bf16_t* ACT = (bf16_t*)(p.ws + OFF_ACTA) + (size_t)row * FF;
#pragma unroll
        for (int bj = 0; bj < 2; ++bj) {
          const int f = (((bcol + bj * 128 + wc * 32) >> 5) << 4) + fq * 4;
          f32x4 g = acc[ai][bj][m][0], u = acc[ai][bj][m][1];
          uint2 o;
          o.x = pack2(siluf_(g[0]) * u[0], siluf_(g[1]) * u[1]);
          o.y = pack2(siluf_(g[2]) * u[2], siluf_(g[3]) * u[3]);
          *(uint2*)(ACT + f) = o;
        }
      }
    }
  }
}

template <int EPI, class UnitFn>
__device__ __forceinline__ void gemm_stream(const Params& p, int layer, int srcmode, const bf16_t* __restrict__ A, const int* __restrict__ rowl, int K,
                                            const UnitFn& unit_of, int bid, int nb) {
  G_LAS unsigned char* lds = (G_LAS unsigned char*)dynsmem;
  int tx_ = threadIdx.x; asm volatile("" : "+v"(tx_));
  const int tid = tx_, wid = __builtin_amdgcn_readfirstlane(tid >> 6), lane = tid & 63, wr = wid >> 2, wc = wid & 3, fr = lane & 15, fq = lane >> 4;
  const int nt = K / 64;
  GUnit cur, nxt;
  int ui = bid;
#define G_REMAP(L_) ((nb & 7) ? (L_) : ((((L_) / nb) * nb) + (((L_) % nb) & 7) * (nb >> 3) + (((L_) % nb) >> 3)))
  if (!unit_of(G_REMAP(ui), cur)) return;
  int R0, C0, R1, C1;
  stage_rc(tid * 16, R0, C0);
  stage_rc(tid * 16 + 8192, R1, C1);
  unsigned voffB[2];
  voffB[0] = (unsigned)(R0 * K + C0) * 2u; voffB[1] = (unsigned)(R1 * K + C1) * 2u;
#define G_CALCA(U_, V0, V1) do { const int h1_ = ((U_).flags & 1) ? 0 : 128; int r00 = (U_).arow0 + R0, r01 = (U_).arow0 + R1, r10 = (U_).arow0 + h1_ + R0, r11 = (U_).arow0 + h1_ + R1; \
    if (rowl) { r00 = rowl[r00]; r01 = rowl[r01]; r10 = rowl[r10]; r11 = rowl[r11]; } \
    V0[0] = (unsigned)(r00 * K + C0) * 2u; V0[1] = (unsigned)(r01 * K + C1) * 2u; V1[0] = (unsigned)(r10 * K + C0) * 2u; V1[1] = (unsigned)(r11 * K + C1) * 2u; } while (0)
  constexpr bool GATHER = (EPI == 2);
  unsigned vA0[2], vA1[2];
  if (GATHER) { G_CALCA(cur, vA0, vA1); } else { vA0[0] = vA0[1] = vA1[0] = vA1[1] = 0u; }
  const size_t kstep = 128;
  const size_t hstep = (size_t)128 * K * 2;
  const unsigned ldsw = (unsigned)wid * 1024u;
  const int aoff = lds_byte(wr * 64 + fr, fq * 8), boff = lds_byte(wc * 32 + fr, fq * 8);
  const char* cA = (const char*)A + (GATHER ? (size_t)0 : (size_t)cur.arow0 * K * 2);
  const char* cB = (const char*)cur.Bt + (size_t)cur.bcol * K * 2;
  f32x4 acc[2][2][4][2];
#pragma unroll
  for (int a = 0; a < 2; ++a)
#pragma unroll
    for (int b = 0; b < 2; ++b)
#pragma unroll
      for (int m = 0; m < 4; ++m)
#pragma unroll
        for (int n = 0; n < 2; ++n) acc[a][b][m][n] = (f32x4){0.f, 0.f, 0.f, 0.f};
  bf16x8 At[4][2], B0[2][2], B1[2][2];
  const int koff = (EPI == 1) ? 8 : 0;
#define G_KT(T_) ((size_t)((((T_) + koff) & (nt - 1))) * kstep)
#define G_STAGE_A(bufoff, H_, base, V0_, V1_) do { if (GATHER) { if (H_) G_STAGE(bufoff, base, V1_); else G_STAGE(bufoff, base, V0_); } \
    else G_STAGE(bufoff, (base) + (H_) * hstep, voffB); } while (0)
  G_STAGE(G_SB(0, 0), cB + G_KT(0), voffB); G_STAGE_A(G_SA(0, 0), 0, cA + G_KT(0), vA0, vA1); G_STAGE(G_SB(0, 1), cB + hstep + G_KT(0), voffB); G_STAGE_A(G_SA(0, 1), 1, cA + G_KT(0), vA0, vA1);
  if (wr == 1) G_BAR;
  G_WAIT_V(4); G_BAR;
  G_STAGE(G_SB(1, 0), cB + G_KT(1), voffB); G_STAGE_A(G_SA(1, 0), 0, cA + G_KT(1), vA0, vA1); G_STAGE(G_SB(1, 1), cB + hstep + G_KT(1), voffB);
  G_WAIT_V(6); G_BAR;
  for (;;) {
    const bool has_next = unit_of(G_REMAP(ui + nb), nxt);
    unsigned nA0[2], nA1[2];
    const char* nB;
    const char* nA;
    if (has_next) {
      if (GATHER) { G_CALCA(nxt, nA0, nA1); nA = cA; } else { nA0[0] = nA0[1] = nA1[0] = nA1[1] = 0u; nA = (const char*)A + (size_t)nxt.arow0 * K * 2; }
      nB = (const char*)nxt.Bt + (size_t)nxt.bcol * K * 2;
    } else { nA0[0] = vA0[0]; nA0[1] = vA0[1]; nA1[0] = vA1[0]; nA1[1] = vA1[1]; nB = cB; nA = cA; }
    const int fl = __builtin_amdgcn_readfirstlane(cur.flags);
    for (int t = 0; t < nt; t += 2) {
      const bool last = (t == nt - 2);
      const char* a1 = cA + G_KT(t + 1);
      const char* a2 = (last ? nA : cA) + G_KT(last ? 0 : t + 2);
      const char* b2 = (last ? nB : cB) + G_KT(last ? 0 : t + 2);
      const char* a3 = (last ? nA : cA) + G_KT(last ? 1 : t + 3);
      const char* b3 = (last ? nB : cB) + G_KT(last ? 1 : t + 3);
      unsigned w0[2], w1[2];
      if (GATHER) {
        w0[0] = last ? nA0[0] : vA0[0]; w0[1] = last ? nA0[1] : vA0[1];
        w1[0] = last ? nA1[0] : vA1[0]; w1[1] = last ? nA1[1] : vA1[1];
      } else { w0[0] = w0[1] = w1[0] = w1[1] = 0u; }
      if (EPI == 1 && t == 4) {
        const float* PS = (const float*)(p.ws + OFF_PSSQ);
#pragma unroll
        for (int ai = 0; ai < 2; ++ai) {
          CFENCE();
#pragma unroll
          for (int m = 0; m < 4; ++m) {
            const int row = cur.orow0 + ai * 128 + wr * 64 + m * 16 + fr;
            const float4 ps = *(const float4*)(PS + (size_t)row * 4);
            const float rs = rsqrtf((ps.x + ps.y + ps.z + ps.w) * (1.f / 256.f) + EPSF);
#pragma unroll
            for (int bj = 0; bj < 2; ++bj)
#pragma unroll
              for (int n = 0; n < 2; ++n) acc[ai][bj][m][n] *= rs;
          }
        }
      }
      G_LDB(B0, 0, 0); G_SCHED; G_LDA(At, 0, 0); G_STAGE_A(G_SA(1, 1), 1, a1, vA0, vA1);
      G_WAIT_L(8); G_BAR; G_WAIT_L(0); G_MMA(0, 0, At, B0); G_BAR; G_SCHED;
      G_LDB(B1, 0, 1); G_STAGE(G_SB(0, 0), b2, voffB);
      G_BAR; G_WAIT_L(0); if (!(fl & 2)) G_MMA(0, 1, At, B1); G_BAR;
      G_LDA(At, 0, 1); G_STAGE_A(G_SA(0, 0), 0, a2, w0, w1);
      G_BAR; G_WAIT_L(0); if (!(fl & 1)) G_MMA(1, 0, At, B0); G_BAR; G_SCHED;
      G_STAGE(G_SB(0, 1), b2 + hstep, voffB);
      G_WAIT_V(6); G_BAR; if (!(fl & 3)) G_MMA(1, 1, At, B1); G_BAR;
      G_LDB(B0, 1, 0); G_SCHED; G_LDA(At, 1, 0); G_STAGE_A(G_SA(0, 1), 1, a2, w0, w1);
      G_WAIT_L(8); G_BAR; G_WAIT_L(0); G_MMA(0, 0, At, B0); G_BAR; G_SCHED;
      G_LDB(B1, 1, 1); G_STAGE(G_SB(1, 0), b3, voffB);
      G_BAR; G_WAIT_L(0); if (!(fl & 2)) G_MMA(0, 1, At, B1); G_BAR;
      G_LDA(At, 1, 1); G_STAGE_A(G_SA(1, 0), 0, a3, w0, w1);
      G_BAR; G_WAIT_L(0); if (!(fl & 1)) G_MMA(1, 0, At, B0); G_BAR; G_SCHED;
      G_STAGE(G_SB(1, 1), b3 + hstep, voffB);
      G_WAIT_V(6); G_BAR; if (!(fl & 3)) G_MMA(1, 1, At, B1); G_BAR;
    }
    gemm_epilogue<EPI>(p, layer, srcmode, acc, cur.orow0, cur.bcol, fl, wr, wc, fr, fq);
    if (!has_next) break;
#pragma unroll
    for (int a = 0; a < 2; ++a)
#pragma unroll
      for (int b = 0; b < 2; ++b)
#pragma unroll
        for (int m = 0; m < 4; ++m)
#pragma unroll
          for (int n = 0; n < 2; ++n) acc[a][b][m][n] = (f32x4){0.f, 0.f, 0.f, 0.f};
    cur = nxt; cB = nB; cA = nA; ui += nb;
    vA0[0] = nA0[0]; vA0[1] = nA0[1]; vA1[0] = nA1[0]; vA1[1] = nA1[1];
  }
  G_WAIT_V(0);
  if (wr == 0) G_BAR;
  G_BAR;
#undef G_CALCA
#undef G_KT
#undef G_STAGE_A
}

__device__ __forceinline__ void phase_inproj(const Params& p, int layer, int bid, int nb) {
  const bf16_t* A = (const bf16_t*)(p.ws + OFF_ACTA);
  const bf16_t* Bt = (const bf16_t*)(p.ws + OFF_WINT) + (size_t)layer * INP * DM;
  constexpr int MT = NTOK / 256, NTL = INP / 256;
  auto unit_of = [&](int t, GUnit& u) -> bool {
    if (t >= MT * NTL) return false;
    const int g = t / 96, w = t % 96, ntg = w / 32, r = w % 32;
    const int mt = g * 8 + (r & 7), ntile = ntg * 4 + (r >> 3);
    u.arow0 = mt * 256; u.bcol = ntile * 256; u.orow0 = mt * 256; u.Bt = Bt; u.flags = 0;
    return true;
  };
  if (bid & 1) { for (int i = 0; i < 5; ++i) __builtin_amdgcn_s_sleep(127); }
  gemm_stream<0>(p, layer, 0, A, nullptr, DM, unit_of, bid, nb);
}
__device__ __forceinline__ void phase_outproj(const Params& p, int layer, int bid, int nb) {
  const bf16_t* A = (const bf16_t*)(p.ws + OFF_ACTA);
  const bf16_t* Bt = (const bf16_t*)(p.ws + OFF_WOUTT) + (size_t)layer * DM * DM;
  constexpr int NTL = DM / 256, LATU = (NLAT / 256) * NTL;
  const int total = LATU + (layer == 0 ? (NCTX / 256) * NTL * 4 : 0);
  auto unit_of = [&](int t, GUnit& u) -> bool {
    if (t >= total) return false;
    if (t < LATU) {
      const int mt = t / NTL, ntile = t % NTL;
      u.arow0 = mt * 256; u.bcol = ntile * 256; u.flags = 0;
    } else {
      const int q = t - LATU, mt = q >> 4, ntile = (q >> 2) & 3, qa = (q >> 1) & 1, qb = q & 1;
      u.arow0 = NLAT + mt * 256 + qa * 128; u.bcol = ntile * 256 + qb * 128; u.flags = 3;
    }
    u.orow0 = u.arow0; u.Bt = Bt;
    return true;
  };
  gemm_stream<1>(p, layer, layer == 0 ? 0 : 1, A, nullptr, DM, unit_of, bid, nb);
}
__device__ __forceinline__ void phase_moe1(const Params& p, int layer, int bid, int nb) {
  const bf16_t* A = (const bf16_t*)(p.ws + OFF_ACTB);
  const int* ROWL = (const int*)(p.ws + OFF_ROWL);
  const int MT = (layer == 0 ? SLOTS : SLOTS_L) / 256;
  const bf16_t* W = (const bf16_t*)(p.ws + OFF_WGU) + (size_t)layer * NEXP * 1024 * DM;
  auto unit_of = [&](int t, GUnit& u) -> bool {
    if (t >= (MT == 16 ? 1024 : 1280)) return false;
    if (MT == 16 || t < 1024) {
      const int e = t >> 6, r = t & 63, ntile = r >> 4, mt = r & 15;
      u.arow0 = e * SLOTS + mt * 256; u.bcol = ntile * 256; u.flags = 0; u.Bt = W + (size_t)e * 1024 * DM;
    } else {
      const int q = t - 1024, e = q >> 4, r = q & 15, ntile = r >> 2, hm = r & 3;
      u.arow0 = e * SLOTS + SLOTS_L + hm * 128; u.bcol = ntile * 256; u.flags = 1; u.Bt = W + (size_t)e * 1024 * DM;
    }
    u.orow0 = u.arow0;
    return true;
  };
  gemm_stream<2>(p, layer, 0, A, ROWL, DM, unit_of, bid, nb);
}
__device__ __forceinline__ void phase_moe2(const Params& p, int layer, int bid, int nb) {
  const bf16_t* A = (const bf16_t*)(p.ws + OFF_ACTA);
  const int MT = (layer == 0 ? SLOTS : SLOTS_L) / 256;
  const bf16_t* W = (const bf16_t*)(p.ws + OFF_WDT) + (size_t)layer * NEXP * DM * FF;
  auto unit_of = [&](int t, GUnit& u) -> bool {
    if (t >= (MT == 16 ? 1024 : 1280)) return false;
    if (MT == 16 || t < 1024) {
      const int e = t >> 6, r = t & 63, ntile = r >> 4, mt = r & 15;
      u.arow0 = e * SLOTS + mt * 256; u.bcol = ntile * 256; u.flags = 0; u.Bt = W + (size_t)e * DM * FF;
    } else {
      const int q = t - 1024, e = q >> 4, r = q & 15, ntile = r >> 2, hm = r & 3;
      u.arow0 = e * SLOTS + SLOTS_L + hm * 128; u.bcol = ntile * 256; u.flags = 1; u.Bt = W + (size_t)e * DM * FF;
    }
    u.orow0 = u.arow0;
    return true;
  };
  gemm_stream<3>(p, layer, 0, A, nullptr, FF, unit_of, bid, nb);
}

template <bool SWA = false, bool SWB = false>
__device__ __forceinline__ void mma16(const bf16_t* At, int r0, const bf16_t* Bt, f32x4* acc, int fr, int fq) {
#pragma unroll
  for (int ks = 0; ks < 2; ++ks) {
    const int ca = (ks * 32 + fq * 8) ^ (SWA ? 16 * ((r0 >> 4) & 3) : 0);
    bf16x8 a = *(const bf16x8*)(At + (r0 + fr) * TS + ca);
#pragma unroll
    for (int nf = 0; nf < 4; ++nf) {
      const int cb = (ks * 32 + fq * 8) ^ (SWB ? 16 * nf : 0);
      bf16x8 b = *(const bf16x8*)(Bt + (nf * 16 + fr) * TS + cb);
      acc[nf] = __builtin_amdgcn_mfma_f32_16x16x32_bf16(a, b, acc[nf], 0, 0, 0);
    }
  }
}

struct StepGeo { int rowbase, seglen, T0; bool wout, second; };
__device__ __forceinline__ StepGeo step_geo(int L, int b, int d, int s) {
  StepGeo g;
  const bool ctx = s < 4;
  const int c = ctx ? s : s - 4;
  const int nch = ctx ? (CTXL / 64) : (SEQ / 64);
  const int nc = d ? nch - 1 - c : c;
  g.seglen = ctx ? CTXL : SEQ;
  g.rowbase = ctx ? NLAT + b * CTXL : b * SEQ;
  g.T0 = nc * 64;
  g.wout = !(L == 1 && ctx);
  const int base = ctx ? 0 : 4;
  const int s_other = d ? base + nc : base + (nch - 1 - nc);
  g.second = s_other < s;
  return g;
}

__device__ __forceinline__ void chain_hgrn_fast(const Params& p, int L, int bh) {
  const int b = bh >> 2, h = bh & 3;
  int tx_ = threadIdx.x; asm volatile("" : "+v"(tx_));
  const int d = tx_ >> 8, tid = tx_ & 255;
  char* sm = dynsmem + d * GROUP_LDS;
  float* CUM = (float*)sm;
  bf16_t* QT = (bf16_t*)(sm + 16640);
  bf16_t* KT = QT + 64 * TS;
  bf16_t* KE = KT + 64 * TS;
  bf16_t* VT = KE + 64 * TS;
  bf16_t* ST = VT + 64 * TS;
  float* SEG = (float*)(ST + 64 * TS);
  const int w = tid >> 6, lane = tid & 63, fr = lane & 15, fq = lane >> 4;
  const int ti = tid >> 2, kq = (tid & 3) * 16;
  const bf16_t* U = (const bf16_t*)(p.ws + OFF_U);
  bf16_t* Y = (bf16_t*)(p.ws + OFF_ACTA);
  float lb[16];
#pragma unroll
  for (int e = 0; e < 16; ++e) lb[e] = (L == 1) ? sigmoidf_(p.in[I_HLB][256 + h * 64 + kq + e] - p.in[I_HLB][h * 64 + kq + e]) : 0.f;
  float nwv[4];
#pragma unroll
  for (int nf = 0; nf < 4; ++nf) nwv[nf] = p.in[I_HNW][L * 256 + h * 64 + nf * 16 + fr];
  f32x4 S[4];
#pragma unroll
  for (int nf = 0; nf < 4; ++nf) S[nf] = (f32x4){0.f, 0.f, 0.f, 0.f};
  uint4 cq0, cq1, cf0, cf1, cv0, cv1;
  {
    StepGeo g = step_geo(L, b, d, 0);
    const bf16_t* ur = U + (size_t)(g.rowbase + (d ? g.T0 + 63 - ti : g.T0 + ti)) * INP + h * 64 + kq;
    cq0 = ((const uint4*)(ur + 512))[0]; cq1 = ((const uint4*)(ur + 512))[1];
    cf0 = ((const uint4*)(ur + 768 + d * 256))[0]; cf1 = ((const uint4*)(ur + 768 + d * 256))[1];
    cv0 = ((const uint4*)(ur + 1280))[0]; cv1 = ((const uint4*)(ur + 1280))[1];
  }
  for (int s = 0; s < 36; ++s) {
    const StepGeo g = step_geo(L, b, d, s);
    const bf16_t* urn = U;
    if (s + 1 < 36) {
      StepGeo g2 = step_geo(L, b, d, s + 1);
      urn = U + (size_t)(g2.rowbase + (d ? g2.T0 + 63 - ti : g2.T0 + ti)) * INP + h * 64 + kq;
    }
    float qv[16], kkv[16];
    {
      uint4 cq[2] = {cq0, cq1}, cf[2] = {cf0, cf1};
#pragma unroll
      for (int e = 0; e < 16; ++e) {
        float qr = unpk(cq, e), fr_ = unpk(cf, e);
        qv[e] = siluf_(qr);
        float f = lb[e] + (1.f - lb[e]) * sigmoidf_(fr_);
        kkv[e] = 1.f - f;
        CUM[ti * 65 + kq + e] = fmaxf(__builtin_amdgcn_logf(f), -115.41560327111707f);
      }
    }
    if (s + 1 < 36) {
      cq0 = ((const uint4*)(urn + 512))[0]; cq1 = ((const uint4*)(urn + 512))[1];
      cf0 = ((const uint4*)(urn + 768 + d * 256))[0]; cf1 = ((const uint4*)(urn + 768 + d * 256))[1];
    }
    __syncthreads();
    {
      float run = 0.f;
#pragma unroll
      for (int r = 0; r < 16; ++r) { int idx = (w * 16 + r) * 65 + lane; run += CUM[idx]; CUM[idx] = run; }
      SEG[w * 64 + lane] = run;
    }
    __syncthreads();
    {
      float off = 0.f;
      for (int s2 = 0; s2 < w; ++s2) off += SEG[s2 * 64 + lane];
      if (w > 0) {
#pragma unroll
        for (int r = 0; r < 16; ++r) CUM[(w * 16 + r) * 65 + lane] += off;
      }
    }
    __syncthreads();
    {
      const int tsw = ti ^ (16 * (tid & 3));
      uint4 cv[2] = {cv0, cv1};
      unsigned qp[8], kp[8];
#pragma unroll
      for (int e2 = 0; e2 < 8; ++e2) {
        float qa[2], ka[2];
#pragma unroll
        for (int u = 0; u < 2; ++u) {
          const int e = e2 * 2 + u, k = kq + e;
          float ci = CUM[ti * 65 + k], cm = CUM[31 * 65 + k], ce = CUM[63 * 65 + k];
          qa[u] = qv[e] * fexp2(fminf(ci - cm, 115.41560327111707f));
          ka[u] = kkv[e] * fexp2(fminf(cm - ci, 115.41560327111707f));
          KE[k * TS + tsw] = f2bf(kkv[e] * fexp2(ce - ci));
          VT[k * TS + tsw] = unpk_raw(cv, e);
        }
        qp[e2] = pack2(qa[0], qa[1]);
        kp[e2] = pack2(ka[0], ka[1]);
      }
      uint4* qd = (uint4*)(QT + ti * TS + kq);
      uint4* kd = (uint4*)(KT + ti * TS + kq);
      qd[0] = make_uint4(qp[0], qp[1], qp[2], qp[3]); qd[1] = make_uint4(qp[4], qp[5], qp[6], qp[7]);
      kd[0] = make_uint4(kp[0], kp[1], kp[2], kp[3]); kd[1] = make_uint4(kp[4], kp[5], kp[6], kp[7]);
    }
    if (s + 1 < 36) { cv0 = ((const uint4*)(urn + 1280))[0]; cv1 = ((const uint4*)(urn + 1280))[1]; }
    float dec[4];
#pragma unroll
    for (int nf = 0; nf < 4; ++nf) {
      const int k = nf * 16 + fr;
      float em = fexp2(CUM[31 * 65 + k]);
      dec[nf] = fexp2(CUM[63 * 65 + k]);
#pragma unroll
      for (int jj = 0; jj < 4; ++jj) ST[(16 * w + 4 * fq + jj) * TS + k] = f2bf(S[nf][jj] * em);
    }
    __syncthreads();
    const size_t orow = (size_t)(g.rowbase + (d ? g.T0 + 63 - ti : g.T0 + ti));
    uint4 pp0 = make_uint4(0u, 0u, 0u, 0u), pp1 = pp0, pg0 = pp0, pg1 = pp0;
    if (g.wout && g.second) {
      const uint4* pr = (const uint4*)(Y + orow * DM + 256 + h * 64 + kq);
      const uint4* gr = (const uint4*)(U + orow * INP + 1536 + h * 64 + kq);
      pp0 = pr[0]; pp1 = pr[1]; pg0 = gr[0]; pg1 = gr[1];
    }
    f32x4 aP[4], aY[4];
#pragma unroll
    for (int nf = 0; nf < 4; ++nf) { aP[nf] = (f32x4){0.f, 0.f, 0.f, 0.f}; aY[nf] = (f32x4){0.f, 0.f, 0.f, 0.f}; }
    mma16(QT, 16 * w, KT, aP, fr, fq);
    mma16(QT, 16 * w, ST, aY, fr, fq);
    CFENCE();
#pragma unroll
    for (int nf = 0; nf < 4; ++nf)
#pragma unroll
      for (int jj = 0; jj < 4; ++jj) {
        const int t = 16 * w + 4 * fq + jj, sc = nf * 16 + fr;
        QT[t * TS + sc] = f2bf(sc <= t ? aP[nf][jj] : 0.f);
      }
    CFENCE();
    mma16<false, true>(QT, 16 * w, VT, aY, fr, fq);
#pragma unroll
    for (int nf = 0; nf < 4; ++nf)
#pragma unroll
      for (int jj = 0; jj < 4; ++jj) S[nf][jj] *= dec[nf];
    mma16<true, true>(VT, 16 * w, KE, S, fr, fq);
    {
      float* OT = CUM;
#pragma unroll
      for (int nf = 0; nf < 4; ++nf)
#pragma unroll
        for (int jj = 0; jj < 4; ++jj) OT[(16 * w + 4 * fq + jj) * 65 + nf * 16 + fr] = aY[nf][jj];
      __syncthreads();
      if (g.wout) {
        float v[16];
#pragma unroll
        for (int e = 0; e < 16; ++e) v[e] = OT[ti * 65 + kq + e];
        if (g.second) {
          const uint4 pp[2] = {pp0, pp1}, pg[2] = {pg0, pg1};
          float ss = 0.f;
#pragma unroll
          for (int e = 0; e < 16; ++e) { v[e] += unpk(pp, e); ss += v[e] * v[e]; }
          ss += dppf<0xB1>(ss); ss += dppf<0x4E>(ss);
          const float rn = rsqrtf(ss * (1.f / 64.f) + EPSF);
          const float4* nwp = (const float4*)(p.in[I_HNW] + L * 256 + h * 64 + kq);
#pragma unroll
          for (int q4 = 0; q4 < 4; ++q4) {
            const float4 nw4 = nwp[q4];
            v[q4 * 4 + 0] *= rn * nw4.x * siluf_(unpk(pg, q4 * 4 + 0));
            v[q4 * 4 + 1] *= rn * nw4.y * siluf_(unpk(pg, q4 * 4 + 1));
            v[q4 * 4 + 2] *= rn * nw4.z * siluf_(unpk(pg, q4 * 4 + 2));
            v[q4 * 4 + 3] *= rn * nw4.w * siluf_(unpk(pg, q4 * 4 + 3));
          }
        }
        uint4* yo = (uint4*)(Y + orow * DM + 256 + h * 64 + kq);
        yo[0] = make_uint4(pack2(v[0], v[1]), pack2(v[2], v[3]), pack2(v[4], v[5]), pack2(v[6], v[7]));
        yo[1] = make_uint4(pack2(v[8], v[9]), pack2(v[10], v[11]), pack2(v[12], v[13]), pack2(v[14], v[15]));
      }
    }
  }
  __syncthreads();
}

__device__ __forceinline__ void chain_ssd_fast(const Params& p, int L, int bh) {
  const int b = bh >> 2, h = bh & 3, gg = h >> 1;
  int tx_ = threadIdx.x; asm volatile("" : "+v"(tx_));
  const int d = tx_ >> 8, tid = tx_ & 255;
  char* sm = dynsmem + d * GROUP_LDS;
  bf16_t* RAW = (bf16_t*)sm;
  bf16_t* CM = (bf16_t*)(sm + 26112);
  bf16_t* BM = CM + 64 * TS;
  bf16_t* XT = BM + 64 * TS;
  bf16_t* BW = XT + 64 * TS;
  bf16_t* SS = BW + 64 * TS;
  float* DT = (float*)(SS + 64 * TS);
  float* CUMV = DT + 64;
  float* CW = CUMV + 64;
  float* CB = CW + 768;
  const int w = tid >> 6, lane = tid & 63, fr = lane & 15, fq = lane >> 4;
  const int ti = tid >> 2, kq = (tid & 3) * 16;
  const bf16_t* U = (const bf16_t*)(p.ws + OFF_U);
  bf16_t* Y = (bf16_t*)(p.ws + OFF_ACTA);
  __syncthreads();
  for (int i = tid; i < 960; i += 256) {
    if (i < 768) {
      int grp = i >> 8, j = (i >> 6) & 3, c = i & 63;
      int col = grp == 0 ? h * 64 + c : (grp == 1 ? 256 + gg * 64 + c : 384 + gg * 64 + c);
      CW[i] = p.in[I_SCW][(L * 4 + j) * 512 + col];
    } else {
      int i2 = i - 768; int grp = i2 >> 6, c = i2 & 63;
      int col = grp == 0 ? h * 64 + c : (grp == 1 ? 256 + gg * 64 + c : 384 + gg * 64 + c);
      CB[i2] = p.in[I_SCB][L * 512 + col];
    }
  }
  const float dsk = p.in[I_SDSK][L * 4 + h];
  const float Aa = -expf(p.in[I_SALOG][(L * 2 + d) * 4 + h]);
  const float dtb = p.in[I_SDTB][(L * 2 + d) * 4 + h];
  f32x4 S[4];
#pragma unroll
  for (int nf = 0; nf < 4; ++nf) S[nf] = (f32x4){0.f, 0.f, 0.f, 0.f};
  uint4 nr0, nr1, nr2, nr3, nr4, nr5, nr6;
  bf16_t ndt = 0;
#define SSD_LD1(I, DST)                                                                                  \
  {                                                                                                      \
    int c16 = tid + 256 * (I);                                                                           \
    uint4 v = make_uint4(0u, 0u, 0u, 0u);                                                                \
    if (c16 < 1632) {                                                                                    \
      int grp = c16 / 544, rem = c16 % 544, r = rem >> 3, part = rem & 7;                                \
      int t = G_.T0 - 2 + r;                                                                             \
      int gcol = grp == 0 ? 2048 + h * 64 : (grp == 1 ? 2304 + gg * 64 : 2432 + gg * 64);               \
      if (t >= 0 && t < G_.seglen) v = *(const uint4*)(U + (size_t)(G_.rowbase + t) * INP + gcol + part * 8); \
    }                                                                                                    \
    DST = v;                                                                                             \
  }
#define SSD_LOAD()                                                                                       \
  {                                                                                                      \
    SSD_LD1(0, nr0) SSD_LD1(1, nr1) SSD_LD1(2, nr2) SSD_LD1(3, nr3) SSD_LD1(4, nr4) SSD_LD1(5, nr5) SSD_LD1(6, nr6) \
    if (tid < 64) ndt = U[(size_t)(G_.rowbase + (d ? G_.T0 + 63 - tid : G_.T0 + tid)) * INP + 2560 + d * 4 + h]; \
  }
#define SSD_ST1(I, SRC) { int c16 = tid + 256 * (I); if (c16 < 1632) *(uint4*)(RAW + c16 * 8) = SRC; }
  { StepGeo G_ = step_geo(L, b, d, 0); SSD_LOAD(); }
  for (int s = 0; s < 36; ++s) {
    const StepGeo g = step_geo(L, b, d, s);
    __syncthreads();
    SSD_ST1(0, nr0) SSD_ST1(1, nr1) SSD_ST1(2, nr2) SSD_ST1(3, nr3) SSD_ST1(4, nr4) SSD_ST1(5, nr5) SSD_ST1(6, nr6)
    if (tid < 64) {
      float dt = softplusf_(bf2f(ndt) + dtb);
      float v = dt * Aa * 1.4426950408889634f;
#pragma unroll
      for (int o = 1; o < 64; o <<= 1) { float n = __shfl_up(v, o); if (lane >= o) v += n; }
      DT[tid] = dt; CUMV[tid] = v;
    }
    if (s + 1 < 36) { StepGeo G_ = step_geo(L, b, d, s + 1); SSD_LOAD(); }
    __syncthreads();
    {
      const int tn = d ? 63 - ti : ti;
      const int tsw = ti ^ (16 * (tid & 3));
      const float cend = CUMV[63];
      const float wend = DT[ti] * fexp2(cend - CUMV[ti]);
#pragma unroll
      for (int grp = 0; grp < 3; ++grp) {
        float val[16];
#pragma unroll
        for (int e = 0; e < 16; ++e) val[e] = CB[grp * 64 + kq + e];
#pragma unroll
        for (int j = 0; j < 4; ++j) {
          const uint4* rp = (const uint4*)(RAW + (grp * 68 + tn + j) * 64 + kq);
          uint4 rr[2] = {rp[0], rp[1]};
#pragma unroll
          for (int e = 0; e < 16; ++e) val[e] += unpk(rr, e) * CW[(grp * 4 + j) * 64 + kq + e];
        }
#pragma unroll
        for (int e = 0; e < 16; ++e) val[e] = siluf_(val[e]);
        if (grp == 0) {
#pragma unroll
          for (int e = 0; e < 16; ++e) XT[(kq + e) * TS + tsw] = f2bf(val[e]);
        } else {
          unsigned pk[8];
#pragma unroll
          for (int e2 = 0; e2 < 8; ++e2) pk[e2] = pack2(val[2 * e2], val[2 * e2 + 1]);
          uint4* dst = (uint4*)((grp == 1 ? BM : CM) + ti * TS + kq);
          dst[0] = make_uint4(pk[0], pk[1], pk[2], pk[3]); dst[1] = make_uint4(pk[4], pk[5], pk[6], pk[7]);
          if (grp == 1) {
#pragma unroll
            for (int e = 0; e < 16; ++e) BW[(kq + e) * TS + tsw] = f2bf(val[e] * wend);
          }
        }
      }
    }
    float cumt[4], cums[4], dts[4];
    const float cend = CUMV[63];
#pragma unroll
    for (int jj = 0; jj < 4; ++jj) cumt[jj] = CUMV[16 * w + 4 * fq + jj];
#pragma unroll
    for (int nf = 0; nf < 4; ++nf) {
      cums[nf] = CUMV[nf * 16 + fr]; dts[nf] = DT[nf * 16 + fr];
#pragma unroll
      for (int jj = 0; jj < 4; ++jj) SS[(16 * w + 4 * fq + jj) * TS + nf * 16 + fr] = f2bf(S[nf][jj]);
    }
    __syncthreads();
    const size_t orow = (size_t)(g.rowbase + (d ? g.T0 + 63 - ti : g.T0 + ti));
    uint4 pp0 = make_uint4(0u, 0u, 0u, 0u), pp1 = pp0, pz0 = pp0, pz1 = pp0;
    if (g.wout && g.second) {
      const uint4* pr = (const uint4*)(Y + orow * DM + 512 + h * 64 + kq);
      const uint4* zr = (const uint4*)(U + orow * INP + 1792 + h * 64 + kq);
      pp0 = pr[0]; pp1 = pr[1]; pz0 = zr[0]; pz1 = zr[1];
    }
    f32x4 aP[4], aY[4];
#pragma unroll
    for (int nf = 0; nf < 4; ++nf) { aP[nf] = (f32x4){0.f, 0.f, 0.f, 0.f}; aY[nf] = (f32x4){0.f, 0.f, 0.f, 0.f}; }
    mma16(CM, 16 * w, BM, aP, fr, fq);
    mma16(CM, 16 * w, SS, aY, fr, fq);
    CFENCE();
#pragma unroll
    for (int nf = 0; nf < 4; ++nf)
#pragma unroll
      for (int jj = 0; jj < 4; ++jj) {
        const int t = 16 * w + 4 * fq + jj, sc = nf * 16 + fr;
        float pv = sc <= t ? aP[nf][jj] * fexp2(cumt[jj] - cums[nf]) * dts[nf] : 0.f;
        CM[t * TS + sc] = f2bf(pv);
        aY[nf][jj] *= fexp2(cumt[jj]);
      }
    CFENCE();
    mma16<false, true>(CM, 16 * w, XT, aY, fr, fq);
    {
      const float de = fexp2(cend);
#pragma unroll
      for (int nf = 0; nf < 4; ++nf)
#pragma unroll
        for (int jj = 0; jj < 4; ++jj) S[nf][jj] *= de;
    }
    mma16<true, true>(XT, 16 * w, BW, S, fr, fq);
    {
      float* OT = (float*)RAW;
#pragma unroll
      for (int nf = 0; nf < 4; ++nf)
#pragma unroll
        for (int jj = 0; jj < 4; ++jj) OT[(16 * w + 4 * fq + jj) * 65 + nf * 16 + fr] = aY[nf][jj];
      __syncthreads();
      if (g.wout) {
        float v[16];
#pragma unroll
        for (int e = 0; e < 16; ++e) v[e] = OT[ti * 65 + kq + e];
        if (g.second) {
          const uint4 pp[2] = {pp0, pp1}, pz[2] = {pz0, pz1};
          const int tsw = ti ^ (16 * (tid & 3));
          float ssq = 0.f;
#pragma unroll
          for (int e = 0; e < 16; ++e) {
            const float tot = unpk(pp, e) + v[e] + dsk * bf2f(XT[(kq + e) * TS + tsw]);
            v[e] = tot * siluf_(unpk(pz, e));
            ssq += v[e] * v[e];
          }
          ssq += dppf<0xB1>(ssq); ssq += dppf<0x4E>(ssq);
          if ((tid & 3) == 0) ((float*)(p.ws + OFF_PSSQ))[orow * 4 + h] = ssq;
        }
        uint4* yo = (uint4*)(Y + orow * DM + 512 + h * 64 + kq);
        yo[0] = make_uint4(pack2(v[0], v[1]), pack2(v[2], v[3]), pack2(v[4], v[5]), pack2(v[6], v[7]));
        yo[1] = make_uint4(pack2(v[8], v[9]), pack2(v[10], v[11]), pack2(v[12], v[13]), pack2(v[14], v[15]));
      }
    }
  }
  __syncthreads();
#undef SSD_LOAD
#undef SSD_LD1
#undef SSD_ST1
}

__device__ __forceinline__ void chain_lru_fast(const Params& p, int L, int bh) {
  const int b = bh >> 2, h = bh & 3;
  int tx_ = threadIdx.x; asm volatile("" : "+v"(tx_));
  const int d = tx_ >> 8, tid = tx_ & 255;
  char* sm = dynsmem + d * GROUP_LDS;
  bf16_t* RAW = (bf16_t*)sm;
  bf16_t* XC = (bf16_t*)(sm + 8704);
  bf16_t* WR = XC + 64 * TS;
  bf16_t* WI = WR + 64 * TS;
  float* AA = (float*)(WI + 64 * TS);
  float* BB = AA + 64 * 65;
  float* SEGA = BB + 64 * 65;
  float* SEGB = SEGA + 256;
  float* CW = SEGB + 256;
  float* CB = CW + 256;
  const int w = tid >> 6, lane = tid & 63, fr = lane & 15, fq = lane >> 4;
  const int ti = tid >> 2, kq = (tid & 3) * 16;
  const bf16_t* U = (const bf16_t*)(p.ws + OFF_U);
  bf16_t* Y = (bf16_t*)(p.ws + OFF_ACTA);
  __syncthreads();
  for (int i = tid; i < 320; i += 256) {
    if (i < 256) CW[i] = p.in[I_LCW][(L * 4 + (i >> 6)) * 256 + h * 64 + (i & 63)];
    else CB[i - 256] = p.in[I_LCB][L * 256 + h * 64 + (i - 256)];
  }
  {
    const bf16_t* wrs = (const bf16_t*)(p.ws + OFF_LRUW) + (size_t)(((L * 2 + d) * 2 + 0) * 4 + h) * 4096;
    const bf16_t* wis = (const bf16_t*)(p.ws + OFF_LRUW) + (size_t)(((L * 2 + d) * 2 + 1) * 4 + h) * 4096;
    for (int c = tid; c < 512; c += 256) {
      int r = c >> 3, part = c & 7;
      *(uint4*)(WR + r * TS + part * 8) = *(const uint4*)(wrs + r * 64 + part * 8);
      *(uint4*)(WI + r * TS + part * 8) = *(const uint4*)(wis + r * 64 + part * 8);
    }
  }
  float br[4], bi[4], sp[4];
#pragma unroll
  for (int nf = 0; nf < 4; ++nf) {
    const int ch = (L * 2 + d) * 256 + h * 64 + nf * 16 + fr;
    br[nf] = p.in[I_LBR][ch]; bi[nf] = p.in[I_LBI][ch]; sp[nf] = softplusf_(-p.in[I_LLAM][ch]);
  }
  float hst = 0.f;
  uint4 nr0, nr1, nr2;
#define LRU_LD1(I, DST)                                                                                  \
  {                                                                                                      \
    int c16 = tid + 256 * (I);                                                                           \
    uint4 v = make_uint4(0u, 0u, 0u, 0u);                                                                \
    if (c16 < 544) {                                                                                     \
      int r = c16 >> 3, part = c16 & 7;                                                                  \
      int t = G_.T0 - 2 + r;                                                                             \
      if (t >= 0 && t < G_.seglen) v = *(const uint4*)(U + (size_t)(G_.rowbase + t) * INP + h * 64 + part * 8); \
    }                                                                                                    \
    DST = v;                                                                                             \
  }
#define LRU_ST1(I, SRC) { int c16 = tid + 256 * (I); if (c16 < 544) *(uint4*)(RAW + c16 * 8) = SRC; }
  { StepGeo G_ = step_geo(L, b, d, 0); LRU_LD1(0, nr0) LRU_LD1(1, nr1) LRU_LD1(2, nr2) }
  for (int s = 0; s < 36; ++s) {
    const StepGeo g = step_geo(L, b, d, s);
    __syncthreads();
    LRU_ST1(0, nr0) LRU_ST1(1, nr1) LRU_ST1(2, nr2)
    if (s + 1 < 36) { StepGeo G_ = step_geo(L, b, d, s + 1); LRU_LD1(0, nr0) LRU_LD1(1, nr1) LRU_LD1(2, nr2) }
    __syncthreads();
    {
      const int tn = d ? 63 - ti : ti;
      float val[16];
#pragma unroll
      for (int e = 0; e < 16; ++e) val[e] = CB[kq + e];
#pragma unroll
      for (int j = 0; j < 4; ++j) {
        const uint4* rp = (const uint4*)(RAW + (tn + j) * 64 + kq);
        uint4 rr[2] = {rp[0], rp[1]};
#pragma unroll
        for (int e = 0; e < 16; ++e) val[e] += unpk(rr, e) * CW[j * 64 + kq + e];
      }
      unsigned pk[8];
#pragma unroll
      for (int e2 = 0; e2 < 8; ++e2) pk[e2] = pack2(val[2 * e2], val[2 * e2 + 1]);
      uint4* dst = (uint4*)(XC + ti * TS + kq);
      dst[0] = make_uint4(pk[0], pk[1], pk[2], pk[3]); dst[1] = make_uint4(pk[4], pk[5], pk[6], pk[7]);
    }
    __syncthreads();
    {
      f32x4 aR[4], aI[4];
#pragma unroll
      for (int nf = 0; nf < 4; ++nf) { aR[nf] = (f32x4){0.f, 0.f, 0.f, 0.f}; aI[nf] = (f32x4){0.f, 0.f, 0.f, 0.f}; }
      mma16(XC, 16 * w, WR, aR, fr, fq);
      mma16(XC, 16 * w, WI, aI, fr, fq);
#pragma unroll
      for (int nf = 0; nf < 4; ++nf)
#pragma unroll
        for (int jj = 0; jj < 4; ++jj) {
          const int t = 16 * w + 4 * fq + jj, e = nf * 16 + fr;
          float r = sigmoidf_(aR[nf][jj] + br[nf]);
          float ig = sigmoidf_(aI[nf][jj] + bi[nf]);
          float la = -8.f * r * sp[nf];
          float xcv = bf2f(XC[t * TS + e]);
          const float av = fexp(la);
          AA[t * 65 + e] = av;
          BB[t * 65 + e] = __builtin_amdgcn_sqrtf(fmaxf(fmaf(-av, av, 1.f), 0.f)) * (ig * xcv);
        }
    }
    __syncthreads();
    const size_t orow = (size_t)(g.rowbase + (d ? g.T0 + 63 - ti : g.T0 + ti));
    uint4 pp0 = make_uint4(0u, 0u, 0u, 0u), pp1 = pp0, pg0 = pp0, pg1 = pp0;
    if (g.wout && g.second) {
      const uint4* pr = (const uint4*)(Y + orow * DM + h * 64 + kq);
      const uint4* gr = (const uint4*)(U + orow * INP + 256 + h * 64 + kq);
      pp0 = pr[0]; pp1 = pr[1]; pg0 = gr[0]; pg1 = gr[1];
    }
    {
      float A = 1.f, B = 0.f;
#pragma unroll
      for (int r = 0; r < 16; ++r) { float a = AA[(w * 16 + r) * 65 + lane], bb = BB[(w * 16 + r) * 65 + lane]; B = a * B + bb; A = a * A; }
      SEGA[w * 64 + lane] = A; SEGB[w * 64 + lane] = B;
    }
    __syncthreads();
    {
      float hin = hst, hall = hst;
#pragma unroll
      for (int s2 = 0; s2 < 4; ++s2) {
        float a = SEGA[s2 * 64 + lane], bb = SEGB[s2 * 64 + lane];
        hall = a * hall + bb;
        if (s2 < w) hin = a * hin + bb;
      }
      hst = hall;
      float hv = hin;
      float* OT = (float*)RAW;
#pragma unroll
      for (int r = 0; r < 16; ++r) {
        const int t = w * 16 + r;
        hv = AA[t * 65 + lane] * hv + BB[t * 65 + lane];
        OT[t * 65 + lane] = hv;
      }
    }
    __syncthreads();
    if (g.wout) {
      const float* OT = (const float*)RAW;
      float v[16];
#pragma unroll
      for (int e = 0; e < 16; ++e) v[e] = OT[ti * 65 + kq + e];
      if (g.second) {
        const uint4 pp[2] = {pp0, pp1}, pg[2] = {pg0, pg1};
#pragma unroll
        for (int e = 0; e < 16; ++e) v[e] = (unpk(pp, e) + v[e]) * gelu_tanh(unpk(pg, e));
      }
      uint4* yo = (uint4*)(Y + orow * DM + h * 64 + kq);
      yo[0] = make_uint4(pack2(v[0], v[1]), pack2(v[2], v[3]), pack2(v[4], v[5]), pack2(v[6], v[7]));
      yo[1] = make_uint4(pack2(v[8], v[9]), pack2(v[10], v[11]), pack2(v[12], v[13]), pack2(v[14], v[15]));
    }
  }
  __syncthreads();
#undef LRU_LD1
#undef LRU_ST1
}

__device__ __forceinline__ void mlaproj_item_fast(const Params& p, int L, int item) {
  char* sm = dynsmem;
  bf16_t* AQ = (bf16_t*)sm;
  bf16_t* AKV = AQ + 128 * 200;
  bf16_t* WB = AKV + 128 * 136;
  bf16_t* OT = WB + 19200;
  int tx_ = threadIdx.x; asm volatile("" : "+v"(tx_));
  const int tid = tx_, w = tid >> 6, lane = tid & 63, fr = lane & 15, fq = lane >> 4;
  const int ti = tid >> 2, part = tid & 3;
  const bf16_t* U = (const bf16_t*)(p.ws + OFF_U);
  const bf16_t* WQT = (const bf16_t*)(p.ws + OFF_WQT) + (size_t)L * 384 * 192;
  const bf16_t* WKVT = (const bf16_t*)(p.ws + OFF_WKVT) + (size_t)L * 512 * 128;
  const float* ROPE = (const float*)(p.ws + OFF_ROPE);
  const float* qan = p.in[I_MQAN] + L * 192;
  const float* kvan = p.in[I_MKVAN] + L * 128;
  const float* qn = p.in[I_MQN] + L * 96;
  const float* kn = p.in[I_MKN] + L * 96;
  bf16_t* QB = (bf16_t*)(p.ws + OFF_ACTB + QB_OFF);
  bf16_t* KB = (bf16_t*)(p.ws + OFF_ACTB + KB_OFF);
  bf16_t* VB = (bf16_t*)(p.ws + OFF_ACTB + VB_OFF);
  const int row0 = item * 128;
  const bool lat = row0 < NLAT;
  const int b = lat ? (row0 >> 11) : ((row0 - NLAT) >> 8);
  const int n0 = lat ? (row0 & 2047) : ((row0 - NLAT) & 255);
  const int key0 = lat ? CTXL + n0 : n0;
  uint4 w0, w1, w2, w3, w4;
#define WLOADQ(HH) { const bf16_t* base = WQT + (size_t)(HH) * 96 * 192; \
    { int c = tid;        w0 = *(const uint4*)(base + (c / 24) * 192 + (c % 24) * 8); } \
    { int c = tid + 512;  w1 = *(const uint4*)(base + (c / 24) * 192 + (c % 24) * 8); } \
    { int c = tid + 1024; w2 = *(const uint4*)(base + (c / 24) * 192 + (c % 24) * 8); } \
    { int c = tid + 1536; w3 = *(const uint4*)(base + (c / 24) * 192 + (c % 24) * 8); } \
    { int c = tid + 2048; if (c < 2304) w4 = *(const uint4*)(base + (c / 24) * 192 + (c % 24) * 8); } }
#define WSTOREQ() { \
    { int c = tid;        *(uint4*)(WB + (c / 24) * 200 + (c % 24) * 8) = w0; } \
    { int c = tid + 512;  *(uint4*)(WB + (c / 24) * 200 + (c % 24) * 8) = w1; } \
    { int c = tid + 1024; *(uint4*)(WB + (c / 24) * 200 + (c % 24) * 8) = w2; } \
    { int c = tid + 1536; *(uint4*)(WB + (c / 24) * 200 + (c % 24) * 8) = w3; } \
    { int c = tid + 2048; if (c < 2304) *(uint4*)(WB + (c / 24) * 200 + (c % 24) * 8) = w4; } }
#define WLOADKV(HH) { const bf16_t* base = WKVT + (size_t)(HH) * 128 * 128; \
    { int c = tid;        w0 = *(const uint4*)(base + (c >> 4) * 128 + (c & 15) * 8); } \
    { int c = tid + 512;  w1 = *(const uint4*)(base + (c >> 4) * 128 + (c & 15) * 8); } \
    { int c = tid + 1024; w2 = *(const uint4*)(base + (c >> 4) * 128 + (c & 15) * 8); } \
    { int c = tid + 1536; w3 = *(const uint4*)(base + (c >> 4) * 128 + (c & 15) * 8); } }
#define WSTOREKV() { \
    { int c = tid;        *(uint4*)(WB + (c >> 4) * 136 + (c & 15) * 8) = w0; } \
    { int c = tid + 512;  *(uint4*)(WB + (c >> 4) * 136 + (c & 15) * 8) = w1; } \
    { int c = tid + 1024; *(uint4*)(WB + (c >> 4) * 136 + (c & 15) * 8) = w2; } \
    { int c = tid + 1536; *(uint4*)(WB + (c >> 4) * 136 + (c & 15) * 8) = w3; } }
  w4 = make_uint4(0u, 0u, 0u, 0u);
  __syncthreads();
  WLOADQ(0);
  {
    const bf16_t* ur = U + (size_t)(row0 + ti) * INP + 2568;
    uint4 q6[6], k4[4], r1;
#pragma unroll
    for (int i = 0; i < 6; ++i) q6[i] = *(const uint4*)(ur + part * 48 + i * 8);
#pragma unroll
    for (int i = 0; i < 4; ++i) k4[i] = *(const uint4*)(ur + 192 + part * 32 + i * 8);
    r1 = *(const uint4*)(ur + 320 + part * 8);
    float sq = 0.f, sk = 0.f, sr = 0.f;
    float qf[48], kf[32], rf[8];
#pragma unroll
    for (int i = 0; i < 6; ++i) {
      const unsigned wv[4] = {q6[i].x, q6[i].y, q6[i].z, q6[i].w};
#pragma unroll
      for (int j = 0; j < 4; ++j) { float a = __uint_as_float(wv[j] << 16), c = __uint_as_float(wv[j] & 0xffff0000u); qf[i * 8 + 2 * j] = a; qf[i * 8 + 2 * j + 1] = c; sq += a * a + c * c; }
    }
#pragma unroll
    for (int i = 0; i < 4; ++i) {
      const unsigned wv[4] = {k4[i].x, k4[i].y, k4[i].z, k4[i].w};
#pragma unroll
      for (int j = 0; j < 4; ++j) { float a = __uint_as_float(wv[j] << 16), c = __uint_as_float(wv[j] & 0xffff0000u); kf[i * 8 + 2 * j] = a; kf[i * 8 + 2 * j + 1] = c; sk += a * a + c * c; }
    }
    {
      const unsigned wv[4] = {r1.x, r1.y, r1.z, r1.w};
#pragma unroll
      for (int j = 0; j < 4; ++j) { float a = __uint_as_float(wv[j] << 16), c = __uint_as_float(wv[j] & 0xffff0000u); rf[2 * j] = a; rf[2 * j + 1] = c; sr += a * a + c * c; }
    }
    sq += dppf<0xB1>(sq); sq += dppf<0x4E>(sq);
    sk += dppf<0xB1>(sk); sk += dppf<0x4E>(sk);
    sr += dppf<0xB1>(sr); sr += dppf<0x4E>(sr);
    const float rq = rsqrtf(sq * (1.f / 192.f) + EPSF), rk = rsqrtf(sk * (1.f / 128.f) + EPSF), rr = rsqrtf(sr * (1.f / 32.f) + EPSF);
#pragma unroll
    for (int i = 0; i < 6; ++i) {
      unsigned pk[4];
#pragma unroll
      for (int j = 0; j < 4; ++j) { int c = part * 48 + i * 8 + 2 * j; pk[j] = pack2(qf[i * 8 + 2 * j] * rq * qan[c], qf[i * 8 + 2 * j + 1] * rq * qan[c + 1]); }
      *(uint4*)(AQ + ti * 200 + part * 48 + i * 8) = make_uint4(pk[0], pk[1], pk[2], pk[3]);
    }
#pragma unroll
    for (int i = 0; i < 4; ++i) {
      unsigned pk[4];
#pragma unroll
      for (int j = 0; j < 4; ++j) { int c = part * 32 + i * 8 + 2 * j; pk[j] = pack2(kf[i * 8 + 2 * j] * rk * kvan[c], kf[i * 8 + 2 * j + 1] * rk * kvan[c + 1]); }
      *(uint4*)(AKV + ti * 136 + part * 32 + i * 8) = make_uint4(pk[0], pk[1], pk[2], pk[3]);
    }
    {
      const int n = n0 + ti;
      unsigned pk[4];
#pragma unroll
      for (int j = 0; j < 4; ++j) {
        const int c = part * 8 + 2 * j, pi = c >> 1;
        float t1 = rf[2 * j] * rr * kn[64 + c], t2 = rf[2 * j + 1] * rr * kn[64 + c + 1];
        if (lat) {
          float cs = ROPE[(n * 16 + pi) * 2], sn = ROPE[(n * 16 + pi) * 2 + 1];
          float o1 = t1 * cs - t2 * sn, o2 = t1 * sn + t2 * cs;
          t1 = o1; t2 = o2;
        }
        pk[j] = pack2(t1, t2);
      }
      const uint4 kv4 = make_uint4(pk[0], pk[1], pk[2], pk[3]);
#pragma unroll
      for (int hh = 0; hh < 4; ++hh) *(uint4*)(KB + (((size_t)(b * 4 + hh)) * NKEY + key0 + ti) * 96 + 64 + part * 8) = kv4;
    }
  }
  WSTOREQ();
  __syncthreads();
  const float qscale = 0.10206207261596577f * 1.4426950408889634f;
  float qnv[6], knv[4], rcs[4][2], rsn[4][2];
#pragma unroll
  for (int nf = 0; nf < 6; ++nf) qnv[nf] = qn[nf * 16 + fr];
#pragma unroll
  for (int nf = 0; nf < 4; ++nf) knv[nf] = kn[nf * 16 + fr];
#pragma unroll
  for (int jj = 0; jj < 4; ++jj)
#pragma unroll
    for (int q2 = 0; q2 < 2; ++q2) {
      const int n = n0 + 16 * w + 4 * fq + jj, pi = (q2 * 16 + fr) >> 1;
      rcs[jj][q2] = lat ? ROPE[(n * 16 + pi) * 2] : 1.f;
      rsn[jj][q2] = lat ? ROPE[(n * 16 + pi) * 2 + 1] : 0.f;
    }
  for (int hh = 0; hh < 4; ++hh) {
    if (hh < 3) { WLOADQ(hh + 1); } else { WLOADKV(0); }
    f32x4 acc[6];
#pragma unroll
    for (int nf = 0; nf < 6; ++nf) acc[nf] = (f32x4){0.f, 0.f, 0.f, 0.f};
#pragma unroll
    for (int ks = 0; ks < 6; ++ks) {
      bf16x8 a = *(const bf16x8*)(AQ + (16 * w + fr) * 200 + ks * 32 + fq * 8);
#pragma unroll
      for (int nf = 0; nf < 6; ++nf) {
        bf16x8 bb = *(const bf16x8*)(WB + (nf * 16 + fr) * 200 + ks * 32 + fq * 8);
        acc[nf] = __builtin_amdgcn_mfma_f32_16x16x32_bf16(a, bb, acc[nf], 0, 0, 0);
      }
    }
#pragma unroll
    for (int jj = 0; jj < 4; ++jj) {
      const int rl = 16 * w + 4 * fq + jj;
      float s1 = 0.f, s2 = 0.f;
#pragma unroll
      for (int nf = 0; nf < 4; ++nf) s1 += acc[nf][jj] * acc[nf][jj];
      s2 = acc[4][jj] * acc[4][jj] + acc[5][jj] * acc[5][jj];
      s1 = sum16(s1); s2 = sum16(s2);
      const float r1 = rsqrtf(s1 * (1.f / 64.f) + EPSF) * qscale, r2 = rsqrtf(s2 * (1.f / 32.f) + EPSF) * qscale;
      bf16_t* qd = OT + rl * 104;
#pragma unroll
      for (int nf = 0; nf < 4; ++nf) qd[nf * 16 + fr] = f2bf(acc[nf][jj] * r1 * qnv[nf]);
#pragma unroll
      for (int nf = 4; nf < 6; ++nf) {
        float v = acc[nf][jj] * r2 * qnv[nf];
        float o = dppf<0xB1>(v);
        const float cs = rcs[jj][nf - 4], sn = rsn[jj][nf - 4];
        v = (fr & 1) ? (o * sn + v * cs) : (v * cs - o * sn);
        qd[64 + (nf - 4) * 16 + fr] = f2bf(v);
      }
    }
    __syncthreads();
#pragma unroll
    for (int i = 0; i < 3; ++i) {
      const int c = tid + 512 * i, r = c / 12, ch = c % 12;
      *(uint4*)(QB + ((size_t)(row0 + r) * 4 + hh) * 96 + ch * 8) = *(const uint4*)(OT + r * 104 + ch * 8);
    }
    if (hh < 3) { WSTOREQ(); } else { WSTOREKV(); }
    __syncthreads();
  }
  for (int hh = 0; hh < 4; ++hh) {
    if (hh < 3) { WLOADKV(hh + 1); }
    f32x4 acc[8];
#pragma unroll
    for (int nf = 0; nf < 8; ++nf) acc[nf] = (f32x4){0.f, 0.f, 0.f, 0.f};
#pragma unroll
    for (int ks = 0; ks < 4; ++ks) {
      bf16x8 a = *(const bf16x8*)(AKV + (16 * w + fr) * 136 + ks * 32 + fq * 8);
#pragma unroll
      for (int nf = 0; nf < 8; ++nf) {
        bf16x8 bb = *(const bf16x8*)(WB + (nf * 16 + fr) * 136 + ks * 32 + fq * 8);
        acc[nf] = __builtin_amdgcn_mfma_f32_16x16x32_bf16(a, bb, acc[nf], 0, 0, 0);
      }
    }
#pragma unroll
    for (int jj = 0; jj < 4; ++jj) {
      const int rl = 16 * w + 4 * fq + jj;
      float s1 = 0.f;
#pragma unroll
      for (int nf = 0; nf < 4; ++nf) s1 += acc[nf][jj] * acc[nf][jj];
      s1 = sum16(s1);
      const float r1 = rsqrtf(s1 * (1.f / 64.f) + EPSF);
      bf16_t* kd = OT + rl * 104;
#pragma unroll
      for (int nf = 0; nf < 4; ++nf) kd[nf * 16 + fr] = f2bf(acc[nf][jj] * r1 * knv[nf]);
    }
#pragma unroll
    for (int nf = 4; nf < 8; ++nf) {
      const int dd = (nf - 4) * 16 + fr;
      uint2 o;
      o.x = pack2(acc[nf][0], acc[nf][1]); o.y = pack2(acc[nf][2], acc[nf][3]);
      *(uint2*)(VB + (((size_t)(b * 4 + hh)) * 64 + dd) * NKEY + key0 + 32 * (w >> 1) + 8 * fq + 4 * (w & 1)) = o;
    }
    __syncthreads();
#pragma unroll
    for (int i = 0; i < 2; ++i) {
      const int c = tid + 512 * i, r = c >> 3, ch = c & 7;
      *(uint4*)(KB + (((size_t)(b * 4 + hh)) * NKEY + key0 + r) * 96 + ch * 8) = *(const uint4*)(OT + r * 104 + ch * 8);
    }
    if (hh < 3) {
      WSTOREKV();
      __syncthreads();
    }
  }
#undef WLOADQ
#undef WSTOREQ
#undef WLOADKV
#undef WSTOREKV
}

template <bool FIXC>
__device__ __forceinline__ void attn_item_fast(const Params& p, int L, int item, float negc) {
  char* sm = dynsmem;
  bf16_t* KT = (bf16_t*)sm;
  bf16_t* VT = (bf16_t*)(sm + 28672);
  int tx_ = threadIdx.x; asm volatile("" : "+v"(tx_));
  const int tid = tx_, w = tid >> 6, lane = tid & 63, fr = lane & 15, fq = lane >> 4;
  int b, h, rowq0, nkeys;
  if (item < 512) { int bh = item >> 3, qb = item & 7; b = bh >> 2; h = bh & 3; rowq0 = b * SEQ + qb * 256; nkeys = NKEY; }
  else { int bh = item - 512; b = bh >> 2; h = bh & 3; rowq0 = NLAT + b * CTXL; nkeys = CTXL; }
  const bf16_t* QB = (const bf16_t*)(p.ws + OFF_ACTB + QB_OFF);
  const bf16_t* KB = (const bf16_t*)(p.ws + OFF_ACTB + KB_OFF) + ((size_t)(b * 4 + h)) * NKEY * 96;
  const bf16_t* VB = (const bf16_t*)(p.ws + OFF_ACTB + VB_OFF) + ((size_t)(b * 4 + h)) * 64 * NKEY;
  bf16_t* Y = (bf16_t*)(p.ws + OFF_ACTA);
  bf16x8 qf[2][3];
#pragma unroll
  for (int m = 0; m < 2; ++m)
#pragma unroll
    for (int ks = 0; ks < 3; ++ks) qf[m][ks] = *(const bf16x8*)(QB + ((size_t)(rowq0 + w * 32 + m * 16 + fr) * 4 + h) * 96 + ks * 32 + fq * 8);
  f32x4 o[2][4];
  float mrow[2], lrow[2];
#pragma unroll
  for (int m = 0; m < 2; ++m) {
    mrow[m] = -1e30f; lrow[m] = 0.f;
#pragma unroll
    for (int j = 0; j < 4; ++j) o[m][j] = (f32x4){0.f, 0.f, 0.f, 0.f};
  }
  const f32x4 negc4 = (f32x4){negc, negc, negc, negc};
  uint4 pk0, pk1, pk2, pv0, pv1;
  const int kr0 = tid / 12, kp0 = tid % 12, kr1 = (tid + 512) / 12, kp1 = (tid + 512) % 12, kr2 = (tid + 1024) / 12, kp2 = (tid + 1024) % 12;
  const int vd0 = tid >> 4, vp0 = tid & 15, vd1 = (tid + 512) >> 4;
#define ATT_LOAD(K0)                                                                 \
  {                                                                                  \
    pk0 = *(const uint4*)(KB + (size_t)((K0) + kr0) * 96 + kp0 * 8);                 \
    pk1 = *(const uint4*)(KB + (size_t)((K0) + kr1) * 96 + kp1 * 8);                 \
    pk2 = *(const uint4*)(KB + (size_t)((K0) + kr2) * 96 + kp2 * 8);                 \
    pv0 = *(const uint4*)(VB + (size_t)vd0 * NKEY + (K0) + vp0 * 8);                 \
    pv1 = *(const uint4*)(VB + (size_t)vd1 * NKEY + (K0) + vp0 * 8);                 \
  }
#define ATT_STORE(BUF)                                                               \
  {                                                                                  \
    bf16_t* kt_ = KT + (BUF) * 23552; bf16_t* vt_ = VT + (BUF) * 23552;               \
    *(uint4*)(kt_ + kr0 * 112 + kp0 * 8) = pk0;                                      \
    *(uint4*)(kt_ + kr1 * 112 + kp1 * 8) = pk1;                                      \
    *(uint4*)(kt_ + kr2 * 112 + kp2 * 8) = pk2;                                      \
    *(uint4*)(vt_ + vd0 * 144 + vp0 * 8) = pv0;                                      \
    *(uint4*)(vt_ + vd1 * 144 + vp0 * 8) = pv1;                                      \
  }
  const int ntiles = nkeys >> 7;
  __syncthreads();
  ATT_LOAD(0);
  ATT_STORE(0);
  if (ntiles > 1) ATT_LOAD(128);
  for (int t = 0; t < ntiles; ++t) {
    __syncthreads();
    if (t + 1 < ntiles) {
      ATT_STORE((t + 1) & 1);
      if (t + 2 < ntiles) ATT_LOAD((t + 2) * 128);
    }
    const bf16_t* KTb = KT + (t & 1) * 23552;
    const bf16_t* VTb = VT + (t & 1) * 23552;
#pragma unroll
    for (int sub = 0; sub < 2; ++sub) {
      const bf16_t* KTs = KTb + sub * 64 * 112;
      f32x4 sacc[2][4];
#pragma unroll
      for (int m = 0; m < 2; ++m)
#pragma unroll
        for (int nf = 0; nf < 4; ++nf) sacc[m][nf] = FIXC ? negc4 : (f32x4){0.f, 0.f, 0.f, 0.f};
#pragma unroll
      for (int ks = 0; ks < 3; ++ks)
#pragma unroll
        for (int nf = 0; nf < 4; ++nf) {
          bf16x8 kb = *(const bf16x8*)(KTs + (nf * 16 + fr) * 112 + ks * 32 + fq * 8);
#pragma unroll
          for (int m = 0; m < 2; ++m) sacc[m][nf] = __builtin_amdgcn_mfma_f32_16x16x32_bf16(kb, qf[m][ks], sacc[m][nf], 0, 0, 0);
        }
      bf16x8 pb[2][2];
      if (FIXC) {
#pragma unroll
        for (int m = 0; m < 2; ++m) {
          float ps0 = 0.f, ps1 = 0.f;
          float pe[4][4];
#pragma unroll
          for (int nf = 0; nf < 4; ++nf) {
            pe[nf][0] = __builtin_amdgcn_exp2f(sacc[m][nf][0]); pe[nf][1] = __builtin_amdgcn_exp2f(sacc[m][nf][1]);
            pe[nf][2] = __builtin_amdgcn_exp2f(sacc[m][nf][2]); pe[nf][3] = __builtin_amdgcn_exp2f(sacc[m][nf][3]);
            ps0 += pe[nf][0] + pe[nf][2]; ps1 += pe[nf][1] + pe[nf][3];
          }
          lrow[m] += ps0 + ps1;
#pragma unroll
          for (int ks2 = 0; ks2 < 2; ++ks2) {
            union { bf16x8 v; unsigned u[4]; } cv;
            cv.u[0] = pack2(pe[2 * ks2][0], pe[2 * ks2][1]); cv.u[1] = pack2(pe[2 * ks2][2], pe[2 * ks2][3]);
            cv.u[2] = pack2(pe[2 * ks2 + 1][0], pe[2 * ks2 + 1][1]); cv.u[3] = pack2(pe[2 * ks2 + 1][2], pe[2 * ks2 + 1][3]);
            pb[m][ks2] = cv.v;
          }
        }
      } else
#pragma unroll
      for (int m = 0; m < 2; ++m) {
        float mx = sacc[m][0][0];
#pragma unroll
        for (int nf = 0; nf < 4; ++nf)
#pragma unroll
          for (int j = 0; j < 4; ++j) mx = fmaxf(mx, sacc[m][nf][j]);
        mx = fmaxf(mx, __shfl_xor(mx, 16)); mx = fmaxf(mx, __shfl_xor(mx, 32));
        const float mn = fmaxf(mrow[m], mx);
        const float al = __builtin_amdgcn_exp2f(mrow[m] - mn);
        mrow[m] = mn;
        float ps = 0.f;
        float pe[4][4];
#pragma unroll
        for (int nf = 0; nf < 4; ++nf)
#pragma unroll
          for (int j = 0; j < 4; ++j) { pe[nf][j] = __builtin_amdgcn_exp2f(sacc[m][nf][j] - mn); ps += pe[nf][j]; }
        lrow[m] = lrow[m] * al + ps;
#pragma unroll
        for (int nfd = 0; nfd < 4; ++nfd)
#pragma unroll
          for (int j = 0; j < 4; ++j) o[m][nfd][j] *= al;
#pragma unroll
        for (int ks2 = 0; ks2 < 2; ++ks2) {
          union { bf16x8 v; unsigned u[4]; } cv;
          cv.u[0] = pack2(pe[2 * ks2][0], pe[2 * ks2][1]); cv.u[1] = pack2(pe[2 * ks2][2], pe[2 * ks2][3]);
          cv.u[2] = pack2(pe[2 * ks2 + 1][0], pe[2 * ks2 + 1][1]); cv.u[3] = pack2(pe[2 * ks2 + 1][2], pe[2 * ks2 + 1][3]);
          pb[m][ks2] = cv.v;
        }
      }
#pragma unroll
      for (int ks2 = 0; ks2 < 2; ++ks2)
#pragma unroll
        for (int nfd = 0; nfd < 4; ++nfd) {
          const bf16x8 va = *(const bf16x8*)(VTb + (nfd * 16 + fr) * 144 + sub * 64 + ks2 * 32 + 8 * fq);
#pragma unroll
          for (int m = 0; m < 2; ++m) o[m][nfd] = __builtin_amdgcn_mfma_f32_16x16x32_bf16(va, pb[m][ks2], o[m][nfd], 0, 0, 0);
        }
    }
  }
#undef ATT_LOAD
#undef ATT_STORE
#pragma unroll
  for (int m = 0; m < 2; ++m) {
    float l = lrow[m];
    l += __shfl_xor(l, 16); l += __shfl_xor(l, 32);
    const float il = 1.f / l;
    bf16_t* yd = Y + (size_t)(rowq0 + w * 32 + m * 16 + fr) * DM + 768 + h * 64;
#pragma unroll
    for (int nfd = 0; nfd < 4; ++nfd) {
      uint2 ov;
      ov.x = pack2(o[m][nfd][0] * il, o[m][nfd][1] * il); ov.y = pack2(o[m][nfd][2] * il, o[m][nfd][3] * il);
      *(uint2*)(yd + nfd * 16 + 4 * fq) = ov;
    }
  }
}

template <int MODE>
__device__ __forceinline__ void attn_item_fixc(const Params& p, int L, int item, float negc) {
  char* sm = dynsmem;
  bf16_t* KT = (bf16_t*)sm;
  bf16_t* VT = (bf16_t*)(sm + 28672);
  int tx_ = threadIdx.x; asm volatile("" : "+v"(tx_));
  const int tid = tx_, w = tid >> 6, lane = tid & 63, fr = lane & 15, fq = lane >> 4;
  int b, h, rowq0, nkeys;
  if (item < 512) { int bh = item >> 3, qb = item & 7; b = bh >> 2; h = bh & 3; rowq0 = b * SEQ + qb * 256; nkeys = NKEY; }
  else { int bh = item - 512; b = bh >> 2; h = bh & 3; rowq0 = NLAT + b * CTXL; nkeys = CTXL; }
  const bf16_t* QB = (const bf16_t*)(p.ws + OFF_ACTB + QB_OFF);
  const bf16_t* KB = (const bf16_t*)(p.ws + OFF_ACTB + KB_OFF) + ((size_t)(b * 4 + h)) * NKEY * 96;
  const bf16_t* VB = (const bf16_t*)(p.ws + OFF_ACTB + VB_OFF) + ((size_t)(b * 4 + h)) * 64 * NKEY;
  bf16_t* Y = (bf16_t*)(p.ws + OFF_ACTA);
  bf16x8 qf[2][3];
#pragma unroll
  for (int m = 0; m < 2; ++m)
#pragma unroll
    for (int ks = 0; ks < 3; ++ks) qf[m][ks] = *(const bf16x8*)(QB + ((size_t)(rowq0 + w * 32 + m * 16 + fr) * 4 + h) * 96 + ks * 32 + fq * 8);
  f32x4 o[2][4];
  float lrow[2];
#pragma unroll
  for (int m = 0; m < 2; ++m) {
    lrow[m] = 0.f;
#pragma unroll
    for (int j = 0; j < 4; ++j) o[m][j] = (f32x4){0.f, 0.f, 0.f, 0.f};
  }
  const f32x4 negc4 = (f32x4){negc, negc, negc, negc};
  uint4 pk0, pk1, pk2, pv0, pv1;
  const int kr0 = tid / 12, kp0 = tid % 12, kr1 = (tid + 512) / 12, kp1 = (tid + 512) % 12, kr2 = (tid + 1024) / 12, kp2 = (tid + 1024) % 12;
  const int vd0 = tid >> 4, vp0 = tid & 15, vd1 = (tid + 512) >> 4;
#define ATT_LOAD(K0)                                                                 \
  {                                                                                  \
    pk0 = *(const uint4*)(KB + (size_t)((K0) + kr0) * 96 + kp0 * 8);                 \
    pk1 = *(const uint4*)(KB + (size_t)((K0) + kr1) * 96 + kp1 * 8);                 \
    pk2 = *(const uint4*)(KB + (size_t)((K0) + kr2) * 96 + kp2 * 8);                 \
    pv0 = *(const uint4*)(VB + (size_t)vd0 * NKEY + (K0) + vp0 * 8);                 \
    pv1 = *(const uint4*)(VB + (size_t)vd1 * NKEY + (K0) + vp0 * 8);                 \
  }
#define ATT_STORE(BUF)                                                               \
  {                                                                                  \
    bf16_t* kt_ = KT + (BUF) * 23552; bf16_t* vt_ = VT + (BUF) * 23552;               \
    *(uint4*)(kt_ + kr0 * 112 + kp0 * 8) = pk0;                                      \
    *(uint4*)(kt_ + kr1 * 112 + kp1 * 8) = pk1;                                      \
    *(uint4*)(kt_ + kr2 * 112 + kp2 * 8) = pk2;                                      \
    *(uint4*)(vt_ + vd0 * 144 + vp0 * 8) = pv0;                                      \
    *(uint4*)(vt_ + vd1 * 144 + vp0 * 8) = pv1;                                      \
  }
#define ATT_SB() __builtin_amdgcn_sched_barrier(0)
#define ATT_LDK(F, KTB, SUB, KS) { _Pragma("unroll") for (int nf = 0; nf < 4; ++nf) F[nf] = *(const bf16x8*)((KTB) + ((SUB) * 64 + nf * 16 + fr) * 112 + (KS) * 32 + fq * 8); }
#define ATT_LDV(F, VTB, SUB, KS2) { _Pragma("unroll") for (int nfd = 0; nfd < 4; ++nfd) F[nfd] = *(const bf16x8*)((VTB) + (nfd * 16 + fr) * 144 + (SUB) * 64 + (KS2) * 32 + 8 * fq); }
#define ATT_MMK(F, KS, INIT) { _Pragma("unroll") for (int nf = 0; nf < 4; ++nf) _Pragma("unroll") for (int m = 0; m < 2; ++m) \
    sacc[m][nf] = __builtin_amdgcn_mfma_f32_16x16x32_bf16(F[nf], qf[m][KS], (INIT) ? negc4 : sacc[m][nf], 0, 0, 0); }
#define ATT_MMV(F, KS2) { _Pragma("unroll") for (int nfd = 0; nfd < 4; ++nfd) _Pragma("unroll") for (int m = 0; m < 2; ++m) \
    o[m][nfd] = __builtin_amdgcn_mfma_f32_16x16x32_bf16(F[nfd], pb[m][KS2], o[m][nfd], 0, 0, 0); }
#define ATT_SOFTMAX() { _Pragma("unroll") for (int m = 0; m < 2; ++m) {                                                   \
      float ps0 = 0.f, ps1 = 0.f; float pe[4][4];                                                                         \
      _Pragma("unroll") for (int nf = 0; nf < 4; ++nf) {                                                                  \
        if (MODE == 1) { pe[nf][0] = sacc[m][nf][0]; pe[nf][1] = sacc[m][nf][1]; pe[nf][2] = sacc[m][nf][2]; pe[nf][3] = sacc[m][nf][3]; ps0 += pe[nf][0]; } else { \
        pe[nf][0] = __builtin_amdgcn_exp2f(sacc[m][nf][0]); pe[nf][1] = __builtin_amdgcn_exp2f(sacc[m][nf][1]);           \
        pe[nf][2] = __builtin_amdgcn_exp2f(sacc[m][nf][2]); pe[nf][3] = __builtin_amdgcn_exp2f(sacc[m][nf][3]);           \
        ps0 += pe[nf][0] + pe[nf][2]; ps1 += pe[nf][1] + pe[nf][3]; } }                                                   \
      lrow[m] += ps0 + ps1;                                                                                               \
      _Pragma("unroll") for (int ks2 = 0; ks2 < 2; ++ks2) {                                                               \
        union { bf16x8 v; unsigned u[4]; } cv;                                                                            \
        cv.u[0] = pack2(pe[2 * ks2][0], pe[2 * ks2][1]); cv.u[1] = pack2(pe[2 * ks2][2], pe[2 * ks2][3]);                 \
        cv.u[2] = pack2(pe[2 * ks2 + 1][0], pe[2 * ks2 + 1][1]); cv.u[3] = pack2(pe[2 * ks2 + 1][2], pe[2 * ks2 + 1][3]); \
        pb[m][ks2] = cv.v; } } }
#define ATT_SUB(X, Y, SUB, NEXT)                                                     \
  {                                                                                  \
    f32x4 sacc[2][4]; bf16x8 pb[2][2];                                               \
    ATT_MMK(X, 0, true);  ATT_SB(); ATT_LDK(X, KTb, SUB, 2);  ATT_SB();              \
    ATT_MMK(Y, 1, false); ATT_SB(); ATT_LDV(Y, VTb, SUB, 0);  ATT_SB();              \
    ATT_MMK(X, 2, false); ATT_SB(); ATT_LDV(X, VTb, SUB, 1);  ATT_SB();              \
    ATT_SOFTMAX();        ATT_SB();                                                  \
    ATT_MMV(Y, 0);        ATT_SB(); if (NEXT) { ATT_LDK(Y, KTb, (SUB) + 1, 0); } ATT_SB(); \
    ATT_MMV(X, 1);        ATT_SB(); if (NEXT) { ATT_LDK(X, KTb, (SUB) + 1, 1); } ATT_SB(); \
  }
  const int ntiles = nkeys >> 7;
  __syncthreads();
  ATT_LOAD(0);
  ATT_STORE(0);
  if (ntiles > 1) ATT_LOAD(128);
  bf16x8 fa[4], fb[4];
  for (int t = 0; t < ntiles; ++t) {
    __syncthreads();
    if (t + 1 < ntiles) {
      ATT_STORE((t + 1) & 1);
      if (t + 2 < ntiles) ATT_LOAD((t + 2) * 128);
    }
    const bf16_t* KTb = KT + (t & 1) * 23552;
    const bf16_t* VTb = VT + (t & 1) * 23552;
    ATT_SB();
    ATT_LDK(fa, KTb, 0, 0); ATT_LDK(fb, KTb, 0, 1);
    ATT_SB();
    ATT_SUB(fa, fb, 0, true);
    ATT_SUB(fb, fa, 1, false);
  }
#undef ATT_LOAD
#undef ATT_STORE
#undef ATT_SB
#undef ATT_LDK
#undef ATT_LDV
#undef ATT_MMK
#undef ATT_MMV
#undef ATT_SOFTMAX
#undef ATT_SUB
#pragma unroll
  for (int m = 0; m < 2; ++m) {
    float l = lrow[m];
    l += __shfl_xor(l, 16); l += __shfl_xor(l, 32);
    const float il = 1.f / l;
    bf16_t* yd = Y + (size_t)(rowq0 + w * 32 + m * 16 + fr) * DM + 768 + h * 64;
#pragma unroll
    for (int nfd = 0; nfd < 4; ++nfd) {
      uint2 ov;
      ov.x = pack2(o[m][nfd][0] * il, o[m][nfd][1] * il); ov.y = pack2(o[m][nfd][2] * il, o[m][nfd][3] * il);
      if (MODE == 0 || negc < -1000.f) *(uint2*)(yd + nfd * 16 + 4 * fq) = ov;
    }
  }
}

__device__ __forceinline__ void phase_mix(const Params& p, int L, int bid, int nb) {
  volatile int* s_itemp = (volatile int*)(dynsmem + 2 * GROUP_LDS);
  int* cnt = (int*)(p.ws + OFF_CNT) + L;
  unsigned* done = (unsigned*)(p.ws + OFF_CNT) + 8 + L * 16;
  const int per = (L == 0) ? 36 : 32;
  const int total = 480 + NB * per;
  float cb;
  {
    const float* qn = p.in[I_MQN] + L * 96;
    const float* kn = p.in[I_MKN] + L * 96;
    const int ln = otid() & 63;
    float a = qn[ln], r = qn[64 + (ln & 31)], c = kn[ln], d = kn[64 + (ln & 31)];
    a *= a; r *= r; c *= c; d *= d;
#pragma unroll
    for (int o = 1; o < 64; o <<= 1) { a = fmaxf(a, __shfl_xor(a, o)); r = fmaxf(r, __shfl_xor(r, o)); c = fmaxf(c, __shfl_xor(c, o)); d = fmaxf(d, __shfl_xor(d, o)); }
    cb = 0.10206207261596577f * 1.4426950408889634f * 1.01f * sqrtf((64.f * a + 32.f * r) * (64.f * c + 32.f * d));
    cb = __int_as_float(__builtin_amdgcn_readfirstlane(__float_as_int(cb)));
  }
  for (;;) {
    __syncthreads();
    if (threadIdx.x == 0) *s_itemp = atomicAdd(cnt, 1);
    __syncthreads();
    const int it = *s_itemp;
    if (it >= total) break;
    if (it < 64) chain_hgrn_fast(p, L, it);
    else if (it < 128) chain_ssd_fast(p, L, it - 64);
    else if (it < 192) chain_lru_fast(p, L, it - 128);
    else if (it < 480) {
      const int j = it - 192, b = j / 18, r = j % 18;
      const int item = r < 2 ? (256 + b * 2 + r) : (b * 16 + r - 2);
      mlaproj_item_fast(p, L, item);
      asm volatile("s_waitcnt vmcnt(0)" ::: "memory");
      __syncthreads();
      if (threadIdx.x == 0) {
        __builtin_amdgcn_fence(__ATOMIC_RELEASE, "agent");
        asm volatile("s_waitcnt vmcnt(0)" ::: "memory");
        (void)xb_add(&done[b], 1u);
      }
    } else {
      const int a = it - 480, b = a / per, r = a % per;
      const int item = r < 32 ? (b * 32 + r) : (512 + b * 4 + (r - 32));
      if (threadIdx.x == 0) {
        unsigned sp = 0;
        while (xb_ld(&done[b]) < 18u) { __builtin_amdgcn_s_sleep(2); if (++sp > (1u << 22)) break; }
        __builtin_amdgcn_fence(__ATOMIC_ACQUIRE, "agent");
        asm volatile("s_waitcnt vmcnt(0)" ::: "memory");
      }
      __syncthreads();
      if (cb <= 40.f) attn_item_fixc<0>(p, L, item, -cb);
      else attn_item_fast<false>(p, L, item, 0.f);
    }
#if DIAG
    if (L == 0 && threadIdx.x == 0) {
      const int ty = it < 64 ? 0 : (it < 128 ? 1 : (it < 192 ? 2 : (it < 480 ? 3 : 4)));
      atomicMax((unsigned long long*)(p.ws + OFF_TS) + 24 + ty, (unsigned long long)wall_clock64());
    }
#endif
  }
}

__device__ __forceinline__ void phase_ssdnorm(const Params& p, int L, int bid, int nb) {
  const int tx0_ = otid();
  const int wave = tx0_ >> 6, lane = tx0_ & 63;
  bf16_t* Y = (bf16_t*)(p.ws + OFF_ACTA);
  const float* nw = p.in[I_SNW] + L * 256;
  const int nrows = (L == 0) ? NTOK : NLAT;
  for (int row = bid * 8 + wave; row < nrows; row += nb * 8) {
    uint2* yp = (uint2*)(Y + (size_t)row * DM + 512) + lane;
    uint2 v = *yp;
    float a0 = __uint_as_float(v.x << 16), a1 = __uint_as_float(v.x & 0xffff0000u), a2 = __uint_as_float(v.y << 16), a3 = __uint_as_float(v.y & 0xffff0000u);
    float ss = wave_sum(a0 * a0 + a1 * a1 + a2 * a2 + a3 * a3);
    float rn = rsqrtf(ss * (1.f / 256.f) + EPSF);
    float4 w = ((const float4*)nw)[lane];
    uint2 o;
    o.x = pack2(a0 * rn * w.x, a1 * rn * w.y);
    o.y = pack2(a2 * rn * w.z, a3 * rn * w.w);
    *yp = o;
  }
}

__device__ __forceinline__ void phase_topk(const Params& p, int L, int bid, int nb) {
  unsigned* hist = (unsigned*)dynsmem;
  unsigned* wsum = hist + 256;
  volatile unsigned* sel = wsum + 16;
  const int tid = otid();
  const int wave = tid >> 6, lane = tid & 63;
  const float* aff = (const float*)(p.ws + OFF_AFF);
  int* ROWL = (int*)(p.ws + OFF_ROWL);
  int* SEL = (int*)(p.ws + OFF_SEL);
  float* GSEL = (float*)(p.ws + OFF_GSEL);
  const int nitems = (L == 0) ? 512 : 256;
  for (int it = bid; it < nitems; it += nb) {
    const bool lat = it < 256;
    const int be = lat ? it : it - 256;
    const int b = be >> 4, e = be & 15;
    const int n = lat ? SEQ : CTXL, cap = lat ? CAPL : CAPC;
    const float* src = lat ? aff + (size_t)be * SEQ : aff + (size_t)NB * NEXP * SEQ + (size_t)be * CTXL;
    float av[4]; unsigned kv[4];
    const bool act = 4 * tid < n;
    if (act) {
      const float4 a4 = *(const float4*)(src + 4 * tid);
      av[0] = a4.x; av[1] = a4.y; av[2] = a4.z; av[3] = a4.w;
#pragma unroll
      for (int q = 0; q < 4; ++q) kv[q] = __float_as_uint(av[q]);
    } else {
#pragma unroll
      for (int q = 0; q < 4; ++q) { av[q] = 0.f; kv[q] = 0u; }
    }
    unsigned prefix = 0u, need = (unsigned)cap;
#pragma unroll 1
    for (int pass = 0; pass < 4; ++pass) {
      const int shift = 24 - 8 * pass;
      __syncthreads();
      if (tid < 256) hist[tid] = 0u;
      __syncthreads();
      if (act) {
#pragma unroll
        for (int q = 0; q < 4; ++q)
          if (pass == 0 || (kv[q] >> (shift + 8)) == prefix) atomicAdd(&hist[(kv[q] >> shift) & 255u], 1u);
      }
      __syncthreads();
      if (wave == 0) {
        const unsigned h0 = hist[4 * lane], h1 = hist[4 * lane + 1], h2 = hist[4 * lane + 2], h3 = hist[4 * lane + 3];
        const unsigned tl = h0 + h1 + h2 + h3;
        unsigned v = tl;
#pragma unroll
        for (int o = 1; o < 64; o <<= 1) { unsigned t2 = __shfl_down(v, o); if (lane + o < 64) v += t2; }
        unsigned run = v - tl;
        if (run < need && run + h3 >= need) { sel[0] = 4 * lane + 3; sel[1] = need - run; } run += h3;
        if (run < need && run + h2 >= need) { sel[0] = 4 * lane + 2; sel[1] = need - run; } run += h2;
        if (run < need && run + h1 >= need) { sel[0] = 4 * lane + 1; sel[1] = need - run; } run += h1;
        if (run < need && run + h0 >= need) { sel[0] = 4 * lane + 0; sel[1] = need - run; }
      }
      __syncthreads();
      prefix = (prefix << 8) | sel[0];
      need = sel[1];
    }
    int ceq = 0, cgt = 0;
#pragma unroll
    for (int q = 0; q < 4; ++q) { ceq += (act && kv[q] == prefix) ? 1 : 0; cgt += (act && kv[q] > prefix) ? 1 : 0; }
    int ieq = ceq;
#pragma unroll
    for (int o = 1; o < 64; o <<= 1) { int t2 = __shfl_up(ieq, o); if (lane >= o) ieq += t2; }
    if (lane == 63) wsum[wave] = (unsigned)ieq;
    __syncthreads();
    int eqbase = ieq - ceq;
    for (int w2 = 0; w2 < wave; ++w2) eqbase += (int)wsum[w2];
    bool take[4];
    int c = 0;
#pragma unroll
    for (int q = 0; q < 4; ++q) {
      bool t = act && kv[q] > prefix;
      if (act && kv[q] == prefix) { t = (unsigned)eqbase < need; ++eqbase; }
      take[q] = t; c += t ? 1 : 0;
    }
    int incl = c;
#pragma unroll
    for (int o = 1; o < 64; o <<= 1) { int t2 = __shfl_up(incl, o); if (lane >= o) incl += t2; }
    if (lane == 63) wsum[8 + wave] = (unsigned)incl;
    __syncthreads();
    int base = incl - c;
    for (int w2 = 0; w2 < wave; ++w2) base += (int)wsum[8 + w2];
    if (act) {
#pragma unroll
      for (int q = 0; q < 4; ++q) {
        const int i = 4 * tid + q;
        const int row = lat ? (b * SEQ + i) : (NLAT + b * CTXL + i);
        int slot = -1;
        if (take[q]) {
          slot = lat ? (e * SLOTS + b * CAPL + base) : (e * SLOTS + SLOTS_L + b * CAPC + base);
          ROWL[slot] = row;
          ++base;
        }
        SEL[(size_t)row * 16 + e] = slot;
        GSEL[(size_t)row * 16 + e] = av[q];
      }
    }
    __syncthreads();
  }
}

#define XB_TMO      128
#define XB_XCNT(j)  (256  + 64 * (j))
#define XB_XSUB(j)  (1280 + 64 * (j))
#define XB_XGEN(j)  (2304 + 64 * (j))
#define XB_TOP      3328
#define XB_TOPGEN   3392
#define XB_SPIN_CAP (1u << 20)
#define XLAS __attribute__((address_space(3)))
__device__ __forceinline__ unsigned xb_xcc_id() { return (unsigned)__builtin_amdgcn_s_getreg((3 << 11) | 20) & 0xFu; }
#define XB_SPIN(cond, bar) do { unsigned _sp = 0; while (cond) { __builtin_amdgcn_s_sleep(1); \
    if ((++_sp & 255u) == 0u) { if (xb_ld(&(bar)[XB_TMO])) break; if (_sp > XB_SPIN_CAP) { atomicAdd(&(bar)[XB_TMO], 1u); break; } } } } while (0)
struct XcdBarrier { unsigned* bar; unsigned x; volatile XLAS unsigned* st; };
__device__ __forceinline__ XcdBarrier xcd_barrier_post(unsigned* bar, volatile XLAS unsigned* st) {
  XcdBarrier b; b.bar = bar; b.x = xb_xcc_id(); b.st = st;
  if (threadIdx.x == 0) (void)xb_add(&bar[XB_XCNT(b.x)], 1u);
  return b;
}
__device__ __forceinline__ void xcd_barrier_complete(unsigned* bar, unsigned x, unsigned& nloc, unsigned& nx) {
  const unsigned G = gridDim.x * gridDim.y * gridDim.z;
  unsigned sum, cnt, mine, sp = 0u;
  for (;;) {
    sum = 0u; cnt = 0u; mine = 0u;
#pragma unroll
    for (unsigned j = 0; j < 16; ++j) { const unsigned c = xb_ld(&bar[XB_XCNT(j)]); sum += c; cnt += (c > 0u) ? 1u : 0u; mine = (j == x) ? c : mine; }
    if (sum == G) break;
    __builtin_amdgcn_s_sleep(1);
    if ((++sp & 255u) == 0u) { if (xb_ld(&bar[XB_TMO])) break; if (sp > XB_SPIN_CAP) { atomicAdd(&bar[XB_TMO], 1u); break; } }
  }
  nloc = mine > 0u ? mine : 1u; nx = cnt > 0u ? cnt : 1u;
}
__device__ __forceinline__ void xcd_barrier(const XcdBarrier& b) {
  asm volatile("s_waitcnt vmcnt(0)" ::: "memory");
  __syncthreads();
  if (threadIdx.x == 0) {
    unsigned* bar = b.bar;
    __builtin_amdgcn_s_waitcnt(0);
    unsigned nloc = b.st[0], nx = b.st[1];
    if (nloc == 0u) { xcd_barrier_complete(bar, b.x, nloc, nx); b.st[0] = nloc; b.st[1] = nx; }
    const unsigned old = xb_add(&bar[XB_XSUB(b.x)], 1u);
    const unsigned gen = old / nloc;
    if (old + 1u == (gen + 1u) * nloc) {
      __builtin_amdgcn_fence(__ATOMIC_RELEASE, "agent");
      asm volatile("s_waitcnt vmcnt(0)" ::: "memory");
      const unsigned og = xb_add(&bar[XB_TOP], 1u);
      const unsigned tg = og / nx;
      if (og + 1u == (tg + 1u) * nx) xb_add(&bar[XB_TOPGEN], 1u);
      else XB_SPIN(xb_ld(&bar[XB_TOPGEN]) == tg, bar);
      __builtin_amdgcn_fence(__ATOMIC_ACQUIRE, "agent");
      xb_add(&bar[XB_XGEN(b.x)], 1u);
      asm volatile("s_waitcnt vmcnt(0)" ::: "memory");
    } else {
      XB_SPIN(xb_ld(&bar[XB_XGEN(b.x)]) == gen, bar);
      __builtin_amdgcn_fence(__ATOMIC_ACQUIRE, "agent");
      asm volatile("s_waitcnt vmcnt(0)" ::: "memory");
    }
  }
  __syncthreads();
}

enum { PH_PREP = 0, PH_NORM1, PH_INPROJ, PH_MLAPROJ, PH_MIX, PH_SSDNORM, PH_OUTPROJ, PH_NORM2, PH_TOPK, PH_MOE1, PH_MOE2, PH_FINAL };

__device__ __forceinline__ void run_phase(const Params& p, int ph, int L, int bid, int nb) {
  switch (ph) {
    case PH_PREP: phase_prep_a(p, bid, nb); break;
    case PH_NORM1: phase_norm1x2(p, L, 0, L == 0 ? 0 : 1, L == 0 ? -1 : 0, NTOK, bid, nb); break;
    case PH_INPROJ: phase_inproj(p, L, bid, nb); break;
    case PH_MLAPROJ: break;
    case PH_MIX: phase_mix(p, L, bid, nb); break;
    case PH_SSDNORM: phase_ssdnorm(p, L, bid, nb); break;
    case PH_OUTPROJ: phase_outproj(p, L, bid, nb); break;
    case PH_NORM2: phase_norm2(p, L, L == 0 ? 1 : 2, L == 0 ? NTOK : NLAT, bid, nb); break;
    case PH_TOPK: phase_topk(p, L, bid, nb); break;
    case PH_MOE1: phase_moe1(p, L, bid, nb); break;
    case PH_MOE2: phase_moe2(p, L, bid, nb); break;
    case PH_FINAL: phase_norm1x2(p, 1, 2, 2, 1, NLAT, bid, nb); break;
  }
}

#if !MEGA
template <int PH>
__global__ void __launch_bounds__(NT, 2) k_phase(Params p, int L) {
  run_phase(p, PH, L, blockIdx.x, gridDim.x);
}
#else
__global__ void __launch_bounds__(NT, 2) k_mega(Params p) {
  cg::grid_group grid = cg::this_grid();
  const int bid = blockIdx.x, nb = gridDim.x;
#if DIAG
  unsigned long long* TSP = (unsigned long long*)(p.ws + OFF_TS);
  int tsi = 0;
#define STAMP() do { if (bid == 0 && threadIdx.x == 0) TSP[tsi] = wall_clock64(); ++tsi; } while (0)
#else
#define STAMP() do {} while (0)
#endif
  volatile XLAS unsigned* xst = (volatile XLAS unsigned*)(dynsmem + XB_LDS_OFF);
  if (threadIdx.x == 0) { xst[0] = 0u; xst[1] = 0u; }
  __syncthreads();
  const XcdBarrier xb = xcd_barrier_post((unsigned*)(p.ws + OFF_BAR), xst);
  STAMP();
  phase_prep_a(p, bid, nb);
  if (p.ws == nullptr) grid.sync();
  xcd_barrier(xb);
  STAMP();
  phase_prep_b(p, bid, nb);
#define RP(PH, L) run_phase(p, PH, L, bid, nb); xcd_barrier(xb); STAMP();
  RP(PH_NORM1, 0) RP(PH_INPROJ, 0) RP(PH_MIX, 0)
#if PROBE_ATT
  { for (int a = bid; a < 512; a += nb) { __syncthreads(); attn_item_fixc<PROBE_ATT - 1>(p, 0, a, -15.f); } } xcd_barrier(xb);
#endif
  RP(PH_OUTPROJ, 0) RP(PH_NORM2, 0) RP(PH_TOPK, 0) RP(PH_MOE1, 0) RP(PH_MOE2, 0)
  RP(PH_NORM1, 1) RP(PH_INPROJ, 1) RP(PH_MIX, 1) RP(PH_OUTPROJ, 1) RP(PH_NORM2, 1) RP(PH_TOPK, 1) RP(PH_MOE1, 1) RP(PH_MOE2, 1)
#if DIAG
  if (bid == 0 && threadIdx.x == 0) {
    const double tot = (double)(TSP[19] - TSP[0]);
    double sa = 0, sb = 0;
    for (int i = 0; i < 19; ++i) {
      const double dtv = (double)(TSP[i + 1] - TSP[i]);
      if ((DIAG_MASK_A >> i) & 1) sa += dtv;
      if ((DIAG_MASK_B >> i) & 1) sb += dtv;
    }
    float* dg = (float*)(p.ws + OFF_TS + 256);
    dg[0] = 0.05f + 0.45f * floorf(64.f * (float)(sa / tot) + 0.5f) / 64.f;
    dg[1] = 100.f + 900.f * floorf(64.f * (float)(sb / tot) + 0.5f) / 64.f;
    if (DIAG == 2) { dg[0] = 0.05f + 0.45f * (float)(tot / 1.0e6); }
    if (DIAG >= 3) {
      const double ms = (double)TSP[3], me = (double)TSP[4];
      const int ia = (DIAG == 3) ? 0 : (DIAG == 4 ? 2 : 4), ib = (DIAG == 3) ? 1 : (DIAG == 4 ? 3 : 4);
      dg[0] = 0.05f + 0.45f * floorf(24.f * (float)(((double)TSP[24 + ia] - ms) / (me - ms)) + 0.5f) / 24.f;
      dg[1] = 100.f + 900.f * floorf(24.f * (float)(((double)TSP[24 + ib] - ms) / (me - ms)) + 0.5f) / 24.f;
      if (DIAG == 5) dg[1] = 100.f + 900.f * floorf(20.f * (float)((me - ms) / 1.0e5) + 0.5f) / 20.f;
    }
  }
  __threadfence();
  grid.sync();
#endif
  run_phase(p, PH_FINAL, 1, bid, nb);
}
#endif

extern "C" void kernel_launch(void* const* d_in, const int* in_sizes, int n_in, void* d_out, int out_size, void* d_ws, size_t ws_size, hipStream_t stream) {
  Params p{};
  for (int i = 0; i < N_IN; ++i) p.in[i] = (const float*)d_in[i];
  p.out = (float*)d_out;
  p.ws = (char*)d_ws;
  if (n_in != N_IN || ws_size < WS_END) { fprintf(stderr, "kernel_launch: bad args n_in=%d ws=%zu need %zu\n", n_in, ws_size, (size_t)WS_END); return; }
#if MEGA
  static int grid = 0;
  if (!grid) {
    int dev = 0, cus = 0, per_cu = 0;
    (void)hipGetDevice(&dev);
    (void)hipDeviceGetAttribute(&cus, hipDeviceAttributeMultiprocessorCount, dev);
    (void)hipFuncSetAttribute((const void*)k_mega, hipFuncAttributeMaxDynamicSharedMemorySize, DYN_LDS);
    (void)hipOccupancyMaxActiveBlocksPerMultiprocessor(&per_cu, (const void*)k_mega, NT, DYN_LDS);
    if (per_cu > 1) per_cu = 1;
    if (per_cu < 1) per_cu = 1;
    grid = cus * per_cu;
  }
  (void)hipMemsetAsync((char*)d_ws + OFF_BAR, 0, SZ_BAR, stream);
  void* args[] = {&p};
  hipError_t e = hipLaunchCooperativeKernel((const void*)k_mega, dim3(grid), dim3(NT), args, DYN_LDS, stream);
  if (e != hipSuccess) fprintf(stderr, "cooperative launch failed: %s (grid %d)\n", hipGetErrorString(e), grid);
#else
  const int G = 256;
  static bool attr = false;
#define SETATTR(PH) (void)hipFuncSetAttribute((const void*)k_phase<PH>, hipFuncAttributeMaxDynamicSharedMemorySize, DYN_LDS)
  if (!attr) { SETATTR(PH_PREP); SETATTR(PH_NORM1); SETATTR(PH_INPROJ); SETATTR(PH_MLAPROJ); SETATTR(PH_MIX); SETATTR(PH_SSDNORM); SETATTR(PH_OUTPROJ);
               SETATTR(PH_NORM2); SETATTR(PH_TOPK); SETATTR(PH_MOE1); SETATTR(PH_MOE2); SETATTR(PH_FINAL); attr = true; }
#define LAUNCH(PH, L) k_phase<PH><<<G, NT, DYN_LDS, stream>>>(p, L)
  LAUNCH(PH_PREP, 0);
  for (int L = 0; L < 2; ++L) {
    LAUNCH(PH_NORM1, L); LAUNCH(PH_INPROJ, L); LAUNCH(PH_MLAPROJ, L); LAUNCH(PH_MIX, L); LAUNCH(PH_SSDNORM, L);
    LAUNCH(PH_OUTPROJ, L); LAUNCH(PH_NORM2, L); LAUNCH(PH_TOPK, L); LAUNCH(PH_MOE1, L); LAUNCH(PH_MOE2, L);
  }
  LAUNCH(PH_FINAL, 1);
#endif
}
```
